# Optimizing an MI355X kernel written in HIP

```python
import jax, jax.numpy as jnp
from jax import lax
import numpy as np

D_MODEL = 2048
BATCH = 4
SEQ = 2048
DEPTH = 1
DEC_BATCH = 128
DEC_SEQ = 4
PAST_LEN = 16384
PAGE_SIZE = 128

N_RET_HEADS = 8
RET_DK = D_MODEL // N_RET_HEADS
RET_DV = 2 * RET_DK
D_RET_QK = N_RET_HEADS * RET_DK
D_RET_V = N_RET_HEADS * RET_DV
RET_CHUNK = 128
ROPE_BASE = 10000.0
D_CONV = D_MODEL
CONV_W = 3
D_FF = 5632
FFN_CONV_W = 3
EPS = 1e-6
D_IN = 2 * D_RET_QK + 2 * D_RET_V + 3 * D_CONV + 2 * D_MODEL

kernel_name = "retnet_shortconv_convffn_hybrid_step"


def rmsnorm(x, g):
    xf = x.astype(jnp.float32)
    y = xf * lax.rsqrt(jnp.mean(xf * xf, axis=-1, keepdims=True) + EPS)
    return (y * g.astype(jnp.float32)).astype(x.dtype)


def rotary(x, pos):
    half = x.shape[-1] // 2
    inv = ROPE_BASE ** (-jnp.arange(half, dtype=jnp.float32) / half)
    ang = pos.astype(jnp.float32)[:, None] * inv[None, :]
    cos = jnp.cos(ang)[None, :, None, :]
    sin = jnp.sin(ang)[None, :, None, :]
    xf = x.astype(jnp.float32)
    x1, x2 = xf[..., :half], xf[..., half:]
    return jnp.concatenate([x1 * cos - x2 * sin, x2 * cos + x1 * sin], axis=-1)


def causal_dwconv(u, buf, w):
    T = u.shape[1]
    width = w.shape[0]
    up = jnp.concatenate([buf.astype(u.dtype), u], axis=1)
    out = sum(w[i] * up[:, i:i + T] for i in range(width))
    return out, up[:, T:]


def retention_chunk(S, q, k, v, log_g):
    C = q.shape[2]
    i = jnp.arange(C, dtype=jnp.float32)
    diff = i[:, None] - i[None, :]
    causal = diff >= 0
    decay = jnp.where(causal[None], jnp.exp(log_g[:, None, None] * jnp.where(causal, diff, 0.0)[None]), 0.0)
    scores = jnp.einsum('bhid,bhjd->bhij', q, k) * decay[None]
    inner = jnp.einsum('bhij,bhje->bhie', scores, v)
    cross = jnp.einsum('bhid,bhde->bhie', q, S) * jnp.exp(log_g[:, None] * (i + 1.0))[None, :, :, None]
    k_dec = k * jnp.exp(log_g[:, None] * (C - 1.0 - i))[None, :, :, None]
    S_new = jnp.exp(log_g * C)[None, :, None, None] * S + jnp.einsum('bhjd,bhje->bhde', k_dec, v)
    return S_new, inner + cross


def retention(q, k, v, s0, chunk, log_g):
    B, H, T, _ = q.shape
    n = T // chunk

    def blocks(a):
        return jnp.moveaxis(a.reshape(B, H, n, chunk, a.shape[-1]), 2, 0)

    def step(S, qkv):
        return retention_chunk(S, qkv[0], qkv[1], qkv[2], log_g)

    s_new, o = lax.scan(step, s0, (blocks(q), blocks(k), blocks(v)))
    o = jnp.moveaxis(o, 0, 2).reshape(B, H, T, v.shape[-1])
    return o, s_new


def hybrid_layer(x, pos, s_ret, s_conv, s_ffn, chunk,
                 g_pre_mix, w_in, conv_w, p_ret, p_conv, w_o, g_post_mix,
                 g_pre_ffn, w_up, w_gate, ffn_conv_w, ffn_conv_b, w_down, g_post_ffn):
    B, T, _ = x.shape
    h = rmsnorm(x, g_pre_mix)
    z = h @ w_in
    cuts = np.cumsum([D_RET_QK, D_RET_QK, D_RET_V, D_RET_V, D_CONV, D_CONV, D_CONV, D_MODEL]).tolist()
    q, k, v, g_ret, gb, gc, hc, gate_a, gate_b = jnp.split(z, cuts, axis=-1)

    log_g = jnp.log1p(-jnp.exp2(-5.0 - jnp.arange(N_RET_HEADS, dtype=jnp.float32)))
    qr = rotary(q.reshape(B, T, N_RET_HEADS, RET_DK), pos)
    kr = rotary(k.reshape(B, T, N_RET_HEADS, RET_DK), pos) * (RET_DK ** -0.5)
    vh = v.reshape(B, T, N_RET_HEADS, RET_DV).astype(jnp.float32)
    o, s_ret_new = retention(qr.transpose(0, 2, 1, 3), kr.transpose(0, 2, 1, 3), vh.transpose(0, 2, 1, 3),
                             s_ret.astype(jnp.float32), chunk, log_g)
    o = o * lax.rsqrt(jnp.mean(o * o, axis=-1, keepdims=True) + EPS)
    o = o.transpose(0, 2, 1, 3).reshape(B, T, D_RET_V).astype(x.dtype)
    y_a = (jax.nn.silu(g_ret) * o) @ p_ret

    conv_out, s_conv_new = causal_dwconv(gc * hc, s_conv, conv_w)
    y_b = (gb * conv_out) @ p_conv

    m = jax.nn.sigmoid(gate_a) * y_a + jax.nn.sigmoid(gate_b) * y_b
    x = x + rmsnorm(m @ w_o, g_post_mix)

    h2 = rmsnorm(x, g_pre_ffn)
    u, s_ffn_new = causal_dwconv(h2 @ w_up, s_ffn, ffn_conv_w)
    f = (jax.nn.gelu(u + ffn_conv_b, approximate=True) * (h2 @ w_gate)) @ w_down
    x = x + rmsnorm(f, g_post_ffn)
    return x, s_ret_new.astype(s_ret.dtype), s_conv_new.astype(s_conv.dtype), s_ffn_new.astype(s_ffn.dtype)


def setup_inputs(seed: int = 0) -> dict:
    key = jax.random.key(seed)
    ks = jax.random.split(key, 20)
    f32 = jnp.float32

    def nrm(k, shape, scale):
        return jax.random.normal(k, shape, f32) * scale

    def gain(k, n):
        return 1.0 + 0.1 * jax.random.normal(k, (DEPTH, n), f32)

    return {
        "x_prompt": nrm(ks[0], (BATCH, SEQ, D_MODEL), 1.0),
        "x_sample": nrm(ks[1], (DEC_BATCH, DEC_SEQ, D_MODEL), 1.0),
        "state_ret": nrm(ks[2], (DEPTH, DEC_BATCH, N_RET_HEADS, RET_DK, RET_DV), 0.05),
        "state_conv": nrm(ks[3], (DEPTH, DEC_BATCH, CONV_W - 1, D_CONV), 1.0),
        "state_ffn": nrm(ks[4], (DEPTH, DEC_BATCH, FFN_CONV_W - 1, D_FF), 1.0),
        "g_pre_mix": gain(ks[5], D_MODEL),
        "w_in": nrm(ks[6], (DEPTH, D_MODEL, D_IN), D_MODEL ** -0.5),
        "conv_w": nrm(ks[7], (DEPTH, CONV_W, D_CONV), CONV_W ** -0.5),
        "p_ret": nrm(ks[8], (DEPTH, D_RET_V, D_MODEL), D_RET_V ** -0.5),
        "p_conv": nrm(ks[9], (DEPTH, D_CONV, D_MODEL), D_CONV ** -0.5),
        "w_o": nrm(ks[10], (DEPTH, D_MODEL, D_MODEL), D_MODEL ** -0.5),
        "g_post_mix": gain(ks[11], D_MODEL),
        "g_pre_ffn": gain(ks[12], D_MODEL),
        "w_up": nrm(ks[13], (DEPTH, D_MODEL, D_FF), D_MODEL ** -0.5),
        "w_gate": nrm(ks[14], (DEPTH, D_MODEL, D_FF), D_MODEL ** -0.5),
        "ffn_conv_w": nrm(ks[15], (DEPTH, FFN_CONV_W, D_FF), FFN_CONV_W ** -0.5),
        "ffn_conv_b": nrm(ks[16], (DEPTH, D_FF), 0.02),
        "w_down": nrm(ks[17], (DEPTH, D_FF, D_MODEL), D_FF ** -0.5),
        "g_post_ffn": gain(ks[18], D_MODEL),
    }


def reference(x_prompt, x_sample, state_ret, state_conv, state_ffn,
              g_pre_mix, w_in, conv_w, p_ret, p_conv, w_o, g_post_mix,
              g_pre_ffn, w_up, w_gate, ffn_conv_w, ffn_conv_b, w_down, g_post_ffn):
    pos_p = jnp.arange(SEQ, dtype=jnp.int32)
    pos_s = PAST_LEN + jnp.arange(DEC_SEQ, dtype=jnp.int32)
    yp, ys = x_prompt, x_sample
    rp, cp, fp, rs, cs, fs = [], [], [], [], [], []
    for l in range(DEPTH):
        w = (g_pre_mix[l], w_in[l], conv_w[l], p_ret[l], p_conv[l], w_o[l], g_post_mix[l],
             g_pre_ffn[l], w_up[l], w_gate[l], ffn_conv_w[l], ffn_conv_b[l], w_down[l], g_post_ffn[l])
        z_ret = jnp.zeros((BATCH, N_RET_HEADS, RET_DK, RET_DV), state_ret.dtype)
        z_conv = jnp.zeros((BATCH, CONV_W - 1, D_CONV), state_conv.dtype)
        z_ffn = jnp.zeros((BATCH, FFN_CONV_W - 1, D_FF), state_ffn.dtype)
        yp, a, b, c = hybrid_layer(yp, pos_p, z_ret, z_conv, z_ffn, RET_CHUNK, *w)
        ys, d, e, f = hybrid_layer(ys, pos_s, state_ret[l], state_conv[l], state_ffn[l], DEC_SEQ, *w)
        rp.append(a); cp.append(b); fp.append(c)
        rs.append(d); cs.append(e); fs.append(f)
    return (yp, ys, jnp.stack(rp), jnp.stack(cp), jnp.stack(fp), jnp.stack(rs), jnp.stack(cs), jnp.stack(fs))
```

```cpp
#include <hip/hip_runtime.h>
#include <hip/hip_cooperative_groups.h>
#include <cstdio>
#include <cstdint>
namespace cg = cooperative_groups;

#define LAS __attribute__((address_space(3)))
typedef unsigned short bf16_t;
typedef short bf16x8 __attribute__((ext_vector_type(8)));
typedef float f32x4 __attribute__((ext_vector_type(4)));
typedef float f32x2 __attribute__((ext_vector_type(2)));
typedef unsigned u32x4 __attribute__((ext_vector_type(4)));
typedef unsigned u32x2 __attribute__((ext_vector_type(2)));

constexpr int DM = 2048, SEQ = 2048, NBATCH = 4, MP = NBATCH * SEQ, DECB = 128, DECT = 4, MS = DECB * DECT, MT = MP + MS;
constexpr int DIN = 22528, NH = 8, DK = 256, DVH = 512, DVT = 4096, DFF = 5632;
constexpr int LDV = MT;
constexpr float EPS = 1e-6f;
constexpr int NWAVES = 8, NTHREADS = 512;
constexpr int LDS_BYTES = 163840;

constexpr size_t OFF_YP = 0, OFF_YS = 16777216, OFF_RP = 17825792, OFF_CP = 22020096, OFF_FP = 22036480, OFF_RS = 22081536, OFF_CS = 156299264, OFF_FS = 156823552, OUT_TOTAL = 158265344;

constexpr size_t al256(size_t x) { return (x + 255) & ~(size_t)255; }
constexpr size_t WS_CTL = 0;
constexpr size_t WS_WINT = 2u << 20;
constexpr size_t WS_PRETT = WS_WINT + al256((size_t)DIN * DM * 2);
constexpr size_t WS_PCONVT = WS_PRETT + al256((size_t)DM * DVT * 2);
constexpr size_t WS_WOT = WS_PCONVT + al256((size_t)DM * DM * 2);
constexpr size_t WS_WUGT = WS_WOT + al256((size_t)DM * DM * 2);
constexpr size_t WS_WDT = WS_WUGT + al256((size_t)2 * DFF * DM * 2);
constexpr size_t WS_HN = WS_WDT + al256((size_t)DM * DFF * 2);
constexpr size_t WS_Q = WS_HN + al256((size_t)MT * DM * 2);
constexpr size_t WS_K = WS_Q + al256((size_t)MT * DM * 2);
constexpr size_t WS_VT = WS_K + al256((size_t)MT * DM * 2);
constexpr size_t WS_GR = WS_VT + al256((size_t)DVT * LDV * 2);
constexpr size_t WS_GB = WS_GR + al256((size_t)MT * DVT * 2);
constexpr size_t WS_CPR = WS_GB + al256((size_t)MT * DM * 2);
constexpr size_t WS_GA = WS_CPR + al256((size_t)MT * DM * 2);
constexpr size_t WS_GBT = WS_GA + al256((size_t)MT * DM * 2);
constexpr size_t WS_KHT = WS_GBT + al256((size_t)MT * DM * 2);
constexpr size_t WS_ARET = WS_KHT + al256((size_t)NBATCH * NH * DK * SEQ * 2);
constexpr size_t WS_ACONV = WS_ARET + al256((size_t)MT * DVT * 2);
constexpr size_t WS_MTMP = WS_ACONV + al256((size_t)MT * DM * 2);
constexpr size_t WS_MBUF = WS_MTMP + al256((size_t)MT * DM * 4);
constexpr size_t WS_MIX = WS_MBUF + al256((size_t)MT * DM * 2);
constexpr size_t WS_X1 = WS_MIX + al256((size_t)MT * DM * 4);
constexpr size_t WS_U = WS_X1 + al256((size_t)MT * DM * 4);
constexpr size_t WS_G = WS_U + al256((size_t)MT * DFF * 2);
constexpr size_t WS_AFF = WS_G + al256((size_t)MT * DFF * 2);
constexpr size_t WS_F = WS_AFF + al256((size_t)MT * DFF * 2);
constexpr size_t WS_ROPE = WS_F + al256((size_t)MT * DM * 4);
constexpr size_t WS_ST = WS_ROPE + al256((size_t)2052 * 128 * 2 * 4);
constexpr size_t WS_END = WS_ST + al256((size_t)32 * 3 * DVH * DK * 2);
constexpr size_t WS_STCNT = 16384;
constexpr size_t PART_BYTES = (size_t)32 * 272 * 8 * 8;
constexpr size_t WS_PART0 = 65536, WS_PART1 = WS_PART0 + PART_BYTES, WS_PART2 = WS_PART1 + PART_BYTES;
constexpr size_t WS_CTL_BYTES = 2u << 20;

typedef __bf16 bf16x2n_t __attribute__((ext_vector_type(2)));
__device__ __forceinline__ unsigned cvt_pk_bf16(float lo, float hi) { const f32x2 v = {lo, hi}; return __builtin_bit_cast(unsigned, __builtin_convertvector(v, bf16x2n_t)); }
__device__ __forceinline__ float bf_lo(unsigned w) { return __uint_as_float(w << 16); }
__device__ __forceinline__ float bf_hi(unsigned w) { return __uint_as_float(w & 0xffff0000u); }
__device__ __forceinline__ float bf1(bf16_t x) { return __uint_as_float((unsigned)x << 16); }
#define LDS_WAIT() asm volatile("s_waitcnt lgkmcnt(0)" ::: "memory")
#define VM_WAIT() asm volatile("s_waitcnt vmcnt(0)" ::: "memory")
#define CFENCE() asm volatile("" ::: "memory")
#define RAW_BAR() do { asm volatile("" ::: "memory"); __builtin_amdgcn_s_barrier(); asm volatile("" ::: "memory"); } while (0)
__device__ __forceinline__ float wave_sum(float v) {
#pragma unroll
    for (int o = 1; o < 64; o <<= 1) v += __shfl_xor(v, o);
    return v;
}
__device__ __forceinline__ float log2gamma(int h) {
    const float t[8] = {-0.04580368961312479f, -0.02272007650008353f, -0.011315313227834146f, -0.005646563141142063f,
                        -0.0028205190623786626f, -0.0014095702546713536f, -0.0007046129765893727f, -0.0003522634716290214f};
    float r = t[0];
#pragma unroll
    for (int i = 1; i < 8; ++i) r = (h == i) ? t[i] : r;
    return r;
}
__device__ __forceinline__ int opaque_tid() { int t = threadIdx.x; asm volatile("" : "+v"(t)); return t; }
__device__ __forceinline__ float sigmoidf_(float v) { return __builtin_amdgcn_rcpf(1.0f + __builtin_amdgcn_exp2f(v * -1.4426950408889634f)); }

struct Params { const float* in[19]; float* out; unsigned char* ws; int ph_lo, ph_hi; };

struct Frame {
    LAS unsigned char* lds;
    int wave, vcu, G;
    const Params* P;
    unsigned char* ws; float* out;
};
#define WSB(F, off) ((bf16_t*)((F).ws + (off)))
#define WSF(F, off) ((float*)((F).ws + (off)))
#define INP(F, k) ((F).P->in[k])
enum { I_XP = 0, I_XS, I_SRET, I_SCONV, I_SFFN, I_GPREMIX, I_WIN, I_CONVW, I_PRET, I_PCONV, I_WO, I_GPOSTMIX, I_GPREFFN, I_WUP, I_WGATE, I_FCW, I_FCB, I_WDOWN, I_GPOSTFFN };
__device__ __forceinline__ const float* xrow(const Frame& F, int m) { return m < MP ? INP(F, I_XP) + (size_t)m * DM : INP(F, I_XS) + (size_t)(m - MP) * DM; }

constexpr int BM = 256, BK = 64, HALF = 128, HTB = HALF * BK * 2, STAGE_BYTES = 8 * HTB;
__device__ __forceinline__ int lds_byte(int r, int c) { const int st = (r >> 4) * 2 + (c >> 5), rr = r & 15, cc = c & 31, ob = rr * 64 + cc * 2; return st * 1024 + (ob ^ (((ob >> 9) & 1) << 5)); }
__device__ __forceinline__ void stage_rc(int b, int& R, int& C) { const int st = b / 1024, sb = b % 1024, swz = sb ^ (((sb >> 9) & 1) << 5); R = (st >> 1) * 16 + swz / 64; C = (st & 1) * 32 + (swz % 64) / 2; }
__device__ __forceinline__ int perm32(int rho) { const int n = rho >> 4, i = rho & 15; return 8 * (i >> 2) + 4 * n + (i & 3); }

struct GUnit { const char* a; const char* b; const char* x; unsigned lda, ldb; int nt, kind, pm, pn; };

__device__ __forceinline__ void tile_of(int L, int nM, int nN, int& pm, int& pn) {
    const int nwg = nM * nN; int wgid = L;
    { const int q = nwg / 8, r = nwg % 8, xcd = wgid % 8, off = wgid / 8; wgid = (xcd < r ? xcd * (q + 1) : r * (q + 1) + (xcd - r) * q) + off; }
    const int nig = 4 * nN, gid = wgid / nig, fm = gid * 4, gsz = (nM - fm) < 4 ? (nM - fm) : 4;
    pm = fm + ((wgid % nig) % gsz); pn = (wgid % nig) / gsz;
}

constexpr int XA_OFF = STAGE_BYTES;
template <bool XR, class Sched, class Epi>
__device__ __forceinline__ void gemm_phase(LAS unsigned char* lds, const Sched& S, const Epi& E) {
    const int tid = threadIdx.x, wid = __builtin_amdgcn_readfirstlane(tid >> 6), lane = tid & 63, wr = wid >> 2, wc = wid & 3, fr = lane & 15, fq = lane >> 4;
    int R0, C0; stage_rc(tid * 16, R0, C0);
    const unsigned RA = (unsigned)R0, RB = (unsigned)((R0 & ~31) + perm32(R0 & 31)), C2 = (unsigned)C0 * 2u;
    const unsigned ldsw = (unsigned)wid * 1024u;
    const int aoff = lds_byte(wr * 64 + fr, fq * 8), boff = lds_byte(wc * 32 + fr, fq * 8);
    const int xoff = XA_OFF + fr * 128 + fq * 16;
#define G_SA(b, h) (((b) * 2 + (h)) * HTB)
#define G_SB(b, h) ((4 + (b) * 2 + (h)) * HTB)
#define G_STAGE(bufoff, gbase, voff, ld64) do { \
        __builtin_amdgcn_global_load_lds((const unsigned*)((const char*)(gbase) + (voff)), (LAS unsigned*)(lds + (bufoff) + ldsw), 16, 0, 0); \
        __builtin_amdgcn_global_load_lds((const unsigned*)((const char*)(gbase) + (ld64) + (voff)), (LAS unsigned*)(lds + (bufoff) + ldsw + 8192), 16, 0, 0); } while (0)
#define G_STAGEX(b, gbase, ld) do { if constexpr (XR) { int t_ = threadIdx.x; asm volatile("" : "+v"(t_));     \
        const unsigned vx_ = (unsigned)(((t_ >> 5) & 1) + 2 * wid) * (ld) + (unsigned)(t_ & 31) * 4u; \
        __builtin_amdgcn_global_load_lds((const unsigned*)((const char*)(gbase) + vx_), (LAS unsigned*)(lds + XA_OFF + (b) * 2048 + wid * 256), 4, 0, 0); } } while (0)
#define G_LDA(dst, b, h) do { _Pragma("unroll") for (int m = 0; m < 4; ++m) _Pragma("unroll") for (int k = 0; k < 2; ++k) dst[m][k] = *(const LAS bf16x8*)(lds + G_SA(b, h) + aoff + m * 2048 + k * 1024); } while (0)
#define G_LDB(dst, b, h) do { _Pragma("unroll") for (int n = 0; n < 2; ++n) _Pragma("unroll") for (int k = 0; k < 2; ++k) dst[n][k] = *(const LAS bf16x8*)(lds + G_SB(b, h) + boff + n * 2048 + k * 1024); } while (0)
#define G_LDX(b) do { if constexpr (XR) { Xf[0] = *(const LAS bf16x8*)(lds + xoff + (b) * 2048); Xf[1] = *(const LAS bf16x8*)(lds + xoff + (b) * 2048 + 64); } } while (0)
#define G_MMA(ai, bj, At, Bt) do { __builtin_amdgcn_s_setprio(1); _Pragma("unroll") for (int m = 0; m < 4; ++m) _Pragma("unroll") for (int n = 0; n < 2; ++n) _Pragma("unroll") for (int k = 0; k < 2; ++k) \
        acc[ai][bj][m][n] = __builtin_amdgcn_mfma_f32_16x16x32_bf16(Bt[n][k], At[m][k], acc[ai][bj][m][n], 0, 0, 0); __builtin_amdgcn_s_setprio(0); } while (0)
#define G_MMAX() do { if constexpr (XR) { if (wr == 0) { _Pragma("unroll") for (int n = 0; n < 2; ++n) _Pragma("unroll") for (int k = 0; k < 2; ++k) xacc[n] = __builtin_amdgcn_mfma_f32_16x16x32_bf16(B0[n][k], Xf[k], xacc[n], 0, 0, 0); } \
        else { _Pragma("unroll") for (int n = 0; n < 2; ++n) _Pragma("unroll") for (int k = 0; k < 2; ++k) xacc[n] = __builtin_amdgcn_mfma_f32_16x16x32_bf16(B1[n][k], Xf[k], xacc[n], 0, 0, 0); } } } while (0)
#define G_WAIT_V(n) asm volatile("s_waitcnt vmcnt(" #n ")" ::: "memory")
#define G_WAIT_VX(n, nx) do { if constexpr (XR) asm volatile("s_waitcnt vmcnt(" #nx ")" ::: "memory"); else asm volatile("s_waitcnt vmcnt(" #n ")" ::: "memory"); } while (0)
#define G_WAIT_L(n) asm volatile("s_waitcnt lgkmcnt(" #n ")" ::: "memory")
#define G_BAR __builtin_amdgcn_s_barrier()
#define G_SCHED __builtin_amdgcn_sched_barrier(0)
    GUnit cur, nxt; int ui = 0;
    if (!S.next(0, cur)) return;
    f32x4 acc[2][2][4][2]; f32x4 xacc[2];
#pragma unroll
    for (int a = 0; a < 2; ++a)
#pragma unroll
        for (int b = 0; b < 2; ++b)
#pragma unroll
            for (int m = 0; m < 4; ++m)
#pragma unroll
                for (int n = 0; n < 2; ++n) acc[a][b][m][n] = (f32x4){0.f, 0.f, 0.f, 0.f};
    xacc[0] = (f32x4){0.f, 0.f, 0.f, 0.f}; xacc[1] = (f32x4){0.f, 0.f, 0.f, 0.f};
    bf16x8 At[4][2], B0[2][2], B1[2][2], Xf[2];
    const char* cA = cur.a; const char* cB = cur.b; const char* cX = cur.x;
    unsigned vA = RA * cur.lda + C2, vB = RB * cur.ldb + C2; unsigned ldx = cur.lda;
    size_t hA = (size_t)HALF * cur.lda, hB = (size_t)HALF * cur.ldb;
    const size_t kstep = (size_t)(BK * 2);
    G_STAGE(G_SB(0, 0), cB, vB, hB / 2); G_STAGE(G_SB(0, 1), cB + hB, vB, hB / 2); G_STAGE(G_SA(0, 0), cA, vA, hA / 2); G_STAGE(G_SA(0, 1), cA + hA, vA, hA / 2); G_STAGEX(0, cX, ldx);
    if (wr == 1) G_BAR;
    G_WAIT_VX(2, 3); G_BAR;
    G_STAGE(G_SB(1, 0), cB + kstep, vB, hB / 2); G_STAGE(G_SA(1, 0), cA + kstep, vA, hA / 2); G_STAGE(G_SB(1, 1), cB + hB + kstep, vB, hB / 2);
    G_WAIT_V(6); G_BAR;
    for (;;) {
        const bool has_next = S.next(ui + 1, nxt);
        const char* nA = has_next ? nxt.a : cA; const char* nB = has_next ? nxt.b : cB; const char* nX = has_next ? nxt.x : cX;
        const unsigned nlda = has_next ? nxt.lda : cur.lda, nldb = has_next ? nxt.ldb : cur.ldb;
        const unsigned nvA = RA * nlda + C2, nvB = RB * nldb + C2;
        const size_t nhA = (size_t)HALF * nlda, nhB = (size_t)HALF * nldb;
        const int nt = cur.nt;
        for (int t = 0; t < nt; t += 2) {
            const bool last = (t == nt - 2);
            const char* a1 = cA + (size_t)(t + 1) * kstep; const char* x1 = cX + (size_t)(t + 1) * kstep;
            const char* a2 = last ? nA : cA + (size_t)(t + 2) * kstep; const char* b2 = last ? nB : cB + (size_t)(t + 2) * kstep; const char* x2 = last ? nX : cX + (size_t)(t + 2) * kstep;
            const unsigned vA2 = last ? nvA : vA, vB2 = last ? nvB : vB, ldx2 = last ? nlda : ldx;
            const size_t hA2 = last ? nhA : hA, hB2 = last ? nhB : hB;
            const char* a3 = a2 + kstep; const char* b3 = b2 + kstep;
            G_LDB(B0, 0, 0); G_LDB(B1, 0, 1); G_SCHED; G_LDA(At, 0, 0); G_STAGE(G_SA(1, 1), a1 + hA, vA, hA / 2); G_STAGEX(1, x1, ldx);
            G_WAIT_VX(8, 9); G_WAIT_L(0); G_BAR; G_MMA(0, 0, At, B0); G_MMA(0, 1, At, B1); G_BAR; G_SCHED;
            G_LDA(At, 0, 1); G_LDX(0); G_STAGE(G_SB(0, 0), b2, vB2, hB2 / 2); G_STAGE(G_SB(0, 1), b2 + hB2, vB2, hB2 / 2); G_STAGE(G_SA(0, 0), a2, vA2, hA2 / 2);
            G_WAIT_VX(8, 9); G_WAIT_L(0); G_BAR; G_MMA(1, 0, At, B0); G_MMA(1, 1, At, B1); G_MMAX(); G_BAR; G_SCHED;
            G_LDB(B0, 1, 0); G_LDB(B1, 1, 1); G_SCHED; G_LDA(At, 1, 0); G_STAGE(G_SA(0, 1), a2 + hA2, vA2, hA2 / 2); G_STAGEX(0, x2, ldx2);
            G_WAIT_VX(8, 9); G_WAIT_L(0); G_BAR; G_MMA(0, 0, At, B0); G_MMA(0, 1, At, B1); G_BAR; G_SCHED;
            G_LDA(At, 1, 1); G_LDX(1); G_STAGE(G_SB(1, 0), b3, vB2, hB2 / 2); G_STAGE(G_SB(1, 1), b3 + hB2, vB2, hB2 / 2); G_STAGE(G_SA(1, 0), a3, vA2, hA2 / 2);
            G_WAIT_VX(8, 9); G_WAIT_L(0); G_BAR; G_MMA(1, 0, At, B0); G_MMA(1, 1, At, B1); G_MMAX(); G_BAR; G_SCHED;
        }
        if (wr == 0) G_BAR;
        { int fre = fr, fqe = fq; asm volatile("" : "+v"(fre), "+v"(fqe));
          bool tiled = false;
          if constexpr (Epi::HAS_TILE) { if (E.is_tile(cur)) { tiled = true; E.tile(cur, acc, xacc, lds, wr, wc, fre, fqe); } }
          if (!tiled) {
              constexpr int NBJ = Epi::NBJ;
#pragma unroll
              for (int ai = 0; ai < 2; ++ai)
#pragma unroll
                  for (int b0 = 0; b0 < 2; b0 += NBJ) {
                      typename Epi::Pre pre[4][NBJ];
#pragma unroll
                      for (int m = 0; m < 4; ++m)
#pragma unroll
                          for (int bb = 0; bb < NBJ; ++bb) pre[m][bb] = E.pre(cur, cur.pm * BM + ai * HALF + wr * 64 + m * 16 + fre, (b0 + bb) * HALF + wc * 32 + 8 * fqe);
#pragma unroll
                      for (int m = 0; m < 4; ++m)
#pragma unroll
                          for (int bb = 0; bb < NBJ; ++bb) E.row(cur, cur.pm * BM + ai * HALF + wr * 64 + m * 16 + fre, (b0 + bb) * HALF + wc * 32 + 8 * fqe, acc[ai][b0 + bb][m][0], acc[ai][b0 + bb][m][1], pre[m][bb]);
                      CFENCE();
                  }
              if constexpr (XR) { const typename Epi::Pre px = E.pre(cur, MP + 16 * cur.pm + fre, wr * HALF + wc * 32 + 8 * fqe); E.row(cur, MP + 16 * cur.pm + fre, wr * HALF + wc * 32 + 8 * fqe, xacc[0], xacc[1], px); }
          } }
        if (!has_next) break;
#pragma unroll
        for (int a = 0; a < 2; ++a)
#pragma unroll
            for (int b = 0; b < 2; ++b)
#pragma unroll
                for (int m = 0; m < 4; ++m)
#pragma unroll
                    for (int n = 0; n < 2; ++n) acc[a][b][m][n] = (f32x4){0.f, 0.f, 0.f, 0.f};
        xacc[0] = (f32x4){0.f, 0.f, 0.f, 0.f}; xacc[1] = (f32x4){0.f, 0.f, 0.f, 0.f};
        cur = nxt; cA = nA; cB = nB; cX = nX; vA = nvA; vB = nvB; ldx = nlda; hA = nhA; hB = nhB; ++ui;
        if (wr == 1) G_BAR;
    }
    G_WAIT_V(0);
    G_BAR;
    CFENCE();
#undef G_SA
#undef G_SB
#undef G_STAGE
#undef G_STAGEX
#undef G_LDA
#undef G_LDB
#undef G_LDX
#undef G_MMA
#undef G_MMAX
#undef G_WAIT_V
#undef G_WAIT_VX
#undef G_WAIT_L
#undef G_BAR
#undef G_SCHED
}

enum { K_ROTQ = 0, K_ROTK, K_SILU, K_PLAIN, K_PROD, K_SIGA, K_SIGB, K_VT, K_YA, K_YB, K_RETP, K_MIX, K_UP, K_GATE, K_DOWN, K_STATE };

__device__ __forceinline__ u32x4 pack8(f32x4 a, f32x4 b) { u32x4 w; w.x = cvt_pk_bf16(a[0], a[1]); w.y = cvt_pk_bf16(a[2], a[3]); w.z = cvt_pk_bf16(b[0], b[1]); w.w = cvt_pk_bf16(b[2], b[3]); return w; }
__device__ __forceinline__ void unpack8(u32x4 w, f32x4& a, f32x4& b) { a = (f32x4){bf_lo(w.x), bf_hi(w.x), bf_lo(w.y), bf_hi(w.y)}; b = (f32x4){bf_lo(w.z), bf_hi(w.z), bf_lo(w.w), bf_hi(w.w)}; }
#define GP(T, base, byteoff) ((T*)((char*)(base) + (unsigned)(byteoff)))
#define GPC(T, base, byteoff) ((const T*)((const char*)(base) + (unsigned)(byteoff)))

struct Epi1 {
    static constexpr bool HAS_TILE = false; static constexpr int NBJ = 2;
    bf16_t *Q, *K, *GR, *GB, *CPR, *GA, *GBT, *VT; const float* rope; float* out;
    struct Pre {};
    __device__ __forceinline__ Pre pre(const GUnit& u, int row, int lc) const { return Pre{}; }
    __device__ __forceinline__ void row(const GUnit& u, int row, int lc, const f32x4 v0, const f32x4 v1, const Pre& pr_) const {
        const int kind = u.kind;
        if (kind == K_ROTQ || kind == K_ROTK) {
            bf16_t* dst = ((kind == K_ROTQ) ? Q : K) + (u.pn & 7) * 256; const float sc = (kind == K_ROTQ) ? 1.0f : 0.0625f;
            const int pidx = row < MP ? (row & (SEQ - 1)) : SEQ + ((row - MP) & 3);
            const f32x4 c01 = *GPC(f32x4, rope, (pidx * 128 + (lc >> 1)) * 8), c23 = *GPC(f32x4, rope, (pidx * 128 + (lc >> 1)) * 8 + 16);
            f32x4 o0, o1;
            o0[0] = (v0[0] * c01[0] - v0[1] * c01[1]) * sc; o0[1] = (v0[1] * c01[0] + v0[0] * c01[1]) * sc;
            o0[2] = (v0[2] * c01[2] - v0[3] * c01[3]) * sc; o0[3] = (v0[3] * c01[2] + v0[2] * c01[3]) * sc;
            o1[0] = (v1[0] * c23[0] - v1[1] * c23[1]) * sc; o1[1] = (v1[1] * c23[0] + v1[0] * c23[1]) * sc;
            o1[2] = (v1[2] * c23[2] - v1[3] * c23[3]) * sc; o1[3] = (v1[3] * c23[2] + v1[2] * c23[3]) * sc;
            *GP(u32x4, dst, (row * DM + lc) * 2) = pack8(o0, o1);
            CFENCE();
        } else if (kind == K_SILU) {
            f32x4 o0, o1;
#pragma unroll
            for (int j = 0; j < 4; ++j) { o0[j] = v0[j] * sigmoidf_(v0[j]); o1[j] = v1[j] * sigmoidf_(v1[j]); }
            *GP(u32x4, GR + (u.pn - 32) * 256, (row * DVT + lc) * 2) = pack8(o0, o1);
        } else if (kind == K_PLAIN) {
            *GP(u32x4, GB + (u.pn - 48) * 256, (row * DM + lc) * 2) = pack8(v0, v1);
        } else if (kind == K_SIGA || kind == K_SIGB) {
            bf16_t* dst = (kind == K_SIGA) ? GA + (u.pn - 72) * 256 : GBT + (u.pn - 80) * 256;
            f32x4 o0, o1;
#pragma unroll
            for (int j = 0; j < 4; ++j) { o0[j] = sigmoidf_(v0[j]); o1[j] = sigmoidf_(v1[j]); }
            __builtin_nontemporal_store(pack8(o0, o1), GP(u32x4, dst, (row * DM + lc) * 2));
        } else if (kind == K_PROD) {
            const int col = (u.pn - 56) * 128 + (lc >> 1);
            const f32x4 pr = (f32x4){v0[0] * v0[1], v0[2] * v0[3], v1[0] * v1[1], v1[2] * v1[3]};
            u32x2 w; w.x = cvt_pk_bf16(pr[0], pr[1]); w.y = cvt_pk_bf16(pr[2], pr[3]);
            *GP(u32x2, CPR, (row * DM + col) * 2) = w;
            if (row < MP) { const int t = row & (SEQ - 1); if (t >= SEQ - 2) *GP(f32x4, out + OFF_CP, (((row >> 11) * 2 + (t - (SEQ - 2))) * DM + col) * 4) = pr; }
            else { const int ms = row - MP, t = ms & 3; if (t >= 2) *GP(f32x4, out + OFF_CS, (((ms >> 2) * 2 + (t - 2)) * DM + col) * 4) = pr; }
        } else {
            *GP(u32x4, VT, (row * LDV + u.pn * BM + lc) * 2) = pack8(v0, v1);
        }
    }
};

struct Epi3 {
    static constexpr bool HAS_TILE = false; static constexpr int NBJ = 1;
    const bf16_t *GA, *GBT; float* MTMP; bf16_t* MBUF;
    struct Pre { u32x4 g; f32x4 t0, t1; };
    __device__ __forceinline__ Pre pre(const GUnit& u, int row, int lc) const {
        const unsigned off = (unsigned)(row * DM + u.pn * BM + lc);
        Pre p; p.t0 = (f32x4){0.f, 0.f, 0.f, 0.f}; p.t1 = p.t0;
        if (u.kind == K_YA) p.g = __builtin_nontemporal_load(GPC(u32x4, GA, off * 2));
        else { p.g = __builtin_nontemporal_load(GPC(u32x4, GBT, off * 2)); p.t0 = *GPC(f32x4, MTMP, off * 4); p.t1 = *GPC(f32x4, MTMP, off * 4 + 16); }
        return p;
    }
    __device__ __forceinline__ void row(const GUnit& u, int row, int lc, const f32x4 v0, const f32x4 v1, const Pre& p) const {
        const unsigned off = (unsigned)(row * DM + u.pn * BM + lc);
        f32x4 g0, g1; unpack8(p.g, g0, g1);
        if (u.kind == K_YA) { *GP(f32x4, MTMP, off * 4) = v0 * g0; *GP(f32x4, MTMP, off * 4 + 16) = v1 * g1; }
        else *GP(u32x4, MBUF, off * 2) = pack8(p.t0 + v0 * g0, p.t1 + v1 * g1);
    }
};

struct EpiB16 {
    static constexpr bool HAS_TILE = false; static constexpr int NBJ = 2;
    bf16_t* C;
    struct Pre {};
    __device__ __forceinline__ Pre pre(const GUnit& u, int row, int lc) const { return Pre{}; }
    __device__ __forceinline__ void row(const GUnit& u, int row, int lc, const f32x4 v0, const f32x4 v1, const Pre&) const {
        *GP(u32x4, C, (unsigned)(row * DM + u.pn * BM + lc) * 2u) = pack8(v0, v1);
    }
};

constexpr int LDS_RED = 139264;
template <class ACC, class XACC>
__device__ __forceinline__ void panel_rstd(LAS unsigned char* lds, unsigned long long* part, int pm, int pn, ACC& acc, XACC& xacc, int wr, int wc, int fr, int fq) {
    LAS float* red = (LAS float*)(lds + LDS_RED);
#pragma unroll
    for (int ai = 0; ai < 2; ++ai)
#pragma unroll
        for (int m = 0; m < 4; ++m) { float sq = 0.f;
#pragma unroll
            for (int bj = 0; bj < 2; ++bj)
#pragma unroll
                for (int n = 0; n < 2; ++n) { const f32x4 v = acc[ai][bj][m][n]; sq += (v[0] * v[0] + v[1] * v[1]) + (v[2] * v[2] + v[3] * v[3]); }
            sq += __shfl_xor(sq, 16); sq += __shfl_xor(sq, 32);
            if (fq == 0) red[wc * 256 + ai * HALF + wr * 64 + m * 16 + fr] = sq; }
    { float sq = 0.f;
#pragma unroll
      for (int n = 0; n < 2; ++n) { const f32x4 v = xacc[n]; sq += (v[0] * v[0] + v[1] * v[1]) + (v[2] * v[2] + v[3] * v[3]); }
      sq += __shfl_xor(sq, 16); sq += __shfl_xor(sq, 32);
      if (fq == 0) red[1024 + (wr * 4 + wc) * 16 + fr] = sq; }
    LDS_WAIT(); RAW_BAR();
    { const int t = opaque_tid();
      if (t < 272) {
          float tot;
          if (t < 256) tot = (red[t] + red[256 + t]) + (red[512 + t] + red[768 + t]);
          else { tot = 0.f;
#pragma unroll
              for (int w = 0; w < 8; ++w) tot += red[1024 + w * 16 + (t - 256)]; }
          unsigned long long* pw = part + ((size_t)(pm * 272 + t)) * 8;
          __hip_atomic_store(pw + pn, ((unsigned long long)1u << 32) | (unsigned long long)__float_as_uint(tot), __ATOMIC_RELAXED, __HIP_MEMORY_SCOPE_AGENT);
          unsigned long long w[8]; unsigned sp = 0;
          for (;;) {
              bool ok = true;
#pragma unroll
              for (int k = 0; k < 8; ++k) w[k] = __hip_atomic_load(pw + k, __ATOMIC_RELAXED, __HIP_MEMORY_SCOPE_AGENT);
#pragma unroll
              for (int k = 0; k < 8; ++k) ok = ok && ((unsigned)(w[k] >> 32) == 1u);
              if (ok || ++sp > (1u << 22)) break;
              __builtin_amdgcn_s_sleep(1); }
          float sum = 0.f;
#pragma unroll
          for (int k = 0; k < 8; ++k) sum += __uint_as_float((unsigned)w[k]);
          red[1280 + t] = rsqrtf(sum * (1.0f / DM) + EPS);
      } }
    LDS_WAIT(); RAW_BAR();
}

struct Epi8 {
    static constexpr bool HAS_TILE = true;
    const float* X1; float* Y; const float* g; unsigned long long* part;
    static constexpr int NBJ = 2;
    struct Pre {};
    __device__ __forceinline__ Pre pre(const GUnit& u, int row, int lc) const { return Pre{}; }
    __device__ __forceinline__ bool is_tile(const GUnit& u) const { return true; }
    __device__ __forceinline__ void row(const GUnit& u, int row, int lc, const f32x4 v0, const f32x4 v1, const Pre&) const {}
    template <class ACC, class XACC>
    __device__ __forceinline__ void tile(const GUnit& u, ACC& acc, XACC& xacc, LAS unsigned char* lds, int wr, int wc, int fr, int fq) const {
        f32x4 xa[2][4], xb[2][4];
#define E8_LOAD(buf, bj_, ai_) do { _Pragma("unroll") for (int m = 0; m < 4; ++m) { const unsigned o_ = (unsigned)(((u.pm * BM + (ai_) * HALF + wr * 64 + fr + 16 * m) * DM + u.pn * BM + (bj_) * HALF + wc * 32 + 8 * fq) * 4); \
            xa[buf][m] = __builtin_nontemporal_load(GPC(f32x4, X1, o_)); xb[buf][m] = __builtin_nontemporal_load(GPC(f32x4, X1, o_ + 16)); } } while (0)
        E8_LOAD(0, 0, 0);
        panel_rstd(lds, part, u.pm, u.pn, acc, xacc, wr, wc, fr, fq);
        const LAS float* rs = (const LAS float*)(lds + LDS_RED) + 1280;
#pragma unroll
        for (int bt = 0; bt < 4; ++bt) { const int bj = bt >> 1, ai = bt & 1, buf = bt & 1;
            if (bt < 3) { if (buf == 0) E8_LOAD(1, (bt + 1) >> 1, (bt + 1) & 1); else E8_LOAD(0, (bt + 1) >> 1, (bt + 1) & 1); }
            const int col = u.pn * BM + bj * HALF + wc * 32 + 8 * fq;
            const f32x4 g0 = *(const f32x4*)(g + col), g1 = *(const f32x4*)(g + col + 4);
            const int rl0 = ai * HALF + wr * 64 + fr;
#pragma unroll
            for (int m = 0; m < 4; ++m) { const unsigned o = (unsigned)(((u.pm * BM + rl0 + 16 * m) * DM + col) * 4); const float r = rs[rl0 + 16 * m];
                __builtin_nontemporal_store(xa[buf][m] + acc[ai][bj][m][0] * r * g0, GP(f32x4, Y, o)); __builtin_nontemporal_store(xb[buf][m] + acc[ai][bj][m][1] * r * g1, GP(f32x4, Y, o + 16)); }
        }
#undef E8_LOAD
        {
            const int col = u.pn * BM + wr * HALF + wc * 32 + 8 * fq; const unsigned o = (unsigned)(((MP + 16 * u.pm + fr) * DM + col) * 4);
            const f32x4 g0 = *(const f32x4*)(g + col), g1 = *(const f32x4*)(g + col + 4); const float r = rs[256 + fr];
            const f32x4 xa = __builtin_nontemporal_load(GPC(f32x4, X1, o)), xb = __builtin_nontemporal_load(GPC(f32x4, X1, o + 16));
            __builtin_nontemporal_store(xa + xacc[0] * r * g0, GP(f32x4, Y, o)); __builtin_nontemporal_store(xb + xacc[1] * r * g1, GP(f32x4, Y, o + 16));
        }
    }
};

struct EpiState {
    static constexpr bool HAS_TILE = false; static constexpr int NBJ = 2;
    bf16_t* ST;
    struct Pre {};
    __device__ __forceinline__ Pre pre(const GUnit& u, int row, int lc) const { return Pre{}; }
    __device__ __forceinline__ void row(const GUnit& u, int row, int lc, const f32x4 v0, const f32x4 v1, const Pre&) const {
        const int bh = u.pm, pe = u.pn & 1, sg = u.pn >> 4, rl = row - bh * BM;
        const float sc = __builtin_amdgcn_exp2f(-log2gamma(bh & 7) * (float)(SEQ - 512 * sg));
        *GP(u32x4, ST, ((((bh * 3 + (sg - 1)) * DVH + pe * BM + rl) * DK) + lc) * 2) = pack8(v0 * sc, v1 * sc);
    }
};

__device__ __forceinline__ unsigned dpp_ror1(unsigned v) { return (unsigned)__builtin_amdgcn_update_dpp(0, (int)v, 0x121, 0xf, 0xf, false); }
__device__ __forceinline__ unsigned dpp_ror2(unsigned v) { return (unsigned)__builtin_amdgcn_update_dpp(0, (int)v, 0x122, 0xf, 0xf, false); }
struct Epi6 {
    static constexpr bool HAS_TILE = true;
    bf16_t *U, *GG; float* out; const bf16_t* ST; bf16_t* AFF; const float *fcw, *fcb;
    __device__ __forceinline__ bool is_tile(const GUnit& u) const { return u.kind == K_GATE; }
    template <class ACC, class XACC>
    __device__ __forceinline__ void tile(const GUnit& u, ACC& acc, XACC& xacc, LAS unsigned char* lds, int wr, int wc, int fr, int fq) const {
        const bool f15 = fr == 15, f14 = fr >= 14;
#pragma unroll
        for (int bj = 0; bj < 2; ++bj) {
            const int col = (u.pn - 22) * BM + bj * HALF + wc * 32 + 8 * fq;
            f32x2 w0[4], w1[4], w2[4], bb[4];
            { const float* cw = fcw + col; const float* cb = fcb + col;
#pragma unroll
              for (int j = 0; j < 4; ++j) { w0[j] = *(const f32x2*)(cw + 2 * j); w1[j] = *(const f32x2*)(cw + DFF + 2 * j); w2[j] = *(const f32x2*)(cw + 2 * DFF + 2 * j); bb[j] = *(const f32x2*)(cb + 2 * j); } }
#pragma unroll
            for (int ai = 0; ai < 2; ++ai) {
                const int rb = u.pm * BM + ai * HALF + wr * 64 + fr;
                u32x4 blk[5];
#pragma unroll
                for (int mm = 0; mm < 5; ++mm) { int r = rb + 16 * (mm - 1); r = r < 0 ? 0 : r; blk[mm] = *GPC(u32x4, U, (r * DFF + col) * 2); }
#pragma unroll
                for (int m = 0; m < 4; ++m) {
                    const int row = rb + 16 * m;
                    const u32x4 c0 = blk[m + 1], pv = blk[m];
                    const f32x4 g0 = acc[ai][bj][m][0], g1 = acc[ai][bj][m][1];
                    f32x4 o0, o1;
#pragma unroll
                    for (int j = 0; j < 4; ++j) {
                        const unsigned q1 = dpp_ror1(f15 ? pv[j] : c0[j]), q2 = dpp_ror2(f14 ? pv[j] : c0[j]);
                        const f32x2 x0 = (f32x2){bf_lo(c0[j]), bf_hi(c0[j])}, x1 = (f32x2){bf_lo(q1), bf_hi(q1)}, x2 = (f32x2){bf_lo(q2), bf_hi(q2)};
                        const f32x2 v = w0[j] * x2 + (w1[j] * x1 + (w2[j] * x0 + bb[j]));
                        const f32x2 z = v * (v * v * (-2.3022082f * 0.044715f) + (-2.3022082f));
                        f32x2 e; e[0] = __builtin_amdgcn_exp2f(z[0]); e[1] = __builtin_amdgcn_exp2f(z[1]);
                        const f32x2 d = e + 1.0f; f32x2 r; r[0] = __builtin_amdgcn_rcpf(d[0]); r[1] = __builtin_amdgcn_rcpf(d[1]);
                        const f32x2 gg = j < 2 ? (f32x2){g0[2 * (j & 1)], g0[2 * (j & 1) + 1]} : (f32x2){g1[2 * (j & 1)], g1[2 * (j & 1) + 1]};
                        const f32x2 o = v * r * gg;
                        if (j < 2) { o0[2 * (j & 1)] = o[0]; o0[2 * (j & 1) + 1] = o[1]; } else { o1[2 * (j & 1)] = o[0]; o1[2 * (j & 1) + 1] = o[1]; }
                    }
                    *GP(u32x4, AFF, (row * DFF + col) * 2) = pack8(o0, o1);
                    const bool fix = row < MP ? (row & 255) < 2 : ((row - MP) & 3) < 2;
                    if (fix) *GP(u32x4, GG, (row * DFF + col) * 2) = pack8(g0, g1);
                }
            }
        }
    }
    static constexpr int NBJ = 2;
    struct Pre { u32x4 st; };
    __device__ __forceinline__ Pre pre(const GUnit& u, int row, int lc) const {
        Pre p; p.st = (u32x4){0u, 0u, 0u, 0u};
        if (u.kind == K_RETP) p.st = *GPC(u32x4, ST, ((((u.pm * 3 + 2) * DVH + u.pn * BM + (row - u.pm * BM)) * DK) + lc) * 2);
        return p;
    }
    __device__ __forceinline__ void row(const GUnit& u, int row, int lc, const f32x4 v0, const f32x4 v1, const Pre& p) const {
        if (u.kind == K_UP) {
            const int col = u.pn * BM + lc;
            *GP(u32x4, U, (row * DFF + col) * 2) = pack8(v0, v1);
            if (row < MP) { const int t = row & (SEQ - 1); if (t >= SEQ - 2) { const unsigned o = (unsigned)((((row >> 11) * 2 + (t - (SEQ - 2))) * DFF + col) * 4); *GP(f32x4, out + OFF_FP, o) = v0; *GP(f32x4, out + OFF_FP, o + 16) = v1; } }
            else { const int ms = row - MP, t = ms & 3; if (t >= 2) { const unsigned o = (unsigned)((((ms >> 2) * 2 + (t - 2)) * DFF + col) * 4); *GP(f32x4, out + OFF_FS, o) = v0; *GP(f32x4, out + OFF_FS, o + 16) = v1; } }
        } else {
            const int e = u.pn * BM + (row - u.pm * BM);
            const float g512 = __builtin_amdgcn_exp2f(log2gamma(u.pm & 7) * 512.0f);
            f32x4 s0, s1; unpack8(p.st, s0, s1);
            const f32x4 a = v0 + s0 * g512, b = v1 + s1 * g512;
            float* ob = out + OFF_RP + (size_t)u.pm * DK * DVH;
#pragma unroll
            for (int j = 0; j < 4; ++j) { const int d0 = lc + j, d1 = lc + 4 + j;
                __builtin_nontemporal_store(a[j], GP(float, ob, (((d0 >> 1) + 128 * (d0 & 1)) * DVH + e) * 4)); __builtin_nontemporal_store(b[j], GP(float, ob, (((d1 >> 1) + 128 * (d1 & 1)) * DVH + e) * 4)); }
        }
    }
};

struct Sched1 {
    const char *HN, *WINT; int G, c;
    __device__ __forceinline__ bool next(int i, GUnit& u) const {
        const int L = i * G + c; if (L >= 2992) return false;
        const bool mainp = L < 2448;
        int pm, pn; tile_of(mainp ? L : L - 2448, mainp ? 34 : 16, mainp ? 72 : 34, pm, pn);
        const int t = pn < 16 ? pn : pn + 16;
        const char* am = HN + (size_t)pm * (256 * 4096); const char* bm = WINT + (size_t)t * (256 * 4096);
        const char* av = WINT + (size_t)(16 + pm) * (256 * 4096); const char* bv = HN + (size_t)pn * (256 * 4096);
        const int km = t < 8 ? K_ROTQ : t < 16 ? K_ROTK : t < 48 ? K_SILU : t < 56 ? K_PLAIN : t < 72 ? K_PROD : t < 80 ? K_SIGA : K_SIGB;
        GUnit r; r.a = mainp ? am : av; r.b = mainp ? bm : bv; r.x = r.a; r.lda = 4096; r.ldb = 4096; r.nt = 32; r.kind = mainp ? km : K_VT; r.pm = pm; r.pn = mainp ? t : pn;
        u = r; return true;
    }
};
struct Sched3 {
    const char *ARET, *PRETT, *ACONV, *PCONVT; int G, c;
    __device__ __forceinline__ bool next(int i, GUnit& u) const {
        const int L = (i >> 1) * G + c, sub = i & 1; if (L >= 256) return false;
        int pm, pn; tile_of(L, 32, 8, pm, pn);
        GUnit r;
        r.a = sub ? ACONV + (size_t)pm * (256 * 4096) : ARET + (size_t)pm * (256 * 8192);
        r.x = sub ? ACONV + (size_t)(MP + 16 * pm) * 4096 : ARET + (size_t)(MP + 16 * pm) * 8192;
        r.b = sub ? PCONVT + (size_t)pn * (256 * 4096) : PRETT + (size_t)pn * (256 * 8192);
        r.lda = sub ? 4096u : 8192u; r.ldb = r.lda; r.nt = sub ? 32 : 64; r.kind = sub ? K_YB : K_YA; r.pm = pm; r.pn = pn;
        u = r; return true;
    }
};
struct SchedX {
    const char *A, *B; int nt, G, c, kind;
    __device__ __forceinline__ bool next(int i, GUnit& u) const {
        const int L = i * G + c; if (L >= 256) return false;
        int pm, pn; tile_of(L, 32, 8, pm, pn);
        const unsigned ld = (unsigned)nt * 128u;
        GUnit r; r.a = A + (size_t)pm * 256 * ld; r.x = A + (size_t)(MP + 16 * pm) * ld; r.b = B + (size_t)pn * 256 * ld; r.lda = ld; r.ldb = ld; r.nt = nt; r.pm = pm; r.pn = pn; r.kind = kind;
        u = r; return true;
    }
};
struct SchedSimple {
    const char *A, *B; int nN, nt, G, c, kind_split, kind_lo, kind_hi;
    __device__ __forceinline__ bool next(int i, GUnit& u) const {
        const int L = i * G + c; if (L >= 34 * nN) return false;
        int pm, pn; tile_of(L, 34, nN, pm, pn);
        const unsigned ld = (unsigned)nt * 128u;
        GUnit r; r.a = A + (size_t)pm * 256 * ld; r.x = r.a; r.b = B + (size_t)pn * 256 * ld; r.lda = ld; r.ldb = ld; r.nt = nt; r.pm = pm; r.pn = pn; r.kind = pn < kind_split ? kind_lo : kind_hi;
        u = r; return true;
    }
};
struct Sched6 {
    const char *A, *B, *KHT, *VT; int G, c;
    __device__ __forceinline__ bool next(int i, GUnit& u) const {
        const int q = (i >> 1) * G + c, sub = i & 1; const bool tile = q < 748;
        const int je = (G == 256) ? ((c >= 236 && i >= 4) ? (i - 4) * 20 + (c - 236) : 64) : (q - 748) * 2 + sub;
        const int j = tile ? 0 : je;
        if (j >= 64) return false;
        int pm, pn; tile_of(tile ? q : 0, 34, 22, pm, pn);
        pn += 22 * sub;
        const int bh = j >> 1, pe = j & 1, b = bh >> 3, h = bh & 7;
        GUnit r;
        r.a = tile ? A + (size_t)pm * (256 * 4096) : VT + ((size_t)(h * DVH + pe * 256) * LDV + (size_t)b * SEQ + (SEQ - 512)) * 2; r.x = r.a;
        r.b = tile ? B + (size_t)pn * (256 * 4096) : KHT + (size_t)bh * (DK * SEQ * 2) + (SEQ - 512) * 2;
        r.lda = tile ? 4096u : (unsigned)(LDV * 2); r.ldb = 4096u; r.nt = tile ? 32 : 8; r.kind = tile ? (sub ? K_GATE : K_UP) : K_RETP; r.pm = tile ? pm : bh; r.pn = tile ? pn : pe;
        u = r; return true;
    }
};
struct SchedState {
    const char *KHT, *VT; int c;
    __device__ __forceinline__ bool next(int i, GUnit& u) const {
        if (i != 0 || c >= 192) return false;
        const int sg = 3 - (c >> 6), k = c & 63, bh = k >> 1, pe = k & 1, b = bh >> 3, h = bh & 7;
        GUnit r; r.a = VT + ((size_t)(h * DVH + pe * 256) * LDV + (size_t)b * SEQ) * 2; r.x = r.a; r.b = KHT + (size_t)bh * (DK * SEQ * 2);
        r.lda = (unsigned)(LDV * 2); r.ldb = (unsigned)(SEQ * 2); r.nt = 8 * sg; r.kind = K_STATE; r.pm = bh; r.pn = pe | (sg << 4);
        u = r; return true;
    }
};
#define XB_TMO      128
#define XB_XCNT(j)  (256  + 64 * (j))
#define XB_XSUB(j)  (1280 + 64 * (j))
#define XB_XGEN(j)  (2304 + 64 * (j))
#define XB_TOP      3328
#define XB_TOPGEN   3392
#define XCD_BAR_WORDS 3456
#define XB_SPIN_CAP (1u << 18)
__device__ __forceinline__ unsigned xb_ld(unsigned* p)              { return __hip_atomic_load(p, __ATOMIC_RELAXED, __HIP_MEMORY_SCOPE_AGENT); }
__device__ __forceinline__ unsigned xb_add(unsigned* p, unsigned v) { return __hip_atomic_fetch_add(p, v, __ATOMIC_RELAXED, __HIP_MEMORY_SCOPE_AGENT); }
__device__ __forceinline__ unsigned xb_xcc_id() { return (unsigned)__builtin_amdgcn_s_getreg((3 << 11) | 20) & 0xFu; }
#define XB_SPIN(cond, bar) do { unsigned _sp = 0; while (cond) { __builtin_amdgcn_s_sleep(1); \
    if ((++_sp & 255u) == 0u) { if (xb_ld(&(bar)[XB_TMO])) break; if (_sp > XB_SPIN_CAP) { atomicAdd(&(bar)[XB_TMO], 1u); break; } } } } while (0)
struct XcdBarrier { unsigned* bar; unsigned x; volatile LAS unsigned* st; };
__device__ __forceinline__ XcdBarrier xcd_barrier_post(unsigned* bar, volatile LAS unsigned* st) {
    XcdBarrier b; b.bar = bar; b.x = xb_xcc_id(); b.st = st;
    if (threadIdx.x == 0) (void)xb_add(&bar[XB_XCNT(b.x)], 1u);
    return b;
}
__device__ __forceinline__ void xcd_barrier_complete(unsigned* bar, unsigned x, unsigned& nloc, unsigned& nx) {
    const unsigned G = gridDim.x * gridDim.y * gridDim.z;
    unsigned sum, cnt, mine, sp = 0u;
    for (;;) {
        sum = 0u; cnt = 0u; mine = 0u;
#pragma unroll
        for (unsigned j = 0; j < 16; ++j) { const unsigned c = xb_ld(&bar[XB_XCNT(j)]); sum += c; cnt += (c > 0u) ? 1u : 0u; mine = (j == x) ? c : mine; }
        if (sum == G) break;
        __builtin_amdgcn_s_sleep(1);
        if ((++sp & 255u) == 0u) { if (xb_ld(&bar[XB_TMO])) break; if (sp > XB_SPIN_CAP) { atomicAdd(&bar[XB_TMO], 1u); break; } }
    }
    nloc = mine > 0u ? mine : 1u; nx = cnt > 0u ? cnt : 1u;
}
__device__ __forceinline__ void xcd_barrier(const XcdBarrier& b) {
    asm volatile("s_waitcnt vmcnt(0)" ::: "memory");
    __syncthreads();
    if (threadIdx.x == 0) {
        unsigned* bar = b.bar;
        __builtin_amdgcn_s_waitcnt(0);
        unsigned nloc = b.st[0], nx = b.st[1];
        if (nloc == 0u) { xcd_barrier_complete(bar, b.x, nloc, nx); b.st[0] = nloc; b.st[1] = nx; }
        const unsigned old = xb_add(&bar[XB_XSUB(b.x)], 1u);
        const unsigned gen = old / nloc;
        if (old + 1u == (gen + 1u) * nloc) {
            __builtin_amdgcn_fence(__ATOMIC_RELEASE, "agent");
            asm volatile("s_waitcnt vmcnt(0)" ::: "memory");
            const unsigned og = xb_add(&bar[XB_TOP], 1u);
            const unsigned tg = og / nx;
            if (og + 1u == (tg + 1u) * nx) xb_add(&bar[XB_TOPGEN], 1u);
            else XB_SPIN(xb_ld(&bar[XB_TOPGEN]) == tg, bar);
            __builtin_amdgcn_fence(__ATOMIC_ACQUIRE, "agent");
            xb_add(&bar[XB_XGEN(b.x)], 1u);
            asm volatile("s_waitcnt vmcnt(0)" ::: "memory");
        } else {
            XB_SPIN(xb_ld(&bar[XB_XGEN(b.x)]) == gen, bar);
            __builtin_amdgcn_fence(__ATOMIC_ACQUIRE, "agent");
            asm volatile("s_waitcnt vmcnt(0)" ::: "memory");
        }
    }
    __syncthreads();
}

struct P0Item { const float* W; bf16_t* WT; int N, K, k0, n0, sc; bool nts; };
__device__ __forceinline__ void tr_load(const P0Item& q, float (&wv)[64]) {
#pragma unroll
    for (int kk = 0; kk < 64; ++kk) wv[kk] = __builtin_nontemporal_load(q.W + (size_t)(q.k0 + kk) * q.N + q.sc);
}
__device__ __forceinline__ void tr_finish(const P0Item& q, const float (&wv)[64], LAS float* scr, int lane) {
#pragma unroll
    for (int kk = 0; kk < 64; ++kk) scr[kk * 65 + lane] = wv[kk];
    LDS_WAIT(); CFENCE();
    const int c = lane & 7;
#pragma unroll
    for (int j = 0; j < 8; ++j) { const int n = (lane >> 3) + 8 * j; const LAS float* s = scr + (8 * c) * 65 + n;
        u32x4 o; o.x = cvt_pk_bf16(s[0 * 65], s[1 * 65]); o.y = cvt_pk_bf16(s[2 * 65], s[3 * 65]); o.z = cvt_pk_bf16(s[4 * 65], s[5 * 65]); o.w = cvt_pk_bf16(s[6 * 65], s[7 * 65]);
        u32x4* dst = (u32x4*)(q.WT + (size_t)(q.n0 + n) * q.K + q.k0 + 8 * c);
        if (q.nts) __builtin_nontemporal_store(o, dst); else *dst = o; }
    LDS_WAIT(); CFENCE();
}
struct ColId { __device__ __forceinline__ int operator()(int n) const { return n; } };
struct ColWin {
    __device__ __forceinline__ int operator()(int np) const {
        if (np < 4096) { const int seg = np >> 11, w = np & 2047, h = w >> 8, r = w & 255; return seg * 2048 + h * 256 + (r >> 1) + 128 * (r & 1); }
        if (np < 14336 || np >= 18432) return np;
        const int w = np - 14336; return 14336 + (w >> 1) + 2048 * (w & 1);
    }
};
__device__ __forceinline__ void sincos_tab(int pidx, int i, float& c, float& s) {
    const int pos = pidx < SEQ ? pidx : 16384 + (pidx - SEQ);
    const float inv = (float)exp2(-(double)i * (13.287712379549449 / 128.0));
    const float ang = (float)pos * inv;
    const double a = (double)ang;
    const double n = rint(a * 0.15915494309189535);
    double r = fma(-n, 6.283185307179586, a); r = fma(-n, 2.4492935982947064e-16, r);
    const double r2 = r * r;
    double ps = -1.0 / 51090942171709440000.0;
    ps = ps * r2 + 1.0 / 121645100408832000.0; ps = ps * r2 - 1.0 / 355687428096000.0; ps = ps * r2 + 1.0 / 1307674368000.0; ps = ps * r2 - 1.0 / 6227020800.0;
    ps = ps * r2 + 1.0 / 39916800.0; ps = ps * r2 - 1.0 / 362880.0; ps = ps * r2 + 1.0 / 5040.0; ps = ps * r2 - 1.0 / 120.0; ps = ps * r2 + 1.0 / 6.0; ps = 1.0 - ps * r2;
    double pc = 1.0 / 1124000727777607680000.0;
    pc = pc * r2 - 1.0 / 2432902008176640000.0; pc = pc * r2 + 1.0 / 6402373705728000.0; pc = pc * r2 - 1.0 / 20922789888000.0; pc = pc * r2 + 1.0 / 87178291200.0;
    pc = pc * r2 - 1.0 / 479001600.0; pc = pc * r2 + 1.0 / 3628800.0; pc = pc * r2 - 1.0 / 40320.0; pc = pc * r2 + 1.0 / 720.0; pc = pc * r2 - 1.0 / 24.0; pc = pc * r2 + 0.5; pc = 1.0 - pc * r2;
    s = (float)(r * ps); c = (float)pc;
}
__device__ __forceinline__ void rms_row_to_bf16(const float* xr_, const float* g, bf16_t* orow, int lane) {
    const f32x4* xr = (const f32x4*)xr_ + lane; f32x4 v[8]; float s = 0.f;
#pragma unroll
    for (int j = 0; j < 8; ++j) { v[j] = __builtin_nontemporal_load(xr + 64 * j); s += (v[j][0] * v[j][0] + v[j][1] * v[j][1]) + (v[j][2] * v[j][2] + v[j][3] * v[j][3]); }
    const float r = rsqrtf(wave_sum(s) * (1.0f / DM) + EPS);
#pragma unroll
    for (int j = 0; j < 8; ++j) { const f32x4 gg = ((const f32x4*)g)[lane + 64 * j]; const f32x4 y = v[j] * r * gg;
        u32x2 w; w.x = cvt_pk_bf16(y[0], y[1]); w.y = cvt_pk_bf16(y[2], y[3]); ((u32x2*)orow)[lane + 64 * j] = w; }
}
__device__ __forceinline__ void p0_prologue(const Frame& F) {
    const int tid = opaque_tid(), lane = tid & 63;
    LAS float* scr = (LAS float*)(F.lds + F.wave * 16640);
    const int gw = F.vcu * NWAVES + F.wave, NGW = F.G * NWAVES;
    constexpr int I_IN = (DM / 64) * (DIN / 64), I_PR = (DVT / 64) * (DM / 64), I_SQ = (DM / 64) * (DM / 64), I_UP = (DM / 64) * (DFF / 64), I_DN = (DFF / 64) * (DM / 64);
    constexpr int C0 = I_IN, C1 = C0 + I_PR, C2 = C1 + I_SQ, C3 = C2 + I_SQ, C4 = C3 + I_UP, C5 = C4 + I_UP, NITEMS = C5 + I_DN;
    auto item_of = [&](int it) -> P0Item {
        const int reg = (it >= C0) + (it >= C1) + (it >= C2) + (it >= C3) + (it >= C4) + (it >= C5);
        const int base = reg == 0 ? 0 : reg == 1 ? C0 : reg == 2 ? C1 : reg == 3 ? C2 : reg == 4 ? C3 : reg == 5 ? C4 : C5, r = it - base;
        const int inp = reg == 0 ? I_WIN : reg == 1 ? I_PRET : reg == 2 ? I_PCONV : reg == 3 ? I_WO : reg == 4 ? I_WUP : reg == 5 ? I_WGATE : I_WDOWN;
        const size_t wso = reg == 0 ? WS_WINT : reg == 1 ? WS_PRETT : reg == 2 ? WS_PCONVT : reg == 3 ? WS_WOT : reg == 4 ? WS_WUGT : reg == 5 ? WS_WUGT + (size_t)DFF * DM * 2 : WS_WDT;
        P0Item q; q.W = INP(F, inp); q.WT = (bf16_t*)(F.ws + wso);
        q.N = reg == 0 ? DIN : (reg == 4 || reg == 5) ? DFF : DM; q.K = reg == 1 ? DVT : reg == 6 ? DFF : DM; q.nts = reg != 0;
        const int nblk = q.N / 64, kb = r / nblk, nb = r - kb * nblk; q.k0 = 64 * kb; q.n0 = 64 * nb;
        q.sc = reg == 0 ? ColWin()(q.n0 + lane) : q.n0 + lane;
        return q;
    };
    {
        float wa[64], wb[64];
        int it = gw; P0Item qa = item_of(it < NITEMS ? it : 0), qb = qa;
        if (it < NITEMS) tr_load(qa, wa);
#pragma unroll 1
        while (it < NITEMS) {
            const int i1 = it + NGW, i2 = it + 2 * NGW;
            if (i1 < NITEMS) { qb = item_of(i1); tr_load(qb, wb); }
            tr_finish(qa, wa, scr, lane);
            if (i1 >= NITEMS) break;
            if (i2 < NITEMS) { qa = item_of(i2); tr_load(qa, wa); }
            tr_finish(qb, wb, scr, lane);
            it = i2;
        }
    }
    for (int m = gw; m < MT; m += NGW) rms_row_to_bf16(xrow(F, m), INP(F, I_GPREMIX), WSB(F, WS_HN) + (size_t)m * DM, lane);
    const int gt = F.vcu * NTHREADS + tid, NGT = F.G * NTHREADS;
    for (int e = gt; e < 2052 * 128; e += NGT) { float c, s; sincos_tab(e >> 7, e & 127, c, s); ((f32x2*)WSF(F, WS_ROPE))[e] = (f32x2){c, s}; }
}

constexpr int FL_KBUF = 0, FL_PBUF = 65536, FL_RED = 81920, FL_QBUF = 86016;
__device__ __forceinline__ void flash_unit(const Frame& F, int b, int h, int qb) {
    constexpr int ABL = 0;
    LAS unsigned char* lds = F.lds;
    const int lane = opaque_tid() & 63;
    const int w = F.wave, fr = lane & 15, fq = lane >> 4;
    const int i0 = qb * 128; const int mrow0 = b * SEQ;
    const float L2g = log2gamma(h);
    { const char* qb_ = (const char*)WSB(F, WS_Q) + ((size_t)(mrow0 + i0 + 16 * w) * DM + h * DK) * 2;
      const int r0 = lane >> 5, cp = lane & 31;
#pragma unroll
      for (int i = 0; i < 8; ++i) { const int row = r0 + 2 * i; const unsigned off = (unsigned)(row * (DM * 2) + ((cp ^ row) * 16));
          __builtin_amdgcn_global_load_lds((const unsigned*)(qb_ + off), (LAS unsigned*)(lds + FL_QBUF + w * 8192 + i * 1024), 16, 0, 0); } }
    f32x4 acc[4][8];
#pragma unroll
    for (int ef = 0; ef < 4; ++ef)
#pragma unroll
        for (int qf = 0; qf < 8; ++qf) acc[ef][qf] = (f32x4){0.f, 0.f, 0.f, 0.f};
    const int nkb = 2 * qb + 2, sg = qb >> 2, jb0 = 8 * sg;
    const char* kbase = (const char*)WSB(F, WS_K) + ((size_t)mrow0 * DM + h * DK) * 2;
    const int krow0 = 2 * w + (lane >> 5);
    const unsigned ksrc = (unsigned)(krow0 * (DM * 2) + (((lane & 31) ^ (krow0 & 15)) * 16));
#define FL_STAGE_K(jb, buf) do { if (ABL & 1) break; const char* kb_ = kbase + (size_t)(jb) * (64 * DM * 2); _Pragma("unroll") for (int i = 0; i < 4; ++i) \
        __builtin_amdgcn_global_load_lds((const unsigned*)(kb_ + (size_t)i * (16 * DM * 2) + ksrc), (LAS unsigned*)(lds + FL_KBUF + (buf) * 32768 + i * 8192 + w * 1024), 16, 0, 0); } while (0)
    FL_STAGE_K(jb0, 0);
    const char* vbase = (const char*)WSB(F, WS_VT) + ((size_t)(h * DVH + 64 * w) * LDV + mrow0) * 2;
    float c2[4];
#pragma unroll
    for (int r = 0; r < 4; ++r) c2[r] = __builtin_amdgcn_exp2f(-L2g * (float)(4 * (lane >> 4) + r));
    bf16x8 Vf[4][2];
    if (sg > 0) {
        const char* sb_ = (const char*)WSB(F, WS_ST) + ((size_t)(((b * NH + h) * 3 + (sg - 1)) * DVH + 64 * w) * DK) * 2;
        const unsigned soff = (unsigned)(fr * (DK * 2) + fq * 16);
#pragma unroll
        for (int ef = 0; ef < 4; ++ef)
#pragma unroll
            for (int ks = 0; ks < 2; ++ks) Vf[ef][ks] = *(const bf16x8*)(sb_ + (size_t)ef * (16 * DK * 2) + ks * 64 + soff);
        VM_WAIT(); RAW_BAR();
#pragma unroll
        for (int ks = 0; ks < 8; ++ks) {
#pragma unroll
            for (int qf = 0; qf < 8; ++qf) { const bf16x8 Qf = *(const LAS bf16x8*)(lds + FL_QBUF + (16 * qf + fr) * 512 + (((ks * 4 + fq) ^ fr) * 16));
#pragma unroll
                for (int ef = 0; ef < 4; ++ef) acc[ef][qf] = __builtin_amdgcn_mfma_f32_16x16x32_bf16(Vf[ef][ks & 1], Qf, acc[ef][qf], 0, 0, 0); }
            if (ks < 6) {
#pragma unroll
                for (int ef = 0; ef < 4; ++ef) Vf[ef][ks & 1] = *(const bf16x8*)(sb_ + (size_t)ef * (16 * DK * 2) + (ks + 2) * 64 + soff); } }
#pragma unroll
        for (int qf = 0; qf < 8; ++qf) { const float lam = __builtin_amdgcn_exp2f(L2g * (float)(i0 + 16 * qf + fr - 512 * sg + 1));
#pragma unroll
            for (int ef = 0; ef < 4; ++ef) acc[ef][qf] *= lam; }
    }
    { const char* v0_ = vbase + (size_t)jb0 * 128; const unsigned voff = (unsigned)((lane & 15) * (LDV * 2) + (lane >> 4) * 16);
#pragma unroll
      for (int ef = 0; ef < 4; ++ef)
#pragma unroll
          for (int ks = 0; ks < 2; ++ks) Vf[ef][ks] = *(const bf16x8*)(v0_ + (size_t)ef * (16 * LDV * 2) + ks * 64 + voff); }
    VM_WAIT();
    for (int jb = jb0; jb < nkb; ++jb) {
        RAW_BAR();
        const bool more = jb + 1 < nkb;
        if (more) FL_STAGE_K(jb + 1, (jb + 1) & 1);
        int fr = lane & 15, fq = lane >> 4; asm volatile("" : "+v"(fr), "+v"(fq));
        f32x4 sacc[4];
        const LAS unsigned char* kl = lds + FL_KBUF + (jb & 1) * 32768 + fr * 512;
        const LAS unsigned char* ql_ = lds + FL_QBUF + w * 8192 + fr * 512;
#pragma unroll
        for (int kf = 0; kf < 4; ++kf) sacc[kf] = (f32x4){0.f, 0.f, 0.f, 0.f};
        if (!(ABL & 2)) {
          bf16x8 Qn, Kn[4];
          { const int sw = (fq ^ fr) * 16; Qn = *(const LAS bf16x8*)(ql_ + sw);
#pragma unroll
            for (int kf = 0; kf < 4; ++kf) Kn[kf] = *(const LAS bf16x8*)(kl + kf * 8192 + sw); }
#pragma unroll
          for (int ks = 0; ks < 8; ++ks) { const bf16x8 Qc = Qn; bf16x8 Kc[4];
#pragma unroll
              for (int kf = 0; kf < 4; ++kf) Kc[kf] = Kn[kf];
              if (ks < 7) { const int sw = (((ks + 1) * 4 + fq) ^ fr) * 16; Qn = *(const LAS bf16x8*)(ql_ + sw);
#pragma unroll
                  for (int kf = 0; kf < 4; ++kf) Kn[kf] = *(const LAS bf16x8*)(kl + kf * 8192 + sw); }
              __builtin_amdgcn_sched_barrier(0);
#pragma unroll
              for (int kf = 0; kf < 4; ++kf) sacc[kf] = __builtin_amdgcn_mfma_f32_16x16x32_bf16(Kc[kf], Qc, sacc[kf], 0, 0, 0);
              __builtin_amdgcn_sched_barrier(0); } }
        { const int ql = 16 * w + fr, iq = i0 + ql;
          const float rowf = __builtin_amdgcn_exp2f(L2g * (float)(iq - 64 * jb));
          const bool diag = jb >= 2 * qb;
#pragma unroll
          for (int kf = 0; kf < 4; ++kf) { const int jbase = 64 * jb + 16 * kf + 4 * fq; float pv[4];
              const float rk = rowf * __builtin_amdgcn_exp2f(L2g * (float)(-16 * kf));
#pragma unroll
              for (int r = 0; r < 4; ++r) { if (ABL & 8) { pv[r] = sacc[kf][r]; continue; } pv[r] = sacc[kf][r] * (rk * c2[r]); if (diag) pv[r] = (iq - (jbase + r)) >= 0 ? pv[r] : 0.f; }
              u32x2 pw; pw.x = cvt_pk_bf16(pv[0], pv[1]); pw.y = cvt_pk_bf16(pv[2], pv[3]);
              *(LAS u32x2*)(lds + FL_PBUF + ql * 128 + (((kf * 2 + (fq >> 1)) ^ ((ql >> 1) & 7)) * 16) + (fq & 1) * 8) = pw; } }
        LDS_WAIT(); RAW_BAR();
        { const LAS unsigned char* pl = lds + FL_PBUF + fr * 128;
          const char* vn_ = vbase + (size_t)(jb + 1) * 128; const unsigned voff = (unsigned)(fr * (LDV * 2) + fq * 16);
#pragma unroll
          for (int ks = 0; ks < 2; ++ks) { const int sw = (((ks * 4 + fq) ^ ((fr >> 1) & 7)) * 16);
              bf16x8 Pn0 = *(const LAS bf16x8*)(pl + sw), Pn1 = *(const LAS bf16x8*)(pl + 2048 + sw);
#pragma unroll
              for (int qf = 0; qf < 8; ++qf) { const bf16x8 Pc = Pn0; Pn0 = Pn1;
                  if (qf < 6) Pn1 = *(const LAS bf16x8*)(pl + (qf + 2) * 2048 + sw);
                  __builtin_amdgcn_sched_barrier(0);
#pragma unroll
                  for (int ef = 0; ef < 4; ++ef) { if (ABL & 4) { asm volatile("" :: "v"(Pc)); continue; } acc[ef][qf] = __builtin_amdgcn_mfma_f32_16x16x32_bf16(Vf[ef][ks], Pc, acc[ef][qf], 0, 0, 0); }
                  __builtin_amdgcn_sched_barrier(0); }
              if (more && !(ABL & 1)) {
#pragma unroll
                  for (int ef = 0; ef < 4; ++ef) Vf[ef][ks] = *(const bf16x8*)(vn_ + (size_t)ef * (16 * LDV * 2) + ks * 64 + voff); } } }
        asm volatile("s_waitcnt vmcnt(8)" ::: "memory");
    }
#undef FL_STAGE_K
    LAS float* red = (LAS float*)(lds + FL_RED);
    float ss[8];
#pragma unroll
    for (int qf = 0; qf < 8; ++qf) { float s = 0.f;
#pragma unroll
        for (int ef = 0; ef < 4; ++ef) { const f32x4 a = acc[ef][qf]; s += (a[0] * a[0] + a[1] * a[1]) + (a[2] * a[2] + a[3] * a[3]); }
        s += __shfl_xor(s, 16); s += __shfl_xor(s, 32); ss[qf] = s; }
    if (fq == 0) {
#pragma unroll
        for (int qf = 0; qf < 8; ++qf) red[w * 128 + 16 * qf + fr] = ss[qf]; }
    LDS_WAIT(); RAW_BAR();
    { const size_t ub = ((size_t)(mrow0 + i0) * DVT + h * DVH + 64 * w) * 2;
      const char* gbase = (const char*)WSB(F, WS_GR) + ub; char* obase = (char*)WSB(F, WS_ARET) + ub;
      const unsigned loff = (unsigned)(fr * (DVT * 2) + fq * 8);
#pragma unroll
      for (int qf = 0; qf < 8; ++qf) { float tot = 0.f;
#pragma unroll
          for (int ww = 0; ww < 8; ++ww) tot += red[ww * 128 + 16 * qf + fr];
          const float rstd = rsqrtf(tot * (1.0f / DVH) + EPS);
#pragma unroll
          for (int ef = 0; ef < 4; ++ef) { const size_t uo = (size_t)qf * (16 * DVT * 2) + ef * 32;
              const u32x2 g = *(const u32x2*)(gbase + uo + loff); const f32x4 a = acc[ef][qf];
              u32x2 o; o.x = cvt_pk_bf16(a[0] * rstd * bf_lo(g.x), a[1] * rstd * bf_hi(g.x)); o.y = cvt_pk_bf16(a[2] * rstd * bf_lo(g.y), a[3] * rstd * bf_hi(g.y));
              *(u32x2*)(obase + uo + loff) = o; }
          CFENCE(); } }
    LDS_WAIT(); RAW_BAR();
}

constexpr int SS_Q = 110592, SS_K = 126976, SS_D = 143360, SS_RED = 143616;
struct StreamSt {
    f32x4 cr[4], vd[4], bc[4];
    const char* s0; char* s1;
    unsigned toff; int git;
    const LAS float* sq; const LAS float* sk; float g4;
};
__device__ __forceinline__ void stream_load(StreamSt& T, int it) {
#pragma unroll
    for (int k = 0; k < 4; ++k) T.bc[k] = __builtin_nontemporal_load((const f32x4*)(T.s0 + (size_t)((4 * it + k) * (DVH * 4)) + T.toff));
}
__device__ __forceinline__ void stream_proc(StreamSt& T, int it) {
#pragma unroll
    for (int k = 0; k < 4; ++k) { const int d = 4 * it + k; const f32x4 s = T.bc[k]; f32x4 sn = s * T.g4;
#pragma unroll
        for (int j = 0; j < 4; ++j) { T.cr[j] += s * T.sq[j * 256 + d]; sn += T.vd[j] * T.sk[j * 256 + d]; }
        __builtin_nontemporal_store(sn, (f32x4*)(T.s1 + (size_t)(d * (DVH * 4)) + T.toff)); }
}
constexpr int F6_KBUF = 0, F6_PBUF = 65536, F6_RED = 73728, F6_QBUF = 77824;
template <bool STREAM>
__device__ __forceinline__ void flash64_unit(const Frame& F, int b, int h, int qb, StreamSt& T) {
    LAS unsigned char* lds = F.lds;
    const int lane = opaque_tid() & 63;
    const int w = F.wave, qfw = w & 3, kf0 = 2 * (w >> 2);
    const int i0 = qb * 64; const int mrow0 = b * SEQ;
    const float L2g = log2gamma(h);
    { const char* qb_ = (const char*)WSB(F, WS_Q) + ((size_t)(mrow0 + i0) * DM + h * DK) * 2;
      const int r0 = lane >> 5, cp = lane & 31;
#pragma unroll
      for (int i = 0; i < 4; ++i) { const int row = 8 * w + 2 * i + r0; const unsigned off = (unsigned)(row * (DM * 2) + ((cp ^ (row & 15)) * 16));
          __builtin_amdgcn_global_load_lds((const unsigned*)(qb_ + off), (LAS unsigned*)(lds + F6_QBUF + (4 * w + i) * 1024), 16, 0, 0); } }
    f32x4 acc[4][4];
#pragma unroll
    for (int ef = 0; ef < 4; ++ef)
#pragma unroll
        for (int qf = 0; qf < 4; ++qf) acc[ef][qf] = (f32x4){0.f, 0.f, 0.f, 0.f};
    const int nkb = qb + 1;
    const char* kbase = (const char*)WSB(F, WS_K) + ((size_t)mrow0 * DM + h * DK) * 2;
    const int krow0 = 2 * w + (lane >> 5);
    const unsigned ksrc = (unsigned)(krow0 * (DM * 2) + (((lane & 31) ^ (krow0 & 15)) * 16));
#define F6_STAGE_K(jb, buf) do { const char* kb_ = kbase + (size_t)(jb) * (64 * DM * 2); _Pragma("unroll") for (int i = 0; i < 4; ++i) \
        __builtin_amdgcn_global_load_lds((const unsigned*)(kb_ + (size_t)i * (16 * DM * 2) + ksrc), (LAS unsigned*)(lds + F6_KBUF + (buf) * 32768 + i * 8192 + w * 1024), 16, 0, 0); } while (0)
    F6_STAGE_K(0, 0);
    const char* vbase = (const char*)WSB(F, WS_VT) + ((size_t)(h * DVH + 64 * w) * LDV + mrow0) * 2;
    float c2[4];
#pragma unroll
    for (int r = 0; r < 4; ++r) c2[r] = __builtin_amdgcn_exp2f(-L2g * (float)(4 * (lane >> 4) + r));
    bf16x8 Vf[4][2];
    { const unsigned voff = (unsigned)((lane & 15) * (LDV * 2) + (lane >> 4) * 16);
#pragma unroll
      for (int ef = 0; ef < 4; ++ef)
#pragma unroll
          for (int ks = 0; ks < 2; ++ks) Vf[ef][ks] = *(const bf16x8*)(vbase + (size_t)ef * (16 * LDV * 2) + ks * 64 + voff); }
    VM_WAIT();
    for (int jb = 0; jb < nkb; ++jb) {
        RAW_BAR();
        const bool more = jb + 1 < nkb;
        if (more) F6_STAGE_K(jb + 1, (jb + 1) & 1);
        int fr = lane & 15, fq = lane >> 4; asm volatile("" : "+v"(fr), "+v"(fq));
        f32x4 sacc[2];
        sacc[0] = (f32x4){0.f, 0.f, 0.f, 0.f}; sacc[1] = (f32x4){0.f, 0.f, 0.f, 0.f};
        { const LAS unsigned char* kl = lds + F6_KBUF + (jb & 1) * 32768 + (16 * kf0 + fr) * 512;
          const LAS unsigned char* ql_ = lds + F6_QBUF + (16 * qfw + fr) * 512;
          bf16x8 Qa, Ka0, Ka1, Qb, Kb0, Kb1;
          { const int s0 = (fq ^ fr) * 16, s1 = ((4 + fq) ^ fr) * 16;
            Qa = *(const LAS bf16x8*)(ql_ + s0); Ka0 = *(const LAS bf16x8*)(kl + s0); Ka1 = *(const LAS bf16x8*)(kl + 8192 + s0);
            Qb = *(const LAS bf16x8*)(ql_ + s1); Kb0 = *(const LAS bf16x8*)(kl + s1); Kb1 = *(const LAS bf16x8*)(kl + 8192 + s1); }
#pragma unroll
          for (int ks = 0; ks < 8; ++ks) { const bf16x8 Qc = Qa, Kc0 = Ka0, Kc1 = Ka1;
              Qa = Qb; Ka0 = Kb0; Ka1 = Kb1;
              if (ks < 6) { const int sw = (((ks + 2) * 4 + fq) ^ fr) * 16; Qb = *(const LAS bf16x8*)(ql_ + sw); Kb0 = *(const LAS bf16x8*)(kl + sw); Kb1 = *(const LAS bf16x8*)(kl + 8192 + sw); }
              __builtin_amdgcn_sched_barrier(0);
              sacc[0] = __builtin_amdgcn_mfma_f32_16x16x32_bf16(Kc0, Qc, sacc[0], 0, 0, 0);
              sacc[1] = __builtin_amdgcn_mfma_f32_16x16x32_bf16(Kc1, Qc, sacc[1], 0, 0, 0);
              __builtin_amdgcn_sched_barrier(0); } }
        { const int ql = 16 * qfw + fr, iq = i0 + ql;
          const float rowf = __builtin_amdgcn_exp2f(L2g * (float)(iq - 64 * jb));
          const bool diag = jb == qb;
#pragma unroll
          for (int kk = 0; kk < 2; ++kk) { const int kf = kf0 + kk; const int jbase = 64 * jb + 16 * kf + 4 * fq; float pv[4];
              const float rk = rowf * __builtin_amdgcn_exp2f(L2g * (float)(-16 * kf));
#pragma unroll
              for (int r = 0; r < 4; ++r) { pv[r] = sacc[kk][r] * (rk * c2[r]); if (diag) pv[r] = (iq - (jbase + r)) >= 0 ? pv[r] : 0.f; }
              u32x2 pw; pw.x = cvt_pk_bf16(pv[0], pv[1]); pw.y = cvt_pk_bf16(pv[2], pv[3]);
              *(LAS u32x2*)(lds + F6_PBUF + ql * 128 + (((kf * 2 + (fq >> 1)) ^ ((ql >> 1) & 7)) * 16) + (fq & 1) * 8) = pw; } }
        LDS_WAIT(); RAW_BAR();
        { const LAS unsigned char* pl = lds + F6_PBUF + fr * 128;
          const char* vn_ = vbase + (size_t)(jb + 1) * 128; const unsigned voff = (unsigned)(fr * (LDV * 2) + fq * 16);
          bf16x8 Pf[2][4];
#pragma unroll
          for (int ks = 0; ks < 2; ++ks) { const int sw = (((ks * 4 + fq) ^ ((fr >> 1) & 7)) * 16);
#pragma unroll
              for (int qf = 0; qf < 4; ++qf) Pf[ks][qf] = *(const LAS bf16x8*)(pl + qf * 2048 + sw); }
#pragma unroll
          for (int ks = 0; ks < 2; ++ks) {
#pragma unroll
              for (int qf = 0; qf < 4; ++qf)
#pragma unroll
                  for (int ef = 0; ef < 4; ++ef) acc[ef][qf] = __builtin_amdgcn_mfma_f32_16x16x32_bf16(Vf[ef][ks], Pf[ks][qf], acc[ef][qf], 0, 0, 0);
              if (more) {
#pragma unroll
                  for (int ef = 0; ef < 4; ++ef) Vf[ef][ks] = *(const bf16x8*)(vn_ + (size_t)ef * (16 * LDV * 2) + ks * 64 + voff); } } }
        if constexpr (STREAM) {
            const int it = T.git; T.git = it + 1;
            if (it < 63) { stream_proc(T, it); stream_load(T, it + 1); if (more) asm volatile("s_waitcnt vmcnt(16)" ::: "memory"); }
            else if (it == 63) { stream_proc(T, it); if (more) asm volatile("s_waitcnt vmcnt(12)" ::: "memory"); }
            else { if (more) asm volatile("s_waitcnt vmcnt(8)" ::: "memory"); }
        } else {
            asm volatile("s_waitcnt vmcnt(8)" ::: "memory");
        }
    }
#undef F6_STAGE_K
    LAS float* red = (LAS float*)(lds + F6_RED);
    { const int fr = lane & 15, fq = lane >> 4;
      float ss[4];
#pragma unroll
      for (int qf = 0; qf < 4; ++qf) { float s = 0.f;
#pragma unroll
          for (int ef = 0; ef < 4; ++ef) { const f32x4 a = acc[ef][qf]; s += (a[0] * a[0] + a[1] * a[1]) + (a[2] * a[2] + a[3] * a[3]); }
          s += __shfl_xor(s, 16); s += __shfl_xor(s, 32); ss[qf] = s; }
      if (fq == 0) {
#pragma unroll
          for (int qf = 0; qf < 4; ++qf) red[w * 64 + 16 * qf + fr] = ss[qf]; }
      LDS_WAIT(); RAW_BAR();
      const size_t ub = ((size_t)(mrow0 + i0) * DVT + h * DVH + 64 * w) * 2;
      const char* gbase = (const char*)WSB(F, WS_GR) + ub; char* obase = (char*)WSB(F, WS_ARET) + ub;
      const unsigned loff = (unsigned)(fr * (DVT * 2) + fq * 8);
#pragma unroll
      for (int qf = 0; qf < 4; ++qf) { float tot = 0.f;
#pragma unroll
          for (int ww = 0; ww < 8; ++ww) tot += red[ww * 64 + 16 * qf + fr];
          const float rstd = rsqrtf(tot * (1.0f / DVH) + EPS);
#pragma unroll
          for (int ef = 0; ef < 4; ++ef) { const size_t uo = (size_t)qf * (16 * DVT * 2) + ef * 32;
              const u32x2 g = *(const u32x2*)(gbase + uo + loff); const f32x4 a = acc[ef][qf];
              u32x2 o; o.x = cvt_pk_bf16(a[0] * rstd * bf_lo(g.x), a[1] * rstd * bf_hi(g.x)); o.y = cvt_pk_bf16(a[2] * rstd * bf_lo(g.y), a[3] * rstd * bf_hi(g.y));
              *(u32x2*)(obase + uo + loff) = o; }
          CFENCE(); } }
    LDS_WAIT(); RAW_BAR();
}

constexpr int SM_QS = 0, SM_KS = 4096, SM_VS = 8192, SM_SD = 16384, SM_RED = 16640, SM_XR = 32768;
__device__ __forceinline__ void sample_unit(const Frame& F, int b, int h) {
    LAS unsigned char* lds = F.lds;
    const int tid = opaque_tid();
    const int lane = tid & 63, w = tid >> 6;
    LAS float* qs = (LAS float*)(lds + SM_QS); LAS float* ks = (LAS float*)(lds + SM_KS); LAS float* vs = (LAS float*)(lds + SM_VS);
    LAS float* sd = (LAS float*)(lds + SM_SD); LAS float* red = (LAS float*)(lds + SM_RED); LAS float* xr = (LAS float*)(lds + SM_XR);
    const int m0 = MP + 4 * b;
    const float L2g = log2gamma(h);
    for (int e = tid; e < 1024; e += NTHREADS) { const int t = e >> 8, d = e & 255, dp = d < 128 ? 2 * d : 2 * (d - 128) + 1;
        qs[e] = bf1(WSB(F, WS_Q)[(size_t)(m0 + t) * DM + h * DK + dp]); ks[e] = bf1(WSB(F, WS_K)[(size_t)(m0 + t) * DM + h * DK + dp]); }
    { const int e = tid; const u32x2 vv = *(const u32x2*)(WSB(F, WS_VT) + (size_t)(h * DVH + e) * LDV + m0);
      vs[0 * 512 + e] = bf_lo(vv.x); vs[1 * 512 + e] = bf_hi(vv.x); vs[2 * 512 + e] = bf_lo(vv.y); vs[3 * 512 + e] = bf_hi(vv.y); }
    LDS_WAIT(); RAW_BAR();
#pragma unroll
    for (int pp = 0; pp < 2; ++pp) { const int pr = 2 * w + pp, t = pr >> 2, j = pr & 3; float s = 0.f;
#pragma unroll
        for (int i = 0; i < 4; ++i) s += qs[t * 256 + lane + 64 * i] * ks[j * 256 + lane + 64 * i];
        s = wave_sum(s);
        if (lane == 0) sd[pr] = (j <= t) ? s * __builtin_amdgcn_exp2f(L2g * (float)(t - j)) : 0.f; }
    const int e4 = (tid & 127) * 4, dg = tid >> 7;
    f32x4 vd[4];
#pragma unroll
    for (int j = 0; j < 4; ++j) { const float dj = __builtin_amdgcn_exp2f(L2g * (float)(3 - j)); vd[j] = (f32x4){vs[j * 512 + e4], vs[j * 512 + e4 + 1], vs[j * 512 + e4 + 2], vs[j * 512 + e4 + 3]} * dj; }
    const float g4 = __builtin_amdgcn_exp2f(L2g * 4.0f);
    f32x4 cr[4];
#pragma unroll
    for (int t = 0; t < 4; ++t) cr[t] = (f32x4){0.f, 0.f, 0.f, 0.f};
    const char* s0 = (const char*)(INP(F, I_SRET) + ((size_t)(b * NH + h) * DK) * DVH);
    char* s1 = (char*)(F.out + OFF_RS + ((size_t)(b * NH + h) * DK) * DVH);
    const unsigned toff = (unsigned)((dg * DVH + e4) * 4);
    f32x4 bA[16], bB[16];
#define SM_LOAD(buf, bt) do { _Pragma("unroll") for (int k_ = 0; k_ < 16; ++k_) buf[k_] = __builtin_nontemporal_load((const f32x4*)(s0 + (size_t)(((bt) * 16 + k_) * (4 * DVH * 4)) + toff)); } while (0)
#define SM_PROC(buf, bt) do { _Pragma("unroll") for (int k_ = 0; k_ < 16; ++k_) { const int d = ((bt) * 16 + k_) * 4 + dg; const f32x4 s = buf[k_]; f32x4 sn = s * g4; \
        _Pragma("unroll") for (int j = 0; j < 4; ++j) { cr[j] += s * qs[j * 256 + d]; sn += vd[j] * ks[j * 256 + d]; } \
        __builtin_nontemporal_store(sn, (f32x4*)(s1 + (size_t)(((bt) * 16 + k_) * (4 * DVH * 4)) + toff)); } } while (0)
    SM_LOAD(bA, 0); SM_LOAD(bB, 1);
    SM_PROC(bA, 0); SM_LOAD(bA, 2);
    SM_PROC(bB, 1); SM_LOAD(bB, 3);
    SM_PROC(bA, 2);
    SM_PROC(bB, 3);
#undef SM_LOAD
#undef SM_PROC
#pragma unroll
    for (int t = 0; t < 4; ++t) *(LAS f32x4*)(xr + (dg * 4 + t) * 512 + e4) = cr[t];
    LDS_WAIT(); RAW_BAR();
    { const int e = tid; float o[4];
#pragma unroll
      for (int t = 0; t < 4; ++t) { float c = (xr[(0 * 4 + t) * 512 + e] + xr[(1 * 4 + t) * 512 + e]) + (xr[(2 * 4 + t) * 512 + e] + xr[(3 * 4 + t) * 512 + e]);
          float in = 0.f;
#pragma unroll
          for (int j = 0; j < 4; ++j) in += sd[t * 4 + j] * vs[j * 512 + e];
          o[t] = in + c * __builtin_amdgcn_exp2f(L2g * (float)(t + 1)); }
#pragma unroll
      for (int t = 0; t < 4; ++t) { const float s = wave_sum(o[t] * o[t]); if (lane == 0) red[w * 4 + t] = s; }
      LDS_WAIT(); RAW_BAR();
#pragma unroll
      for (int t = 0; t < 4; ++t) { float tot = 0.f;
#pragma unroll
          for (int ww = 0; ww < 8; ++ww) tot += red[ww * 4 + t];
          const float rstd = rsqrtf(tot * (1.0f / DVH) + EPS);
          const size_t off = (size_t)(m0 + t) * DVT + h * DVH + e;
          const float val = o[t] * rstd * bf1(WSB(F, WS_GR)[off]);
          WSB(F, WS_ARET)[off] = (bf16_t)(cvt_pk_bf16(val, 0.f) & 0xffffu); } }
    LDS_WAIT(); RAW_BAR();
}

__device__ __forceinline__ void conv_branch_range(const Frame& F, int i0, int i1) {
#pragma unroll 2
    for (int it = i0 + opaque_tid(); it < i1; it += NTHREADS) { const int m = it >> 8, c = (it & 255) * 8;
        f32x4 u2a, u2b, u1a, u1b, u0a, u0b;
        unpack8(*(const u32x4*)(WSB(F, WS_CPR) + (size_t)m * DM + c), u2a, u2b);
        const f32x4 z = (f32x4){0.f, 0.f, 0.f, 0.f}; u1a = z; u1b = z; u0a = z; u0b = z;
        if (m < MP) { const int t = m & (SEQ - 1);
            if (t >= 1) unpack8(*(const u32x4*)(WSB(F, WS_CPR) + (size_t)(m - 1) * DM + c), u1a, u1b);
            if (t >= 2) unpack8(*(const u32x4*)(WSB(F, WS_CPR) + (size_t)(m - 2) * DM + c), u0a, u0b);
        } else { const int ms = m - MP, b = ms >> 2, t = ms & 3;
            if (t + 1 >= 2) unpack8(*(const u32x4*)(WSB(F, WS_CPR) + (size_t)(m - 1) * DM + c), u1a, u1b); else { const float* sp = INP(F, I_SCONV) + ((size_t)b * 2 + (t + 1)) * DM + c; u1a = *(const f32x4*)sp; u1b = *(const f32x4*)(sp + 4); }
            if (t >= 2) unpack8(*(const u32x4*)(WSB(F, WS_CPR) + (size_t)(m - 2) * DM + c), u0a, u0b); else { const float* sp = INP(F, I_SCONV) + ((size_t)b * 2 + t) * DM + c; u0a = *(const f32x4*)sp; u0b = *(const f32x4*)(sp + 4); } }
        const f32x4 w0a = *(const f32x4*)(INP(F, I_CONVW) + c), w0b = *(const f32x4*)(INP(F, I_CONVW) + c + 4), w1a = *(const f32x4*)(INP(F, I_CONVW) + DM + c), w1b = *(const f32x4*)(INP(F, I_CONVW) + DM + c + 4),
                    w2a = *(const f32x4*)(INP(F, I_CONVW) + 2 * DM + c), w2b = *(const f32x4*)(INP(F, I_CONVW) + 2 * DM + c + 4);
        f32x4 ga, gb; unpack8(__builtin_nontemporal_load((const u32x4*)(WSB(F, WS_GB) + (size_t)m * DM + c)), ga, gb);
        const f32x4 oa = (w0a * u0a + w1a * u1a + w2a * u2a) * ga, ob = (w0b * u0b + w1b * u1b + w2b * u2b) * gb;
        *(u32x4*)(WSB(F, WS_ACONV) + (size_t)m * DM + c) = pack8(oa, ob); }
}
__device__ __forceinline__ void kht_prep(const Frame& F) {
    LAS float* scr = (LAS float*)(F.lds + F.wave * 16640);
    const int lane = opaque_tid() & 63;
    const int gw = F.vcu * NWAVES + F.wave, NGW = F.G * NWAVES;
    constexpr int NIT = NBATCH * NH * (SEQ / 64) * (DK / 64);
    for (int it = gw; it < NIT; it += NGW) { const int db = it & 3, tb = (it >> 2) & 31, bh = it >> 7, b = bh >> 3, h = bh & 7;
        const float L2g = log2gamma(h);
        const int t0 = 64 * tb, d0 = 64 * db;
#pragma unroll
        for (int i = 0; i < 8; ++i) { const int tr = (lane >> 3) + 8 * i, cc = lane & 7;
            f32x4 a, bq; unpack8(*(const u32x4*)(WSB(F, WS_K) + (size_t)(b * SEQ + t0 + tr) * DM + h * DK + d0 + 8 * cc), a, bq);
            const float dec = __builtin_amdgcn_exp2f(L2g * (float)(SEQ - 1 - (t0 + tr)));
            LAS float* sp = scr + tr * 65 + 8 * cc;
            sp[0] = a[0] * dec; sp[1] = a[1] * dec; sp[2] = a[2] * dec; sp[3] = a[3] * dec; sp[4] = bq[0] * dec; sp[5] = bq[1] * dec; sp[6] = bq[2] * dec; sp[7] = bq[3] * dec; }
        LDS_WAIT(); CFENCE();
#pragma unroll
        for (int j = 0; j < 8; ++j) { const int n = (lane >> 3) + 8 * j, cc = lane & 7; const LAS float* s = scr + (8 * cc) * 65 + n;
            u32x4 o; o.x = cvt_pk_bf16(s[0 * 65], s[1 * 65]); o.y = cvt_pk_bf16(s[2 * 65], s[3 * 65]); o.z = cvt_pk_bf16(s[4 * 65], s[5 * 65]); o.w = cvt_pk_bf16(s[6 * 65], s[7 * 65]);
            *(u32x4*)(WSB(F, WS_KHT) + ((size_t)bh * DK + d0 + n) * SEQ + t0 + 8 * cc) = o; }
        LDS_WAIT(); CFENCE(); }
}

__device__ __forceinline__ void p2_merged(const Frame& F) {
    LAS unsigned char* lds = F.lds;
    const int tid = opaque_tid(), lane = tid & 63, g = tid >> 7, wg = (tid >> 6) & 1, e4 = (tid & 127) * 4;
    const int su = 4 * F.vcu + g, bS = su >> 3, hS = su & 7, m0 = MP + 4 * bS;
    const float L2g = log2gamma(hS);
    LAS float* sq = (LAS float*)(lds + SS_Q) + g * 1024; LAS float* sk = (LAS float*)(lds + SS_K) + g * 1024;
    LAS float* sd = (LAS float*)(lds + SS_D) + g * 16; LAS float* sred = (LAS float*)(lds + SS_RED);
    for (int e = (tid & 127); e < 1024; e += 128) { const int t = e >> 8, d = e & 255, dp = d < 128 ? 2 * d : 2 * (d - 128) + 1;
        sq[e] = bf1(WSB(F, WS_Q)[(size_t)(m0 + t) * DM + hS * DK + dp]); sk[e] = bf1(WSB(F, WS_K)[(size_t)(m0 + t) * DM + hS * DK + dp]); }
    StreamSt T;
    {
      f32x4 v[4];
#pragma unroll
      for (int c = 0; c < 4; ++c) { const u32x2 vv = *(const u32x2*)(WSB(F, WS_VT) + (size_t)(hS * DVH + e4 + c) * LDV + m0);
          v[0][c] = bf_lo(vv.x); v[1][c] = bf_hi(vv.x); v[2][c] = bf_lo(vv.y); v[3][c] = bf_hi(vv.y); }
#pragma unroll
      for (int j = 0; j < 4; ++j) T.vd[j] = v[j] * __builtin_amdgcn_exp2f(L2g * (float)(3 - j)); }
#pragma unroll
    for (int t = 0; t < 4; ++t) T.cr[t] = (f32x4){0.f, 0.f, 0.f, 0.f};
    T.s0 = (const char*)(INP(F, I_SRET) + ((size_t)(bS * NH + hS) * DK) * DVH); T.s1 = (char*)(F.out + OFF_RS + ((size_t)(bS * NH + hS) * DK) * DVH);
    T.toff = (unsigned)(e4 * 4); T.git = 0; T.sq = sq; T.sk = sk; T.g4 = __builtin_amdgcn_exp2f(L2g * 4.0f);
    stream_load(T, 0);
    LDS_WAIT(); RAW_BAR();
#pragma unroll
    for (int i = 0; i < 8; ++i) { const int pr = 8 * wg + i, t = pr >> 2, j = pr & 3; float sc = 0.f;
#pragma unroll
        for (int i4 = 0; i4 < 4; ++i4) sc += sq[t * 256 + lane + 64 * i4] * sk[j * 256 + lane + 64 * i4];
        sc = wave_sum(sc);
        if (lane == 0) sd[pr] = (j <= t) ? sc * __builtin_amdgcn_exp2f(L2g * (float)((t - j) - (3 - j))) : 0.f; }
    LDS_WAIT(); RAW_BAR();
    { const int p = F.vcu, bh = p >> 3, ql = p & 7, b_ = bh >> 3, h_ = bh & 7;
#pragma unroll 1
      for (int u = 0; u < 4; ++u) { const int qb = u == 0 ? 31 - ql : u == 1 ? 16 + ql : u == 2 ? 15 - ql : ql; flash64_unit<true>(F, b_, h_, qb, T); } }
    while (T.git < 64) { const int it = T.git; T.git = it + 1; stream_proc(T, it); if (it < 63) stream_load(T, it + 1); }
    f32x4 o[4];
    float L2e = L2g; asm volatile("" : "+v"(L2e));
#pragma unroll
    for (int t = 0; t < 4; ++t) { f32x4 in = (f32x4){0.f, 0.f, 0.f, 0.f};
#pragma unroll
        for (int j = 0; j < 4; ++j) in += T.vd[j] * sd[t * 4 + j];
        o[t] = in + T.cr[t] * __builtin_amdgcn_exp2f(L2e * (float)(t + 1));
        const float ps = wave_sum((o[t][0] * o[t][0] + o[t][1] * o[t][1]) + (o[t][2] * o[t][2] + o[t][3] * o[t][3]));
        if (lane == 0) sred[(g * 2 + wg) * 4 + t] = ps; }
    LDS_WAIT(); RAW_BAR();
#pragma unroll
    for (int t = 0; t < 4; ++t) { const float tot = sred[(g * 2) * 4 + t] + sred[(g * 2 + 1) * 4 + t];
        const float rstd = rsqrtf(tot * (1.0f / DVH) + EPS);
        const size_t off = (size_t)(m0 + t) * DVT + hS * DVH + e4;
        const u32x2 gg = *(const u32x2*)(WSB(F, WS_GR) + off);
        u32x2 ow; ow.x = cvt_pk_bf16(o[t][0] * rstd * bf_lo(gg.x), o[t][1] * rstd * bf_hi(gg.x)); ow.y = cvt_pk_bf16(o[t][2] * rstd * bf_lo(gg.y), o[t][3] * rstd * bf_hi(gg.y));
        *(u32x2*)(WSB(F, WS_ARET) + off) = ow; }
    LDS_WAIT(); RAW_BAR();
}

__device__ __forceinline__ void conv_branch_range(const Frame& F, int i0, int i1);

__device__ __forceinline__ void p2_main(const Frame& F, int c) {
    unsigned* cnt = (unsigned*)(F.ws + WS_STCNT);
    { SchedState S{(const char*)WSB(F, WS_KHT), (const char*)WSB(F, WS_VT), c}; EpiState E{WSB(F, WS_ST)}; gemm_phase<false>(F.lds, S, E); }
    if (c < 192) {
        if (threadIdx.x == 0) { __builtin_amdgcn_fence(__ATOMIC_RELEASE, "agent"); asm volatile("s_waitcnt vmcnt(0)" ::: "memory");
            __hip_atomic_fetch_add(cnt, 1u, __ATOMIC_RELAXED, __HIP_MEMORY_SCOPE_AGENT); }
    }
    const int vc = F.vcu;
    const int nS = vc < DECB * NH ? (DECB * NH - vc + F.G - 1) / F.G : 0, nP = vc < 256 ? (256 - vc + F.G - 1) / F.G : 0;
    const int typ = (vc >> 3) % 3, fpos = typ == 0 ? (nS < 1 ? nS : 1) : typ == 1 ? nS / 2 : nS;
    int ns = 0, nf = 0;
#pragma unroll 1
    for (int slot = 0; slot < nS + 2 * nP; ++slot) {
        if (slot >= fpos && nf < 2 * nP) {
            if (nf == 0) {
                if (threadIdx.x == 0) { unsigned sp = 0;
                    while (__hip_atomic_load(cnt, __ATOMIC_RELAXED, __HIP_MEMORY_SCOPE_AGENT) < 192u) { __builtin_amdgcn_s_sleep(2); if (++sp > (1u << 22)) break; }
                    __builtin_amdgcn_fence(__ATOMIC_ACQUIRE, "agent"); asm volatile("s_waitcnt vmcnt(0)" ::: "memory"); }
                __syncthreads(); }
            const int p = vc + (nf >> 1) * F.G, bh = p >> 3, ql = p & 7;
            flash_unit(F, bh >> 3, bh & 7, (nf & 1) ? ql : 15 - ql); ++nf;
        } else { const int su = vc + ns * F.G; ++ns; sample_unit(F, su >> 3, su & 7); }
    }
    { constexpr int NIT = MT * (DM / 8), PER = (NIT + 383) / 384;
      if (F.G == 256) { const int wgt = c >> 6, u0 = c < 64 ? 0 : c < 128 ? (c - 64) : c < 192 ? 64 + 2 * (c - 128) : 192 + 3 * (c - 192);
          const int i0 = u0 * PER, i1 = (u0 + wgt) * PER < NIT ? (u0 + wgt) * PER : NIT; conv_branch_range(F, i0, i1); }
      else { const int per = (NIT + F.G - 1) / F.G; const int i0 = c * per, i1 = (c + 1) * per < NIT ? (c + 1) * per : NIT; conv_branch_range(F, i0, i1); } }
}

__device__ __forceinline__ void p5_rows(const Frame& F) {
    const int gw = F.vcu * NWAVES + F.wave, NGW = F.G * NWAVES, lane = opaque_tid() & 63;
#pragma unroll 2
    for (int m = gw; m < MT; m += NGW) {
        const u32x2* mr = (const u32x2*)(WSB(F, WS_MIX) + (size_t)m * DM) + lane; const f32x4* xr = (const f32x4*)xrow(F, m) + lane;
        f32x4 v[8]; float s = 0.f;
#pragma unroll
        for (int j = 0; j < 8; ++j) { const u32x2 w_ = mr[64 * j]; v[j] = (f32x4){bf_lo(w_.x), bf_hi(w_.x), bf_lo(w_.y), bf_hi(w_.y)}; s += (v[j][0] * v[j][0] + v[j][1] * v[j][1]) + (v[j][2] * v[j][2] + v[j][3] * v[j][3]); }
        const float r1 = rsqrtf(wave_sum(s) * (1.0f / DM) + EPS); float s2 = 0.f;
#pragma unroll
        for (int j = 0; j < 8; ++j) { const f32x4 g = ((const f32x4*)INP(F, I_GPOSTMIX))[lane + 64 * j]; v[j] = __builtin_nontemporal_load(xr + 64 * j) + v[j] * r1 * g;
            s2 += (v[j][0] * v[j][0] + v[j][1] * v[j][1]) + (v[j][2] * v[j][2] + v[j][3] * v[j][3]); __builtin_nontemporal_store(v[j], (f32x4*)(WSF(F, WS_X1) + (size_t)m * DM) + lane + 64 * j); }
        const float r2 = rsqrtf(wave_sum(s2) * (1.0f / DM) + EPS);
#pragma unroll
        for (int j = 0; j < 8; ++j) { const f32x4 g = ((const f32x4*)INP(F, I_GPREFFN))[lane + 64 * j]; const f32x4 y = v[j] * r2 * g;
            u32x2 w; w.x = cvt_pk_bf16(y[0], y[1]); w.y = cvt_pk_bf16(y[2], y[3]); ((u32x2*)(WSB(F, WS_HN) + (size_t)m * DM))[lane + 64 * j] = w; }
    }
}
__device__ __forceinline__ float gelu_tanh(float v) { const float u = 1.5957691216057308f * (v + 0.044715f * v * v * v); return v * __builtin_amdgcn_rcpf(1.0f + __builtin_amdgcn_exp2f(u * -1.4426950408889634f)); }
__device__ __forceinline__ void p7_elementwise(const Frame& F, int wi, int nw) {
    const int gt = wi * NTHREADS + opaque_tid(), NGT = nw * NTHREADS;
    constexpr int CPR8 = DFF / 8;
    constexpr int NFIX = 2 * (MP / 256) + 2 * DECB;
    for (int it = gt; it < NFIX * CPR8; it += NGT) { const int k = it / CPR8, c = (it - k * CPR8) * 8;
        const int m = k < 64 ? (k >> 1) * 256 + (k & 1) : MP + ((k - 64) >> 1) * 4 + ((k - 64) & 1);
        f32x4 u2a, u2b, u1a, u1b, u0a, u0b;
        unpack8(*(const u32x4*)(WSB(F, WS_U) + (size_t)m * DFF + c), u2a, u2b);
        const f32x4 z = (f32x4){0.f, 0.f, 0.f, 0.f}; u1a = z; u1b = z; u0a = z; u0b = z;
        if (m < MP) { const int t = m & (SEQ - 1);
            if (t >= 1) unpack8(*(const u32x4*)(WSB(F, WS_U) + (size_t)(m - 1) * DFF + c), u1a, u1b);
            if (t >= 2) unpack8(*(const u32x4*)(WSB(F, WS_U) + (size_t)(m - 2) * DFF + c), u0a, u0b);
        } else { const int ms = m - MP, b = ms >> 2, t = ms & 3;
            if (t + 1 >= 2) unpack8(*(const u32x4*)(WSB(F, WS_U) + (size_t)(m - 1) * DFF + c), u1a, u1b); else { const float* sp = INP(F, I_SFFN) + ((size_t)b * 2 + (t + 1)) * DFF + c; u1a = *(const f32x4*)sp; u1b = *(const f32x4*)(sp + 4); }
            if (t >= 2) unpack8(*(const u32x4*)(WSB(F, WS_U) + (size_t)(m - 2) * DFF + c), u0a, u0b); else { const float* sp = INP(F, I_SFFN) + ((size_t)b * 2 + t) * DFF + c; u0a = *(const f32x4*)sp; u0b = *(const f32x4*)(sp + 4); } }
        const float* cw = INP(F, I_FCW) + c;
        const f32x4 w0a = *(const f32x4*)cw, w0b = *(const f32x4*)(cw + 4), w1a = *(const f32x4*)(cw + DFF), w1b = *(const f32x4*)(cw + DFF + 4), w2a = *(const f32x4*)(cw + 2 * DFF), w2b = *(const f32x4*)(cw + 2 * DFF + 4);
        const f32x4 ba = *(const f32x4*)(INP(F, I_FCB) + c), bb = *(const f32x4*)(INP(F, I_FCB) + c + 4);
        f32x4 ga, gb; unpack8(__builtin_nontemporal_load((const u32x4*)(WSB(F, WS_G) + (size_t)m * DFF + c)), ga, gb);
        f32x4 va = w0a * u0a + w1a * u1a + w2a * u2a + ba, vb = w0b * u0b + w1b * u1b + w2b * u2b + bb, oa, ob;
#pragma unroll
        for (int j = 0; j < 4; ++j) { oa[j] = gelu_tanh(va[j]) * ga[j]; ob[j] = gelu_tanh(vb[j]) * gb[j]; }
        *(u32x4*)(WSB(F, WS_AFF) + (size_t)m * DFF + c) = pack8(oa, ob); }
}
__device__ __forceinline__ void p9_rows(const Frame& F) {
    const int gw = F.vcu * NWAVES + F.wave, NGW = F.G * NWAVES, lane = opaque_tid() & 63;
#pragma unroll 2
    for (int m = gw; m < MT; m += NGW) {
        const u32x2* fr_ = (const u32x2*)(WSB(F, WS_F) + (size_t)m * DM) + lane; const f32x4* xr = (const f32x4*)(WSF(F, WS_X1) + (size_t)m * DM) + lane;
        f32x4 v[8]; float s = 0.f;
#pragma unroll
        for (int j = 0; j < 8; ++j) { const u32x2 w_ = fr_[64 * j]; v[j] = (f32x4){bf_lo(w_.x), bf_hi(w_.x), bf_lo(w_.y), bf_hi(w_.y)}; s += (v[j][0] * v[j][0] + v[j][1] * v[j][1]) + (v[j][2] * v[j][2] + v[j][3] * v[j][3]); }
        const float r1 = rsqrtf(wave_sum(s) * (1.0f / DM) + EPS);
#pragma unroll
        for (int j = 0; j < 8; ++j) { const f32x4 g = ((const f32x4*)INP(F, I_GPOSTFFN))[lane + 64 * j]; __builtin_nontemporal_store(__builtin_nontemporal_load(xr + 64 * j) + v[j] * r1 * g, (f32x4*)(F.out + (size_t)m * DM) + lane + 64 * j); }
    }
}

__global__ void __launch_bounds__(NTHREADS, 2) fwd_kernel(Params P) {
    extern __shared__ __attribute__((aligned(16))) unsigned char lds_raw[];
    cg::grid_group grid = cg::this_grid();
    Frame F;
    F.lds = (LAS unsigned char*)lds_raw;
    F.wave = __builtin_amdgcn_readfirstlane((int)threadIdx.x >> 6);
    F.G = gridDim.x; { const int bx = blockIdx.x; F.vcu = (F.G % 8 == 0) ? (bx % 8) * (F.G / 8) + bx / 8 : bx; }
    F.P = &P; F.ws = P.ws; F.out = P.out;
    volatile LAS unsigned* bst = (volatile LAS unsigned*)(F.lds + LDS_BYTES - 64);
    if (threadIdx.x < 2) bst[threadIdx.x] = 0u;
    __syncthreads();
    const XcdBarrier xbar = xcd_barrier_post((unsigned*)(P.ws + WS_CTL), bst);
    const int lo = P.ph_lo, hi = P.ph_hi;
#define IN(k) (lo <= (k) && (k) < hi)
#define SEAM(k) do { if (IN(k) && IN((k) + 1)) xcd_barrier(xbar); } while (0)
    const int c = (int)blockIdx.x;
#ifndef PROBE_PH
#define PROBE_PH (-1)
#endif
#define REPS(k) (((k) == PROBE_PH) ? 2 : 1)
#define PHASE(k, ...) do { if (IN(k)) { for (int rep_ = 0; rep_ < REPS(k); ++rep_) { if (rep_) grid.sync(); __VA_ARGS__ } } SEAM(k); } while (0)
    PHASE(0, { p0_prologue(F); __syncthreads(); });
    PHASE(1, {
        Sched1 S{(const char*)WSB(F, WS_HN), (const char*)WSB(F, WS_WINT), F.G, c};
        Epi1 E{WSB(F, WS_Q), WSB(F, WS_K), WSB(F, WS_GR), WSB(F, WS_GB), WSB(F, WS_CPR), WSB(F, WS_GA), WSB(F, WS_GBT), WSB(F, WS_VT), WSF(F, WS_ROPE), F.out};
        gemm_phase<false>(F.lds, S, E); });
    PHASE(2, { kht_prep(F); xcd_barrier(xbar); p2_main(F, c); __syncthreads(); });
    PHASE(3, {
        Sched3 S{(const char*)WSB(F, WS_ARET), (const char*)WSB(F, WS_PRETT), (const char*)WSB(F, WS_ACONV), (const char*)WSB(F, WS_PCONVT), F.G, c};
        Epi3 E{WSB(F, WS_GA), WSB(F, WS_GBT), WSF(F, WS_MTMP), WSB(F, WS_MBUF)};
        gemm_phase<true>(F.lds, S, E); });
    PHASE(4, {
        SchedX S{(const char*)WSB(F, WS_MBUF), (const char*)WSB(F, WS_WOT), 32, F.G, c, K_MIX};
        EpiB16 E{WSB(F, WS_MIX)};
        gemm_phase<true>(F.lds, S, E); });
    PHASE(5, { p5_rows(F); });
    PHASE(6, {
        Sched6 S{(const char*)WSB(F, WS_HN), (const char*)WSB(F, WS_WUGT), (const char*)WSB(F, WS_KHT), (const char*)WSB(F, WS_VT), F.G, c};
        Epi6 E{WSB(F, WS_U), WSB(F, WS_G), F.out, WSB(F, WS_ST), WSB(F, WS_AFF), INP(F, I_FCW), INP(F, I_FCB)};
        gemm_phase<false>(F.lds, S, E); });
    PHASE(7, {
        p7_elementwise(F, c, F.G); });
    PHASE(8, {
        SchedX S{(const char*)WSB(F, WS_AFF), (const char*)WSB(F, WS_WDT), 88, F.G, c, K_DOWN};
        Epi8 E{WSF(F, WS_X1), F.out, INP(F, I_GPOSTFFN), (unsigned long long*)(F.ws + WS_PART0)};
        gemm_phase<true>(F.lds, S, E); });
#undef PHASE
#undef REPS
#undef IN
#undef SEAM
}

extern "C" void kernel_launch(void* const* d_in, const int* in_sizes, int n_in, void* d_out, int out_size, void* d_ws, size_t ws_size, hipStream_t stream) {
    static int grid = 0;
    if (grid == 0) {
        if (n_in != 19 || (size_t)out_size != OUT_TOTAL || ws_size < WS_END) { fprintf(stderr, "kernel_launch: unexpected problem: n_in %d out %d ws %zu (need %zu)\n", n_in, out_size, ws_size, (size_t)WS_END); grid = -1; return; }
        int dev = 0, cus = 0, per_cu = 0;
        if (hipGetDevice(&dev) != hipSuccess || hipDeviceGetAttribute(&cus, hipDeviceAttributeMultiprocessorCount, dev) != hipSuccess) { grid = -1; return; }
        if (hipFuncSetAttribute((const void*)fwd_kernel, hipFuncAttributeMaxDynamicSharedMemorySize, LDS_BYTES) != hipSuccess) { fprintf(stderr, "kernel_launch: hipFuncSetAttribute failed\n"); grid = -1; return; }
        if (hipOccupancyMaxActiveBlocksPerMultiprocessor(&per_cu, (const void*)fwd_kernel, NTHREADS, LDS_BYTES) != hipSuccess || per_cu < 1) { fprintf(stderr, "kernel_launch: occupancy query failed (%d)\n", per_cu); (void)hipGetLastError(); grid = -1; return; }
        grid = cus * per_cu;
        fprintf(stderr, "kernel_launch: %d CUs x %d blocks/CU -> grid %d\n", cus, per_cu, grid);
    }
    if (grid < 0) return;
    if (hipMemsetAsync((char*)d_ws + WS_CTL, 0, WS_CTL_BYTES, stream) != hipSuccess) { fprintf(stderr, "kernel_launch: hipMemsetAsync failed\n"); return; }
    Params p{};
    for (int i = 0; i < 19; ++i) p.in[i] = (const float*)d_in[i];
    p.out = (float*)d_out; p.ws = (unsigned char*)d_ws; p.ph_lo = 0; p.ph_hi = 9;
    void* args[] = {&p};
    hipError_t e = hipLaunchCooperativeKernel((const void*)fwd_kernel, dim3(grid), dim3(NTHREADS), args, LDS_BYTES, stream);
    if (e != hipSuccess) fprintf(stderr, "kernel_launch: cooperative launch failed: %s (grid %d)\n", hipGetErrorString(e), grid);
}
```

```cpp
#include <hip/hip_runtime.h>
#include <hip/hip_cooperative_groups.h>
#include <cstdio>
#include <cstdint>
namespace cg = cooperative_groups;

#define LAS __attribute__((address_space(3)))
typedef unsigned short bf16_t;
typedef short bf16x8 __attribute__((ext_vector_type(8)));
typedef float f32x4 __attribute__((ext_vector_type(4)));
typedef float f32x2 __attribute__((ext_vector_type(2)));
typedef unsigned u32x4 __attribute__((ext_vector_type(4)));
typedef unsigned u32x2 __attribute__((ext_vector_type(2)));

constexpr int DM = 2048, SEQ = 2048, NBATCH = 4, MP = NBATCH * SEQ, DECB = 128, DECT = 4, MS = DECB * DECT, MT = MP + MS;
constexpr int DIN = 22528, NH = 8, DK = 256, DVH = 512, DVT = 4096, DFF = 5632;
constexpr int LDV = MT;
constexpr float EPS = 1e-6f;
constexpr int NWAVES = 8, NTHREADS = 512;
constexpr int LDS_BYTES = 163840;

constexpr size_t OFF_YP = 0, OFF_YS = 16777216, OFF_RP = 17825792, OFF_CP = 22020096, OFF_FP = 22036480, OFF_RS = 22081536, OFF_CS = 156299264, OFF_FS = 156823552, OUT_TOTAL = 158265344;

constexpr size_t al256(size_t x) { return (x + 255) & ~(size_t)255; }
constexpr size_t WS_CTL = 0;
constexpr size_t WS_WINT = 2u << 20;
constexpr size_t WS_PRETT = WS_WINT + al256((size_t)DIN * DM * 2);
constexpr size_t WS_PCONVT = WS_PRETT + al256((size_t)DM * DVT * 2);
constexpr size_t WS_WOT = WS_PCONVT + al256((size_t)DM * DM * 2);
constexpr size_t WS_WUGT = WS_WOT + al256((size_t)DM * DM * 2);
constexpr size_t WS_WDT = WS_WUGT + al256((size_t)2 * DFF * DM * 2);
constexpr size_t WS_HN = WS_WDT + al256((size_t)DM * DFF * 2);
constexpr size_t WS_Q = WS_HN + al256((size_t)MT * DM * 2);
constexpr size_t WS_K = WS_Q + al256((size_t)MT * DM * 2);
constexpr size_t WS_VT = WS_K + al256((size_t)MT * DM * 2);
constexpr size_t WS_GR = WS_VT + al256((size_t)DVT * LDV * 2);
constexpr size_t WS_GB = WS_GR + al256((size_t)MT * DVT * 2);
constexpr size_t WS_CPR = WS_GB + al256((size_t)MT * DM * 2);
constexpr size_t WS_GA = WS_CPR + al256((size_t)MT * DM * 2);
constexpr size_t WS_GBT = WS_GA + al256((size_t)MT * DM * 2);
constexpr size_t WS_KHT = WS_GBT + al256((size_t)MT * DM * 2);
constexpr size_t WS_ARET = WS_KHT + al256((size_t)NBATCH * NH * DK * SEQ * 2);
constexpr size_t WS_ACONV = WS_ARET + al256((size_t)MT * DVT * 2);
constexpr size_t WS_MTMP = WS_ACONV + al256((size_t)MT * DM * 2);
constexpr size_t WS_MBUF = WS_MTMP + al256((size_t)MT * DM * 4);
constexpr size_t WS_MIX = WS_MBUF + al256((size_t)MT * DM * 2);
constexpr size_t WS_X1 = WS_MIX + al256((size_t)MT * DM * 4);
constexpr size_t WS_U = WS_X1 + al256((size_t)MT * DM * 4);
constexpr size_t WS_G = WS_U + al256((size_t)MT * DFF * 2);
constexpr size_t WS_AFF = WS_G + al256((size_t)MT * DFF * 2);
constexpr size_t WS_F = WS_AFF + al256((size_t)MT * DFF * 2);
constexpr size_t WS_ROPE = WS_F + al256((size_t)MT * DM * 4);
constexpr size_t WS_ST = WS_ROPE + al256((size_t)2052 * 128 * 2 * 4);
constexpr size_t WS_END = WS_ST + al256((size_t)32 * 3 * DVH * DK * 2);
constexpr size_t WS_STCNT = 16384;
constexpr size_t PART_BYTES = (size_t)32 * 272 * 8 * 8;
constexpr size_t WS_PART0 = 65536, WS_PART1 = WS_PART0 + PART_BYTES, WS_PART2 = WS_PART1 + PART_BYTES;
constexpr size_t WS_CTL_BYTES = 2u << 20;

typedef __bf16 bf16x2n_t __attribute__((ext_vector_type(2)));
__device__ __forceinline__ unsigned cvt_pk_bf16(float lo, float hi) { const f32x2 v = {lo, hi}; return __builtin_bit_cast(unsigned, __builtin_convertvector(v, bf16x2n_t)); }
__device__ __forceinline__ float bf_lo(unsigned w) { return __uint_as_float(w << 16); }
__device__ __forceinline__ float bf_hi(unsigned w) { return __uint_as_float(w & 0xffff0000u); }
__device__ __forceinline__ float bf1(bf16_t x) { return __uint_as_float((unsigned)x << 16); }
#define LDS_WAIT() asm volatile("s_waitcnt lgkmcnt(0)" ::: "memory")
#define VM_WAIT() asm volatile("s_waitcnt vmcnt(0)" ::: "memory")
#define CFENCE() asm volatile("" ::: "memory")
#define RAW_BAR() do { asm volatile("" ::: "memory"); __builtin_amdgcn_s_barrier(); asm volatile("" ::: "memory"); } while (0)
__device__ __forceinline__ float wave_sum(float v) {
#pragma unroll
    for (int o = 1; o < 64; o <<= 1) v += __shfl_xor(v, o);
    return v;
}
__device__ __forceinline__ float log2gamma(int h) {
    const float t[8] = {-0.04580368961312479f, -0.02272007650008353f, -0.011315313227834146f, -0.005646563141142063f,
                        -0.0028205190623786626f, -0.0014095702546713536f, -0.0007046129765893727f, -0.0003522634716290214f};
    float r = t[0];
#pragma unroll
    for (int i = 1; i < 8; ++i) r = (h == i) ? t[i] : r;
    return r;
}
__device__ __forceinline__ int opaque_tid() { int t = threadIdx.x; asm volatile("" : "+v"(t)); return t; }
__device__ __forceinline__ float sigmoidf_(float v) { return __builtin_amdgcn_rcpf(1.0f + __builtin_amdgcn_exp2f(v * -1.4426950408889634f)); }

struct Params { const float* in[19]; float* out; unsigned char* ws; int ph_lo, ph_hi; };

struct Frame {
    LAS unsigned char* lds;
    int wave, vcu, G;
    const Params* P;
    unsigned char* ws; float* out;
};
#define WSB(F, off) ((bf16_t*)((F).ws + (off)))
#define WSF(F, off) ((float*)((F).ws + (off)))
#define INP(F, k) ((F).P->in[k])
enum { I_XP = 0, I_XS, I_SRET, I_SCONV, I_SFFN, I_GPREMIX, I_WIN, I_CONVW, I_PRET, I_PCONV, I_WO, I_GPOSTMIX, I_GPREFFN, I_WUP, I_WGATE, I_FCW, I_FCB, I_WDOWN, I_GPOSTFFN };
__device__ __forceinline__ const float* xrow(const Frame& F, int m) { return m < MP ? INP(F, I_XP) + (size_t)m * DM : INP(F, I_XS) + (size_t)(m - MP) * DM; }

constexpr int BM = 256, BK = 64, HALF = 128, HTB = HALF * BK * 2, STAGE_BYTES = 8 * HTB;
__device__ __forceinline__ int lds_byte(int r, int c) { const int st = (r >> 4) * 2 + (c >> 5), rr = r & 15, cc = c & 31, ob = rr * 64 + cc * 2; return st * 1024 + (ob ^ (((ob >> 9) & 1) << 5)); }
__device__ __forceinline__ void stage_rc(int b, int& R, int& C) { const int st = b / 1024, sb = b % 1024, swz = sb ^ (((sb >> 9) & 1) << 5); R = (st >> 1) * 16 + swz / 64; C = (st & 1) * 32 + (swz % 64) / 2; }
__device__ __forceinline__ int perm32(int rho) { const int n = rho >> 4, i = rho & 15; return 8 * (i >> 2) + 4 * n + (i & 3); }

struct GUnit { const char* a; const char* b; const char* x; unsigned lda, ldb; int nt, kind, pm, pn; };

__device__ __forceinline__ void tile_of(int L, int nM, int nN, int& pm, int& pn) {
    const int nwg = nM * nN; int wgid = L;
    { const int q = nwg / 8, r = nwg % 8, xcd = wgid % 8, off = wgid / 8; wgid = (xcd < r ? xcd * (q + 1) : r * (q + 1) + (xcd - r) * q) + off; }
    const int nig = 4 * nN, gid = wgid / nig, fm = gid * 4, gsz = (nM - fm) < 4 ? (nM - fm) : 4;
    pm = fm + ((wgid % nig) % gsz); pn = (wgid % nig) / gsz;
}

constexpr int XA_OFF = STAGE_BYTES;
template <bool XR, class Sched, class Epi>
__device__ __forceinline__ void gemm_phase(LAS unsigned char* lds, const Sched& S, const Epi& E) {
    const int tid = threadIdx.x, wid = __builtin_amdgcn_readfirstlane(tid >> 6), lane = tid & 63, wr = wid >> 2, wc = wid & 3, fr = lane & 15, fq = lane >> 4;
    int R0, C0; stage_rc(tid * 16, R0, C0);
    const unsigned RA = (unsigned)R0, RB = (unsigned)((R0 & ~31) + perm32(R0 & 31)), C2 = (unsigned)C0 * 2u;
    const unsigned ldsw = (unsigned)wid * 1024u;
    const int aoff = lds_byte(wr * 64 + fr, fq * 8), boff = lds_byte(wc * 32 + fr, fq * 8);
    const int xoff = XA_OFF + fr * 128 + fq * 16;
#define G_SA(b, h) (((b) * 2 + (h)) * HTB)
#define G_SB(b, h) ((4 + (b) * 2 + (h)) * HTB)
#define G_STAGE(bufoff, gbase, voff, ld64) do { \
        __builtin_amdgcn_global_load_lds((const unsigned*)((const char*)(gbase) + (voff)), (LAS unsigned*)(lds + (bufoff) + ldsw), 16, 0, 0); \
        __builtin_amdgcn_global_load_lds((const unsigned*)((const char*)(gbase) + (ld64) + (voff)), (LAS unsigned*)(lds + (bufoff) + ldsw + 8192), 16, 0, 0); } while (0)
#define G_STAGEX(b, gbase, ld) do { if constexpr (XR) { int t_ = threadIdx.x; asm volatile("" : "+v"(t_));     \
        const unsigned vx_ = (unsigned)(((t_ >> 5) & 1) + 2 * wid) * (ld) + (unsigned)(t_ & 31) * 4u; \
        __builtin_amdgcn_global_load_lds((const unsigned*)((const char*)(gbase) + vx_), (LAS unsigned*)(lds + XA_OFF + (b) * 2048 + wid * 256), 4, 0, 0); } } while (0)
#define G_LDA(dst, b, h) do { _Pragma("unroll") for (int m = 0; m < 4; ++m) _Pragma("unroll") for (int k = 0; k < 2; ++k) dst[m][k] = *(const LAS bf16x8*)(lds + G_SA(b, h) + aoff + m * 2048 + k * 1024); } while (0)
#define G_LDB(dst, b, h) do { _Pragma("unroll") for (int n = 0; n < 2; ++n) _Pragma("unroll") for (int k = 0; k < 2; ++k) dst[n][k] = *(const LAS bf16x8*)(lds + G_SB(b, h) + boff + n * 2048 + k * 1024); } while (0)
#define G_LDX(b) do { if constexpr (XR) { Xf[0] = *(const LAS bf16x8*)(lds + xoff + (b) * 2048); Xf[1] = *(const LAS bf16x8*)(lds + xoff + (b) * 2048 + 64); } } while (0)
#define G_MMA(ai, bj, At, Bt) do { __builtin_amdgcn_s_setprio(1); _Pragma("unroll") for (int m = 0; m < 4; ++m) _Pragma("unroll") for (int n = 0; n < 2; ++n) _Pragma("unroll") for (int k = 0; k < 2; ++k) \
        acc[ai][bj][m][n] = __builtin_amdgcn_mfma_f32_16x16x32_bf16(Bt[n][k], At[m][k], acc[ai][bj][m][n], 0, 0, 0); __builtin_amdgcn_s_setprio(0); } while (0)
#define G_MMAX() do { if constexpr (XR) { if (wr == 0) { _Pragma("unroll") for (int n = 0; n < 2; ++n) _Pragma("unroll") for (int k = 0; k < 2; ++k) xacc[n] = __builtin_amdgcn_mfma_f32_16x16x32_bf16(B0[n][k], Xf[k], xacc[n], 0, 0, 0); } \
        else { _Pragma("unroll") for (int n = 0; n < 2; ++n) _Pragma("unroll") for (int k = 0; k < 2; ++k) xacc[n] = __builtin_amdgcn_mfma_f32_16x16x32_bf16(B1[n][k], Xf[k], xacc[n], 0, 0, 0); } } } while (0)
#define G_WAIT_V(n) asm volatile("s_waitcnt vmcnt(" #n ")" ::: "memory")
#define G_WAIT_VX(n, nx) do { if constexpr (XR) asm volatile("s_waitcnt vmcnt(" #nx ")" ::: "memory"); else asm volatile("s_waitcnt vmcnt(" #n ")" ::: "memory"); } while (0)
#define G_WAIT_L(n) asm volatile("s_waitcnt lgkmcnt(" #n ")" ::: "memory")
#define G_BAR __builtin_amdgcn_s_barrier()
#define G_SCHED __builtin_amdgcn_sched_barrier(0)
    GUnit cur, nxt; int ui = 0;
    if (!S.next(0, cur)) return;
    f32x4 acc[2][2][4][2]; f32x4 xacc[2];
#pragma unroll
    for (int a = 0; a < 2; ++a)
#pragma unroll
        for (int b = 0; b < 2; ++b)
#pragma unroll
            for (int m = 0; m < 4; ++m)
#pragma unroll
                for (int n = 0; n < 2; ++n) acc[a][b][m][n] = (f32x4){0.f, 0.f, 0.f, 0.f};
    xacc[0] = (f32x4){0.f, 0.f, 0.f, 0.f}; xacc[1] = (f32x4){0.f, 0.f, 0.f, 0.f};
    bf16x8 At[4][2], B0[2][2], B1[2][2], Xf[2];
    const char* cA = cur.a; const char* cB = cur.b; const char* cX = cur.x;
    unsigned vA = RA * cur.lda + C2, vB = RB * cur.ldb + C2; unsigned ldx = cur.lda;
    size_t hA = (size_t)HALF * cur.lda, hB = (size_t)HALF * cur.ldb;
    const size_t kstep = (size_t)(BK * 2);
    G_STAGE(G_SB(0, 0), cB, vB, hB / 2); G_STAGE(G_SB(0, 1), cB + hB, vB, hB / 2); G_STAGE(G_SA(0, 0), cA, vA, hA / 2); G_STAGE(G_SA(0, 1), cA + hA, vA, hA / 2); G_STAGEX(0, cX, ldx);
    if (wr == 1) G_BAR;
    G_WAIT_VX(2, 3); G_BAR;
    G_STAGE(G_SB(1, 0), cB + kstep, vB, hB / 2); G_STAGE(G_SA(1, 0), cA + kstep, vA, hA / 2); G_STAGE(G_SB(1, 1), cB + hB + kstep, vB, hB / 2);
    G_WAIT_V(6); G_BAR;
    for (;;) {
        const bool has_next = S.next(ui + 1, nxt);
        const char* nA = has_next ? nxt.a : cA; const char* nB = has_next ? nxt.b : cB; const char* nX = has_next ? nxt.x : cX;
        const unsigned nlda = has_next ? nxt.lda : cur.lda, nldb = has_next ? nxt.ldb : cur.ldb;
        const unsigned nvA = RA * nlda + C2, nvB = RB * nldb + C2;
        const size_t nhA = (size_t)HALF * nlda, nhB = (size_t)HALF * nldb;
        const int nt = cur.nt;
        for (int t = 0; t < nt; t += 2) {
            const bool last = (t == nt - 2);
            const char* a1 = cA + (size_t)(t + 1) * kstep; const char* x1 = cX + (size_t)(t + 1) * kstep;
            const char* a2 = last ? nA : cA + (size_t)(t + 2) * kstep; const char* b2 = last ? nB : cB + (size_t)(t + 2) * kstep; const char* x2 = last ? nX : cX + (size_t)(t + 2) * kstep;
            const unsigned vA2 = last ? nvA : vA, vB2 = last ? nvB : vB, ldx2 = last ? nlda : ldx;
            const size_t hA2 = last ? nhA : hA, hB2 = last ? nhB : hB;
            const char* a3 = a2 + kstep; const char* b3 = b2 + kstep;
            G_LDB(B0, 0, 0); G_LDB(B1, 0, 1); G_SCHED; G_LDA(At, 0, 0); G_STAGE(G_SA(1, 1), a1 + hA, vA, hA / 2); G_STAGEX(1, x1, ldx);
            G_WAIT_VX(8, 9); G_WAIT_L(0); G_BAR; G_MMA(0, 0, At, B0); G_MMA(0, 1, At, B1); G_BAR; G_SCHED;
            G_LDA(At, 0, 1); G_LDX(0); G_STAGE(G_SB(0, 0), b2, vB2, hB2 / 2); G_STAGE(G_SB(0, 1), b2 + hB2, vB2, hB2 / 2); G_STAGE(G_SA(0, 0), a2, vA2, hA2 / 2);
            G_WAIT_VX(8, 9); G_WAIT_L(0); G_BAR; G_MMA(1, 0, At, B0); G_MMA(1, 1, At, B1); G_MMAX(); G_BAR; G_SCHED;
            G_LDB(B0, 1, 0); G_LDB(B1, 1, 1); G_SCHED; G_LDA(At, 1, 0); G_STAGE(G_SA(0, 1), a2 + hA2, vA2, hA2 / 2); G_STAGEX(0, x2, ldx2);
            G_WAIT_VX(8, 9); G_WAIT_L(0); G_BAR; G_MMA(0, 0, At, B0); G_MMA(0, 1, At, B1); G_BAR; G_SCHED;
            G_LDA(At, 1, 1); G_LDX(1); G_STAGE(G_SB(1, 0), b3, vB2, hB2 / 2); G_STAGE(G_SB(1, 1), b3 + hB2, vB2, hB2 / 2); G_STAGE(G_SA(1, 0), a3, vA2, hA2 / 2);
            G_WAIT_VX(8, 9); G_WAIT_L(0); G_BAR; G_MMA(1, 0, At, B0); G_MMA(1, 1, At, B1); G_MMAX(); G_BAR; G_SCHED;
        }
        if (wr == 0) G_BAR;
        { int fre = fr, fqe = fq; asm volatile("" : "+v"(fre), "+v"(fqe));
          bool tiled = false;
          if constexpr (Epi::HAS_TILE) { if (E.is_tile(cur)) { tiled = true; E.tile(cur, acc, xacc, lds, wr, wc, fre, fqe); } }
          if (!tiled) {
              constexpr int NBJ = Epi::NBJ;
#pragma unroll
              for (int ai = 0; ai < 2; ++ai)
#pragma unroll
                  for (int b0 = 0; b0 < 2; b0 += NBJ) {
                      typename Epi::Pre pre[4][NBJ];
#pragma unroll
                      for (int m = 0; m < 4; ++m)
#pragma unroll
                          for (int bb = 0; bb < NBJ; ++bb) pre[m][bb] = E.pre(cur, cur.pm * BM + ai * HALF + wr * 64 + m * 16 + fre, (b0 + bb) * HALF + wc * 32 + 8 * fqe);
#pragma unroll
                      for (int m = 0; m < 4; ++m)
#pragma unroll
                          for (int bb = 0; bb < NBJ; ++bb) E.row(cur, cur.pm * BM + ai * HALF + wr * 64 + m * 16 + fre, (b0 + bb) * HALF + wc * 32 + 8 * fqe, acc[ai][b0 + bb][m][0], acc[ai][b0 + bb][m][1], pre[m][bb]);
                      CFENCE();
                  }
              if constexpr (XR) { const typename Epi::Pre px = E.pre(cur, MP + 16 * cur.pm + fre, wr * HALF + wc * 32 + 8 * fqe); E.row(cur, MP + 16 * cur.pm + fre, wr * HALF + wc * 32 + 8 * fqe, xacc[0], xacc[1], px); }
          } }
        if (!has_next) break;
#pragma unroll
        for (int a = 0; a < 2; ++a)
#pragma unroll
            for (int b = 0; b < 2; ++b)
#pragma unroll
                for (int m = 0; m < 4; ++m)
#pragma unroll
                    for (int n = 0; n < 2; ++n) acc[a][b][m][n] = (f32x4){0.f, 0.f, 0.f, 0.f};
        xacc[0] = (f32x4){0.f, 0.f, 0.f, 0.f}; xacc[1] = (f32x4){0.f, 0.f, 0.f, 0.f};
        cur = nxt; cA = nA; cB = nB; cX = nX; vA = nvA; vB = nvB; ldx = nlda; hA = nhA; hB = nhB; ++ui;
        if (wr == 1) G_BAR;
    }
    G_WAIT_V(0);
    G_BAR;
    CFENCE();
#undef G_SA
#undef G_SB
#undef G_STAGE
#undef G_STAGEX
#undef G_LDA
#undef G_LDB
#undef G_LDX
#undef G_MMA
#undef G_MMAX
#undef G_WAIT_V
#undef G_WAIT_VX
#undef G_WAIT_L
#undef G_BAR
#undef G_SCHED
}

enum { K_ROTQ = 0, K_ROTK, K_SILU, K_PLAIN, K_PROD, K_SIGA, K_SIGB, K_VT, K_YA, K_YB, K_RETP, K_MIX, K_UP, K_GATE, K_DOWN, K_STATE };

__device__ __forceinline__ u32x4 pack8(f32x4 a, f32x4 b) { u32x4 w; w.x = cvt_pk_bf16(a[0], a[1]); w.y = cvt_pk_bf16(a[2], a[3]); w.z = cvt_pk_bf16(b[0], b[1]); w.w = cvt_pk_bf16(b[2], b[3]); return w; }
__device__ __forceinline__ void unpack8(u32x4 w, f32x4& a, f32x4& b) { a = (f32x4){bf_lo(w.x), bf_hi(w.x), bf_lo(w.y), bf_hi(w.y)}; b = (f32x4){bf_lo(w.z), bf_hi(w.z), bf_lo(w.w), bf_hi(w.w)}; }
#define GP(T, base, byteoff) ((T*)((char*)(base) + (unsigned)(byteoff)))
#define GPC(T, base, byteoff) ((const T*)((const char*)(base) + (unsigned)(byteoff)))

struct Epi1 {
    static constexpr bool HAS_TILE = false; static constexpr int NBJ = 2;
    bf16_t *Q, *K, *GR, *GB, *CPR, *GA, *GBT, *VT; const float* rope; float* out;
    struct Pre {};
    __device__ __forceinline__ Pre pre(const GUnit& u, int row, int lc) const { return Pre{}; }
    __device__ __forceinline__ void row(const GUnit& u, int row, int lc, const f32x4 v0, const f32x4 v1, const Pre& pr_) const {
        const int kind = u.kind;
        if (kind == K_ROTQ || kind == K_ROTK) {
            bf16_t* dst = ((kind == K_ROTQ) ? Q : K) + (u.pn & 7) * 256; const float sc = (kind == K_ROTQ) ? 1.0f : 0.0625f;
            const int pidx = row < MP ? (row & (SEQ - 1)) : SEQ + ((row - MP) & 3);
            const f32x4 c01 = *GPC(f32x4, rope, (pidx * 128 + (lc >> 1)) * 8), c23 = *GPC(f32x4, rope, (pidx * 128 + (lc >> 1)) * 8 + 16);
            f32x4 o0, o1;
            o0[0] = (v0[0] * c01[0] - v0[1] * c01[1]) * sc; o0[1] = (v0[1] * c01[0] + v0[0] * c01[1]) * sc;
            o0[2] = (v0[2] * c01[2] - v0[3] * c01[3]) * sc; o0[3] = (v0[3] * c01[2] + v0[2] * c01[3]) * sc;
            o1[0] = (v1[0] * c23[0] - v1[1] * c23[1]) * sc; o1[1] = (v1[1] * c23[0] + v1[0] * c23[1]) * sc;
            o1[2] = (v1[2] * c23[2] - v1[3] * c23[3]) * sc; o1[3] = (v1[3] * c23[2] + v1[2] * c23[3]) * sc;
            *GP(u32x4, dst, (row * DM + lc) * 2) = pack8(o0, o1);
            CFENCE();
        } else if (kind == K_SILU) {
            f32x4 o0, o1;
#pragma unroll
            for (int j = 0; j < 4; ++j) { o0[j] = v0[j] * sigmoidf_(v0[j]); o1[j] = v1[j] * sigmoidf_(v1[j]); }
            *GP(u32x4, GR + (u.pn - 32) * 256, (row * DVT + lc) * 2) = pack8(o0, o1);
        } else if (kind == K_PLAIN) {
            *GP(u32x4, GB + (u.pn - 48) * 256, (row * DM + lc) * 2) = pack8(v0, v1);
        } else if (kind == K_SIGA || kind == K_SIGB) {
            bf16_t* dst = (kind == K_SIGA) ? GA + (u.pn - 72) * 256 : GBT + (u.pn - 80) * 256;
            f32x4 o0, o1;
#pragma unroll
            for (int j = 0; j < 4; ++j) { o0[j] = sigmoidf_(v0[j]); o1[j] = sigmoidf_(v1[j]); }
            __builtin_nontemporal_store(pack8(o0, o1), GP(u32x4, dst, (row * DM + lc) * 2));
        } else if (kind == K_PROD) {
            const int col = (u.pn - 56) * 128 + (lc >> 1);
            const f32x4 pr = (f32x4){v0[0] * v0[1], v0[2] * v0[3], v1[0] * v1[1], v1[2] * v1[3]};
            u32x2 w; w.x = cvt_pk_bf16(pr[0], pr[1]); w.y = cvt_pk_bf16(pr[2], pr[3]);
            *GP(u32x2, CPR, (row * DM + col) * 2) = w;
            if (row < MP) { const int t = row & (SEQ - 1); if (t >= SEQ - 2) *GP(f32x4, out + OFF_CP, (((row >> 11) * 2 + (t - (SEQ - 2))) * DM + col) * 4) = pr; }
            else { const int ms = row - MP, t = ms & 3; if (t >= 2) *GP(f32x4, out + OFF_CS, (((ms >> 2) * 2 + (t - 2)) * DM + col) * 4) = pr; }
        } else {
            *GP(u32x4, VT, (row * LDV + u.pn * BM + lc) * 2) = pack8(v0, v1);
        }
    }
};

struct Epi3 {
    static constexpr bool HAS_TILE = false; static constexpr int NBJ = 1;
    const bf16_t *GA, *GBT; float* MTMP; bf16_t* MBUF;
    struct Pre { u32x4 g; f32x4 t0, t1; };
    __device__ __forceinline__ Pre pre(const GUnit& u, int row, int lc) const {
        const unsigned off = (unsigned)(row * DM + u.pn * BM + lc);
        Pre p; p.t0 = (f32x4){0.f, 0.f, 0.f, 0.f}; p.t1 = p.t0;
        if (u.kind == K_YA) p.g = __builtin_nontemporal_load(GPC(u32x4, GA, off * 2));
        else { p.g = __builtin_nontemporal_load(GPC(u32x4, GBT, off * 2)); p.t0 = *GPC(f32x4, MTMP, off * 4); p.t1 = *GPC(f32x4, MTMP, off * 4 + 16); }
        return p;
    }
    __device__ __forceinline__ void row(const GUnit& u, int row, int lc, const f32x4 v0, const f32x4 v1, const Pre& p) const {
        const unsigned off = (unsigned)(row * DM + u.pn * BM + lc);
        f32x4 g0, g1; unpack8(p.g, g0, g1);
        if (u.kind == K_YA) { *GP(f32x4, MTMP, off * 4) = v0 * g0; *GP(f32x4, MTMP, off * 4 + 16) = v1 * g1; }
        else *GP(u32x4, MBUF, off * 2) = pack8(p.t0 + v0 * g0, p.t1 + v1 * g1);
    }
};

struct EpiB16 {
    static constexpr bool HAS_TILE = false; static constexpr int NBJ = 2;
    bf16_t* C;
    struct Pre {};
    __device__ __forceinline__ Pre pre(const GUnit& u, int row, int lc) const { return Pre{}; }
    __device__ __forceinline__ void row(const GUnit& u, int row, int lc, const f32x4 v0, const f32x4 v1, const Pre&) const {
        *GP(u32x4, C, (unsigned)(row * DM + u.pn * BM + lc) * 2u) = pack8(v0, v1);
    }
};

constexpr int LDS_RED = 139264;
template <class ACC, class XACC>
__device__ __forceinline__ void panel_rstd(LAS unsigned char* lds, unsigned long long* part, int pm, int pn, ACC& acc, XACC& xacc, int wr, int wc, int fr, int fq) {
    LAS float* red = (LAS float*)(lds + LDS_RED);
#pragma unroll
    for (int ai = 0; ai < 2; ++ai)
#pragma unroll
        for (int m = 0; m < 4; ++m) { float sq = 0.f;
#pragma unroll
            for (int bj = 0; bj < 2; ++bj)
#pragma unroll
                for (int n = 0; n < 2; ++n) { const f32x4 v = acc[ai][bj][m][n]; sq += (v[0] * v[0] + v[1] * v[1]) + (v[2] * v[2] + v[3] * v[3]); }
            sq += __shfl_xor(sq, 16); sq += __shfl_xor(sq, 32);
            if (fq == 0) red[wc * 256 + ai * HALF + wr * 64 + m * 16 + fr] = sq; }
    { float sq = 0.f;
#pragma unroll
      for (int n = 0; n < 2; ++n) { const f32x4 v = xacc[n]; sq += (v[0] * v[0] + v[1] * v[1]) + (v[2] * v[2] + v[3] * v[3]); }
      sq += __shfl_xor(sq, 16); sq += __shfl_xor(sq, 32);
      if (fq == 0) red[1024 + (wr * 4 + wc) * 16 + fr] = sq; }
    LDS_WAIT(); RAW_BAR();
    { const int t = opaque_tid();
      if (t < 272) {
          float tot;
          if (t < 256) tot = (red[t] + red[256 + t]) + (red[512 + t] + red[768 + t]);
          else { tot = 0.f;
#pragma unroll
              for (int w = 0; w < 8; ++w) tot += red[1024 + w * 16 + (t - 256)]; }
          unsigned long long* pw = part + ((size_t)(pm * 272 + t)) * 8;
          __hip_atomic_store(pw + pn, ((unsigned long long)1u << 32) | (unsigned long long)__float_as_uint(tot), __ATOMIC_RELAXED, __HIP_MEMORY_SCOPE_AGENT);
          unsigned long long w[8]; unsigned sp = 0;
          for (;;) {
              bool ok = true;
#pragma unroll
              for (int k = 0; k < 8; ++k) w[k] = __hip_atomic_load(pw + k, __ATOMIC_RELAXED, __HIP_MEMORY_SCOPE_AGENT);
#pragma unroll
              for (int k = 0; k < 8; ++k) ok = ok && ((unsigned)(w[k] >> 32) == 1u);
              if (ok || ++sp > (1u << 22)) break;
              __builtin_amdgcn_s_sleep(1); }
          float sum = 0.f;
#pragma unroll
          for (int k = 0; k < 8; ++k) sum += __uint_as_float((unsigned)w[k]);
          red[1280 + t] = rsqrtf(sum * (1.0f / DM) + EPS);
      } }
    LDS_WAIT(); RAW_BAR();
}

struct Epi8 {
    static constexpr bool HAS_TILE = true;
    const float* X1; float* Y; const float* g; unsigned long long* part;
    static constexpr int NBJ = 2;
    struct Pre {};
    __device__ __forceinline__ Pre pre(const GUnit& u, int row, int lc) const { return Pre{}; }
    __device__ __forceinline__ bool is_tile(const GUnit& u) const { return true; }
    __device__ __forceinline__ void row(const GUnit& u, int row, int lc, const f32x4 v0, const f32x4 v1, const Pre&) const {}
    template <class ACC, class XACC>
    __device__ __forceinline__ void tile(const GUnit& u, ACC& acc, XACC& xacc, LAS unsigned char* lds, int wr, int wc, int fr, int fq) const {
        f32x4 xa[2][4], xb[2][4];
#define E8_LOAD(buf, bj_, ai_) do { _Pragma("unroll") for (int m = 0; m < 4; ++m) { const unsigned o_ = (unsigned)(((u.pm * BM + (ai_) * HALF + wr * 64 + fr + 16 * m) * DM + u.pn * BM + (bj_) * HALF + wc * 32 + 8 * fq) * 4); \
            xa[buf][m] = __builtin_nontemporal_load(GPC(f32x4, X1, o_)); xb[buf][m] = __builtin_nontemporal_load(GPC(f32x4, X1, o_ + 16)); } } while (0)
        E8_LOAD(0, 0, 0);
        panel_rstd(lds, part, u.pm, u.pn, acc, xacc, wr, wc, fr, fq);
        const LAS float* rs = (const LAS float*)(lds + LDS_RED) + 1280;
#pragma unroll
        for (int bt = 0; bt < 4; ++bt) { const int bj = bt >> 1, ai = bt & 1, buf = bt & 1;
            if (bt < 3) { if (buf == 0) E8_LOAD(1, (bt + 1) >> 1, (bt + 1) & 1); else E8_LOAD(0, (bt + 1) >> 1, (bt + 1) & 1); }
            const int col = u.pn * BM + bj * HALF + wc * 32 + 8 * fq;
            const f32x4 g0 = *(const f32x4*)(g + col), g1 = *(const f32x4*)(g + col + 4);
            const int rl0 = ai * HALF + wr * 64 + fr;
#pragma unroll
            for (int m = 0; m < 4; ++m) { const unsigned o = (unsigned)(((u.pm * BM + rl0 + 16 * m) * DM + col) * 4); const float r = rs[rl0 + 16 * m];
                __builtin_nontemporal_store(xa[buf][m] + acc[ai][bj][m][0] * r * g0, GP(f32x4, Y, o)); __builtin_nontemporal_store(xb[buf][m] + acc[ai][bj][m][1] * r * g1, GP(f32x4, Y, o + 16)); }
        }
#undef E8_LOAD
        {
            const int col = u.pn * BM + wr * HALF + wc * 32 + 8 * fq; const unsigned o = (unsigned)(((MP + 16 * u.pm + fr) * DM + col) * 4);
            const f32x4 g0 = *(const f32x4*)(g + col), g1 = *(const f32x4*)(g + col + 4); const float r = rs[256 + fr];
            const f32x4 xa = __builtin_nontemporal_load(GPC(f32x4, X1, o)), xb = __builtin_nontemporal_load(GPC(f32x4, X1, o + 16));
            __builtin_nontemporal_store(xa + xacc[0] * r * g0, GP(f32x4, Y, o)); __builtin_nontemporal_store(xb + xacc[1] * r * g1, GP(f32x4, Y, o + 16));
        }
    }
};

struct EpiState {
    static constexpr bool HAS_TILE = false; static constexpr int NBJ = 2;
    bf16_t* ST;
    struct Pre {};
    __device__ __forceinline__ Pre pre(const GUnit& u, int row, int lc) const { return Pre{}; }
    __device__ __forceinline__ void row(const GUnit& u, int row, int lc, const f32x4 v0, const f32x4 v1, const Pre&) const {
        const int bh = u.pm, pe = u.pn & 1, sg = u.pn >> 4, rl = row - bh * BM;
        const float sc = __builtin_amdgcn_exp2f(-log2gamma(bh & 7) * (float)(SEQ - 512 * sg));
        *GP(u32x4, ST, ((((bh * 3 + (sg - 1)) * DVH + pe * BM + rl) * DK) + lc) * 2) = pack8(v0 * sc, v1 * sc);
    }
};

__device__ __forceinline__ unsigned dpp_ror1(unsigned v) { return (unsigned)__builtin_amdgcn_update_dpp(0, (int)v, 0x121, 0xf, 0xf, false); }
__device__ __forceinline__ unsigned dpp_ror2(unsigned v) { return (unsigned)__builtin_amdgcn_update_dpp(0, (int)v, 0x122, 0xf, 0xf, false); }
struct Epi6 {
    static constexpr bool HAS_TILE = true;
    bf16_t *U, *GG; float* out; const bf16_t* ST; bf16_t* AFF; const float *fcw, *fcb;
    __device__ __forceinline__ bool is_tile(const GUnit& u) const { return u.kind == K_GATE; }
    template <class ACC, class XACC>
    __device__ __forceinline__ void tile(const GUnit& u, ACC& acc, XACC& xacc, LAS unsigned char* lds, int wr, int wc, int fr, int fq) const {
        const bool f15 = fr == 15, f14 = fr >= 14;
#pragma unroll
        for (int bj = 0; bj < 2; ++bj) {
            const int col = (u.pn - 22) * BM + bj * HALF + wc * 32 + 8 * fq;
            f32x2 w0[4], w1[4], w2[4], bb[4];
            { const float* cw = fcw + col; const float* cb = fcb + col;
#pragma unroll
              for (int j = 0; j < 4; ++j) { w0[j] = *(const f32x2*)(cw + 2 * j); w1[j] = *(const f32x2*)(cw + DFF + 2 * j); w2[j] = *(const f32x2*)(cw + 2 * DFF + 2 * j); bb[j] = *(const f32x2*)(cb + 2 * j); } }
#pragma unroll
            for (int ai = 0; ai < 2; ++ai) {
                const int rb = u.pm * BM + ai * HALF + wr * 64 + fr;
                u32x4 blk[5];
#pragma unroll
                for (int mm = 0; mm < 5; ++mm) { int r = rb + 16 * (mm - 1); r = r < 0 ? 0 : r; blk[mm] = *GPC(u32x4, U, (r * DFF + col) * 2); }
#pragma unroll
                for (int m = 0; m < 4; ++m) {
                    const int row = rb + 16 * m;
                    const u32x4 c0 = blk[m + 1], pv = blk[m];
                    const f32x4 g0 = acc[ai][bj][m][0], g1 = acc[ai][bj][m][1];
                    f32x4 o0, o1;
#pragma unroll
                    for (int j = 0; j < 4; ++j) {
                        const unsigned q1 = dpp_ror1(f15 ? pv[j] : c0[j]), q2 = dpp_ror2(f14 ? pv[j] : c0[j]);
                        const f32x2 x0 = (f32x2){bf_lo(c0[j]), bf_hi(c0[j])}, x1 = (f32x2){bf_lo(q1), bf_hi(q1)}, x2 = (f32x2){bf_lo(q2), bf_hi(q2)};
                        const f32x2 v = w0[j] * x2 + (w1[j] * x1 + (w2[j] * x0 + bb[j]));
                        const f32x2 z = v * (v * v * (-2.3022082f * 0.044715f) + (-2.3022082f));
                        f32x2 e; e[0] = __builtin_amdgcn_exp2f(z[0]); e[1] = __builtin_amdgcn_exp2f(z[1]);
                        const f32x2 d = e + 1.0f; f32x2 r; r[0] = __builtin_amdgcn_rcpf(d[0]); r[1] = __builtin_amdgcn_rcpf(d[1]);
                        const f32x2 gg = j < 2 ? (f32x2){g0[2 * (j & 1)], g0[2 * (j & 1) + 1]} : (f32x2){g1[2 * (j & 1)], g1[2 * (j & 1) + 1]};
                        const f32x2 o = v * r * gg;
                        if (j < 2) { o0[2 * (j & 1)] = o[0]; o0[2 * (j & 1) + 1] = o[1]; } else { o1[2 * (j & 1)] = o[0]; o1[2 * (j & 1) + 1] = o[1]; }
                    }
                    *GP(u32x4, AFF, (row * DFF + col) * 2) = pack8(o0, o1);
                    const bool fix = row < MP ? (row & 255) < 2 : ((row - MP) & 3) < 2;
                    if (fix) *GP(u32x4, GG, (row * DFF + col) * 2) = pack8(g0, g1);
                }
            }
        }
    }
    static constexpr int NBJ = 2;
    struct Pre { u32x4 st; };
    __device__ __forceinline__ Pre pre(const GUnit& u, int row, int lc) const {
        Pre p; p.st = (u32x4){0u, 0u, 0u, 0u};
        if (u.kind == K_RETP) p.st = *GPC(u32x4, ST, ((((u.pm * 3 + 2) * DVH + u.pn * BM + (row - u.pm * BM)) * DK) + lc) * 2);
        return p;
    }
    __device__ __forceinline__ void row(const GUnit& u, int row, int lc, const f32x4 v0, const f32x4 v1, const Pre& p) const {
        if (u.kind == K_UP) {
            const int col = u.pn * BM + lc;
            *GP(u32x4, U, (row * DFF + col) * 2) = pack8(v0, v1);
            if (row < MP) { const int t = row & (SEQ - 1); if (t >= SEQ - 2) { const unsigned o = (unsigned)((((row >> 11) * 2 + (t - (SEQ - 2))) * DFF + col) * 4); *GP(f32x4, out + OFF_FP, o) = v0; *GP(f32x4, out + OFF_FP, o + 16) = v1; } }
            else { const int ms = row - MP, t = ms & 3; if (t >= 2) { const unsigned o = (unsigned)((((ms >> 2) * 2 + (t - 2)) * DFF + col) * 4); *GP(f32x4, out + OFF_FS, o) = v0; *GP(f32x4, out + OFF_FS, o + 16) = v1; } }
        } else {
            const int e = u.pn * BM + (row - u.pm * BM);
            const float g512 = __builtin_amdgcn_exp2f(log2gamma(u.pm & 7) * 512.0f);
            f32x4 s0, s1; unpack8(p.st, s0, s1);
            const f32x4 a = v0 + s0 * g512, b = v1 + s1 * g512;
            float* ob = out + OFF_RP + (size_t)u.pm * DK * DVH;
#pragma unroll
            for (int j = 0; j < 4; ++j) { const int d0 = lc + j, d1 = lc + 4 + j;
                __builtin_nontemporal_store(a[j], GP(float, ob, (((d0 >> 1) + 128 * (d0 & 1)) * DVH + e) * 4)); __builtin_nontemporal_store(b[j], GP(float, ob, (((d1 >> 1) + 128 * (d1 & 1)) * DVH + e) * 4)); }
        }
    }
};

struct Sched1 {
    const char *HN, *WINT; int G, c;
    __device__ __forceinline__ bool next(int i, GUnit& u) const {
        const int L = i * G + c; if (L >= 2992) return false;
        const bool mainp = L < 2448;
        int pm, pn; tile_of(mainp ? L : L - 2448, mainp ? 34 : 16, mainp ? 72 : 34, pm, pn);
        const int t = pn < 16 ? pn : pn + 16;
        const char* am = HN + (size_t)pm * (256 * 4096); const char* bm = WINT + (size_t)t * (256 * 4096);
        const char* av = WINT + (size_t)(16 + pm) * (256 * 4096); const char* bv = HN + (size_t)pn * (256 * 4096);
        const int km = t < 8 ? K_ROTQ : t < 16 ? K_ROTK : t < 48 ? K_SILU : t < 56 ? K_PLAIN : t < 72 ? K_PROD : t < 80 ? K_SIGA : K_SIGB;
        GUnit r; r.a = mainp ? am : av; r.b = mainp ? bm : bv; r.x = r.a; r.lda = 4096; r.ldb = 4096; r.nt = 32; r.kind = mainp ? km : K_VT; r.pm = pm; r.pn = mainp ? t : pn;
        u = r; return true;
    }
};
struct Sched3 {
    const char *ARET, *PRETT, *ACONV, *PCONVT; int G, c;
    __device__ __forceinline__ bool next(int i, GUnit& u) const {
        const int L = (i >> 1) * G + c, sub = i & 1; if (L >= 256) return false;
        int pm, pn; tile_of(L, 32, 8, pm, pn);
        GUnit r;
        r.a = sub ? ACONV + (size_t)pm * (256 * 4096) : ARET + (size_t)pm * (256 * 8192);
        r.x = sub ? ACONV + (size_t)(MP + 16 * pm) * 4096 : ARET + (size_t)(MP + 16 * pm) * 8192;
        r.b = sub ? PCONVT + (size_t)pn * (256 * 4096) : PRETT + (size_t)pn * (256 * 8192);
        r.lda = sub ? 4096u : 8192u; r.ldb = r.lda; r.nt = sub ? 32 : 64; r.kind = sub ? K_YB : K_YA; r.pm = pm; r.pn = pn;
        u = r; return true;
    }
};
struct SchedX {
    const char *A, *B; int nt, G, c, kind;
    __device__ __forceinline__ bool next(int i, GUnit& u) const {
        const int L = i * G + c; if (L >= 256) return false;
        int pm, pn; tile_of(L, 32, 8, pm, pn);
        const unsigned ld = (unsigned)nt * 128u;
        GUnit r; r.a = A + (size_t)pm * 256 * ld; r.x = A + (size_t)(MP + 16 * pm) * ld; r.b = B + (size_t)pn * 256 * ld; r.lda = ld; r.ldb = ld; r.nt = nt; r.pm = pm; r.pn = pn; r.kind = kind;
        u = r; return true;
    }
};
struct SchedSimple {
    const char *A, *B; int nN, nt, G, c, kind_split, kind_lo, kind_hi;
    __device__ __forceinline__ bool next(int i, GUnit& u) const {
        const int L = i * G + c; if (L >= 34 * nN) return false;
        int pm, pn; tile_of(L, 34, nN, pm, pn);
        const unsigned ld = (unsigned)nt * 128u;
        GUnit r; r.a = A + (size_t)pm * 256 * ld; r.x = r.a; r.b = B + (size_t)pn * 256 * ld; r.lda = ld; r.ldb = ld; r.nt = nt; r.pm = pm; r.pn = pn; r.kind = pn < kind_split ? kind_lo : kind_hi;
        u = r; return true;
    }
};
struct Sched6 {
    const char *A, *B, *KHT, *VT; int G, c;
    __device__ __forceinline__ bool next(int i, GUnit& u) const {
        const int q = (i >> 1) * G + c, sub = i & 1; const bool tile = q < 748;
        const int je = (G == 256) ? ((c >= 236 && i >= 4) ? (i - 4) * 20 + (c - 236) : 64) : (q - 748) * 2 + sub;
        const int j = tile ? 0 : je;
        if (j >= 64) return false;
        int pm, pn; tile_of(tile ? q : 0, 34, 22, pm, pn);
        pn += 22 * sub;
        const int bh = j >> 1, pe = j & 1, b = bh >> 3, h = bh & 7;
        GUnit r;
        r.a = tile ? A + (size_t)pm * (256 * 4096) : VT + ((size_t)(h * DVH + pe * 256) * LDV + (size_t)b * SEQ + (SEQ - 512)) * 2; r.x = r.a;
        r.b = tile ? B + (size_t)pn * (256 * 4096) : KHT + (size_t)bh * (DK * SEQ * 2) + (SEQ - 512) * 2;
        r.lda = tile ? 4096u : (unsigned)(LDV * 2); r.ldb = 4096u; r.nt = tile ? 32 : 8; r.kind = tile ? (sub ? K_GATE : K_UP) : K_RETP; r.pm = tile ? pm : bh; r.pn = tile ? pn : pe;
        u = r; return true;
    }
};
struct SchedState {
    const char *KHT, *VT; int c;
    __device__ __forceinline__ bool next(int i, GUnit& u) const {
        if (i != 0 || c >= 192) return false;
        const int sg = 3 - (c >> 6), k = c & 63, bh = k >> 1, pe = k & 1, b = bh >> 3, h = bh & 7;
        GUnit r; r.a = VT + ((size_t)(h * DVH + pe * 256) * LDV + (size_t)b * SEQ) * 2; r.x = r.a; r.b = KHT + (size_t)bh * (DK * SEQ * 2);
        r.lda = (unsigned)(LDV * 2); r.ldb = (unsigned)(SEQ * 2); r.nt = 8 * sg; r.kind = K_STATE; r.pm = bh; r.pn = pe | (sg << 4);
        u = r; return true;
    }
};
#define XB_TMO      128
#define XB_XCNT(j)  (256  + 64 * (j))
#define XB_XSUB(j)  (1280 + 64 * (j))
#define XB_XGEN(j)  (2304 + 64 * (j))
#define XB_TOP      3328
#define XB_TOPGEN   3392
#define XCD_BAR_WORDS 3456
#define XB_SPIN_CAP (1u << 18)
__device__ __forceinline__ unsigned xb_ld(unsigned* p)              { return __hip_atomic_load(p, __ATOMIC_RELAXED, __HIP_MEMORY_SCOPE_AGENT); }
__device__ __forceinline__ unsigned xb_add(unsigned* p, unsigned v) { return __hip_atomic_fetch_add(p, v, __ATOMIC_RELAXED, __HIP_MEMORY_SCOPE_AGENT); }
__device__ __forceinline__ unsigned xb_xcc_id() { return (unsigned)__builtin_amdgcn_s_getreg((3 << 11) | 20) & 0xFu; }
#define XB_SPIN(cond, bar) do { unsigned _sp = 0; while (cond) { __builtin_amdgcn_s_sleep(1); \
    if ((++_sp & 255u) == 0u) { if (xb_ld(&(bar)[XB_TMO])) break; if (_sp > XB_SPIN_CAP) { atomicAdd(&(bar)[XB_TMO], 1u); break; } } } } while (0)
struct XcdBarrier { unsigned* bar; unsigned x; volatile LAS unsigned* st; };
__device__ __forceinline__ XcdBarrier xcd_barrier_post(unsigned* bar, volatile LAS unsigned* st) {
    XcdBarrier b; b.bar = bar; b.x = xb_xcc_id(); b.st = st;
    if (threadIdx.x == 0) (void)xb_add(&bar[XB_XCNT(b.x)], 1u);
    return b;
}
__device__ __forceinline__ void xcd_barrier_complete(unsigned* bar, unsigned x, unsigned& nloc, unsigned& nx) {
    const unsigned G = gridDim.x * gridDim.y * gridDim.z;
    unsigned sum, cnt, mine, sp = 0u;
    for (;;) {
        sum = 0u; cnt = 0u; mine = 0u;
#pragma unroll
        for (unsigned j = 0; j < 16; ++j) { const unsigned c = xb_ld(&bar[XB_XCNT(j)]); sum += c; cnt += (c > 0u) ? 1u : 0u; mine = (j == x) ? c : mine; }
        if (sum == G) break;
        __builtin_amdgcn_s_sleep(1);
        if ((++sp & 255u) == 0u) { if (xb_ld(&bar[XB_TMO])) break; if (sp > XB_SPIN_CAP) { atomicAdd(&bar[XB_TMO], 1u); break; } }
    }
    nloc = mine > 0u ? mine : 1u; nx = cnt > 0u ? cnt : 1u;
}
__device__ __forceinline__ void xcd_barrier(const XcdBarrier& b) {
    asm volatile("s_waitcnt vmcnt(0)" ::: "memory");
    __syncthreads();
    if (threadIdx.x == 0) {
        unsigned* bar = b.bar;
        __builtin_amdgcn_s_waitcnt(0);
        unsigned nloc = b.st[0], nx = b.st[1];
        if (nloc == 0u) { xcd_barrier_complete(bar, b.x, nloc, nx); b.st[0] = nloc; b.st[1] = nx; }
        const unsigned old = xb_add(&bar[XB_XSUB(b.x)], 1u);
        const unsigned gen = old / nloc;
        if (old + 1u == (gen + 1u) * nloc) {
            __builtin_amdgcn_fence(__ATOMIC_RELEASE, "agent");
            asm volatile("s_waitcnt vmcnt(0)" ::: "memory");
            const unsigned og = xb_add(&bar[XB_TOP], 1u);
            const unsigned tg = og / nx;
            if (og + 1u == (tg + 1u) * nx) xb_add(&bar[XB_TOPGEN], 1u);
            else XB_SPIN(xb_ld(&bar[XB_TOPGEN]) == tg, bar);
            __builtin_amdgcn_fence(__ATOMIC_ACQUIRE, "agent");
            xb_add(&bar[XB_XGEN(b.x)], 1u);
            asm volatile("s_waitcnt vmcnt(0)" ::: "memory");
        } else {
            XB_SPIN(xb_ld(&bar[XB_XGEN(b.x)]) == gen, bar);
            __builtin_amdgcn_fence(__ATOMIC_ACQUIRE, "agent");
            asm volatile("s_waitcnt vmcnt(0)" ::: "memory");
        }
    }
    __syncthreads();
}

template <bool NTS, class ColMap>
__device__ __forceinline__ void transpose_item(const float* W, int N, int K, bf16_t* WT, LAS float* scr, int item, int lane, ColMap cm) {
    const int nblk = N / 64, kb = item / nblk, nb = item % nblk, k0 = 64 * kb, n0 = 64 * nb;
    const int sc = cm(n0 + lane);
    float wv[64];
#pragma unroll
    for (int kk = 0; kk < 64; ++kk) wv[kk] = __builtin_nontemporal_load(W + (size_t)(k0 + kk) * N + sc);
#pragma unroll
    for (int kk = 0; kk < 64; ++kk) scr[kk * 65 + lane] = wv[kk];
    LDS_WAIT(); CFENCE();
    const int c = lane & 7;
#pragma unroll
    for (int j = 0; j < 8; ++j) { const int n = (lane >> 3) + 8 * j; const LAS float* s = scr + (8 * c) * 65 + n;
        u32x4 o; o.x = cvt_pk_bf16(s[0 * 65], s[1 * 65]); o.y = cvt_pk_bf16(s[2 * 65], s[3 * 65]); o.z = cvt_pk_bf16(s[4 * 65], s[5 * 65]); o.w = cvt_pk_bf16(s[6 * 65], s[7 * 65]);
        if (NTS) __builtin_nontemporal_store(o, (u32x4*)(WT + (size_t)(n0 + n) * K + k0 + 8 * c)); else *(u32x4*)(WT + (size_t)(n0 + n) * K + k0 + 8 * c) = o; }
    LDS_WAIT(); CFENCE();
}
struct ColId { __device__ __forceinline__ int operator()(int n) const { return n; } };
struct ColWin {
    __device__ __forceinline__ int operator()(int np) const {
        if (np < 4096) { const int seg = np >> 11, w = np & 2047, h = w >> 8, r = w & 255; return seg * 2048 + h * 256 + (r >> 1) + 128 * (r & 1); }
        if (np < 14336 || np >= 18432) return np;
        const int w = np - 14336; return 14336 + (w >> 1) + 2048 * (w & 1);
    }
};
__device__ __forceinline__ void sincos_tab(int pidx, int i, float& c, float& s) {
    const int pos = pidx < SEQ ? pidx : 16384 + (pidx - SEQ);
    const float inv = (float)exp2(-(double)i * (13.287712379549449 / 128.0));
    const float ang = (float)pos * inv;
    const double a = (double)ang;
    const double n = rint(a * 0.15915494309189535);
    double r = fma(-n, 6.283185307179586, a); r = fma(-n, 2.4492935982947064e-16, r);
    const double r2 = r * r;
    double ps = -1.0 / 51090942171709440000.0;
    ps = ps * r2 + 1.0 / 121645100408832000.0; ps = ps * r2 - 1.0 / 355687428096000.0; ps = ps * r2 + 1.0 / 1307674368000.0; ps = ps * r2 - 1.0 / 6227020800.0;
    ps = ps * r2 + 1.0 / 39916800.0; ps = ps * r2 - 1.0 / 362880.0; ps = ps * r2 + 1.0 / 5040.0; ps = ps * r2 - 1.0 / 120.0; ps = ps * r2 + 1.0 / 6.0; ps = 1.0 - ps * r2;
    double pc = 1.0 / 1124000727777607680000.0;
    pc = pc * r2 - 1.0 / 2432902008176640000.0; pc = pc * r2 + 1.0 / 6402373705728000.0; pc = pc * r2 - 1.0 / 20922789888000.0; pc = pc * r2 + 1.0 / 87178291200.0;
    pc = pc * r2 - 1.0 / 479001600.0; pc = pc * r2 + 1.0 / 3628800.0; pc = pc * r2 - 1.0 / 40320.0; pc = pc * r2 + 1.0 / 720.0; pc = pc * r2 - 1.0 / 24.0; pc = pc * r2 + 0.5; pc = 1.0 - pc * r2;
    s = (float)(r * ps); c = (float)pc;
}
__device__ __forceinline__ void rms_row_to_bf16(const float* xr_, const float* g, bf16_t* orow, int lane) {
    const f32x4* xr = (const f32x4*)xr_ + lane; f32x4 v[8]; float s = 0.f;
#pragma unroll
    for (int j = 0; j < 8; ++j) { v[j] = __builtin_nontemporal_load(xr + 64 * j); s += (v[j][0] * v[j][0] + v[j][1] * v[j][1]) + (v[j][2] * v[j][2] + v[j][3] * v[j][3]); }
    const float r = rsqrtf(wave_sum(s) * (1.0f / DM) + EPS);
#pragma unroll
    for (int j = 0; j < 8; ++j) { const f32x4 gg = ((const f32x4*)g)[lane + 64 * j]; const f32x4 y = v[j] * r * gg;
        u32x2 w; w.x = cvt_pk_bf16(y[0], y[1]); w.y = cvt_pk_bf16(y[2], y[3]); ((u32x2*)orow)[lane + 64 * j] = w; }
}
__device__ __forceinline__ void p0_prologue(const Frame& F) {
    const int tid = opaque_tid(), lane = tid & 63;
    LAS float* scr = (LAS float*)(F.lds + F.wave * 16640);
    const int gw = F.vcu * NWAVES + F.wave, NGW = F.G * NWAVES;
    constexpr int I_IN = (DM / 64) * (DIN / 64), I_PR = (DVT / 64) * (DM / 64), I_SQ = (DM / 64) * (DM / 64), I_UP = (DM / 64) * (DFF / 64), I_DN = (DFF / 64) * (DM / 64);
    constexpr int NITEMS = I_IN + I_PR + 2 * I_SQ + 2 * I_UP + I_DN;
    for (int it = gw; it < NITEMS; it += NGW) {
        int r = it;
        if (r < I_IN) { transpose_item<false>(INP(F, I_WIN), DIN, DM, WSB(F, WS_WINT), scr, r, lane, ColWin()); continue; } r -= I_IN;
        if (r < I_PR) { transpose_item<true>(INP(F, I_PRET), DM, DVT, WSB(F, WS_PRETT), scr, r, lane, ColId()); continue; } r -= I_PR;
        if (r < I_SQ) { transpose_item<true>(INP(F, I_PCONV), DM, DM, WSB(F, WS_PCONVT), scr, r, lane, ColId()); continue; } r -= I_SQ;
        if (r < I_SQ) { transpose_item<true>(INP(F, I_WO), DM, DM, WSB(F, WS_WOT), scr, r, lane, ColId()); continue; } r -= I_SQ;
        if (r < I_UP) { transpose_item<true>(INP(F, I_WUP), DFF, DM, WSB(F, WS_WUGT), scr, r, lane, ColId()); continue; } r -= I_UP;
        if (r < I_UP) { transpose_item<true>(INP(F, I_WGATE), DFF, DM, WSB(F, WS_WUGT) + (size_t)DFF * DM, scr, r, lane, ColId()); continue; } r -= I_UP;
        transpose_item<true>(INP(F, I_WDOWN), DM, DFF, WSB(F, WS_WDT), scr, r, lane, ColId());
    }
    for (int m = gw; m < MT; m += NGW) rms_row_to_bf16(xrow(F, m), INP(F, I_GPREMIX), WSB(F, WS_HN) + (size_t)m * DM, lane);
    const int gt = F.vcu * NTHREADS + tid, NGT = F.G * NTHREADS;
    for (int e = gt; e < 2052 * 128; e += NGT) { float c, s; sincos_tab(e >> 7, e & 127, c, s); ((f32x2*)WSF(F, WS_ROPE))[e] = (f32x2){c, s}; }
}

constexpr int FL_KBUF = 0, FL_PBUF = 65536, FL_RED = 81920, FL_QBUF = 86016;
__device__ __forceinline__ void flash_unit(const Frame& F, int b, int h, int qb) {
    constexpr int ABL = 0;
    LAS unsigned char* lds = F.lds;
    const int lane = opaque_tid() & 63;
    const int w = F.wave, fr = lane & 15, fq = lane >> 4;
    const int i0 = qb * 128; const int mrow0 = b * SEQ;
    const float L2g = log2gamma(h);
    { const char* qb_ = (const char*)WSB(F, WS_Q) + ((size_t)(mrow0 + i0 + 16 * w) * DM + h * DK) * 2;
      const int r0 = lane >> 5, cp = lane & 31;
#pragma unroll
      for (int i = 0; i < 8; ++i) { const int row = r0 + 2 * i; const unsigned off = (unsigned)(row * (DM * 2) + ((cp ^ row) * 16));
          __builtin_amdgcn_global_load_lds((const unsigned*)(qb_ + off), (LAS unsigned*)(lds + FL_QBUF + w * 8192 + i * 1024), 16, 0, 0); } }
    f32x4 acc[4][8];
#pragma unroll
    for (int ef = 0; ef < 4; ++ef)
#pragma unroll
        for (int qf = 0; qf < 8; ++qf) acc[ef][qf] = (f32x4){0.f, 0.f, 0.f, 0.f};
    const int nkb = 2 * qb + 2, sg = qb >> 2, jb0 = 8 * sg;
    const char* kbase = (const char*)WSB(F, WS_K) + ((size_t)mrow0 * DM + h * DK) * 2;
    const int krow0 = 2 * w + (lane >> 5);
    const unsigned ksrc = (unsigned)(krow0 * (DM * 2) + (((lane & 31) ^ (krow0 & 15)) * 16));
#define FL_STAGE_K(jb, buf) do { if (ABL & 1) break; const char* kb_ = kbase + (size_t)(jb) * (64 * DM * 2); _Pragma("unroll") for (int i = 0; i < 4; ++i) \
        __builtin_amdgcn_global_load_lds((const unsigned*)(kb_ + (size_t)i * (16 * DM * 2) + ksrc), (LAS unsigned*)(lds + FL_KBUF + (buf) * 32768 + i * 8192 + w * 1024), 16, 0, 0); } while (0)
    FL_STAGE_K(jb0, 0);
    const char* vbase = (const char*)WSB(F, WS_VT) + ((size_t)(h * DVH + 64 * w) * LDV + mrow0) * 2;
    float c2[4];
#pragma unroll
    for (int r = 0; r < 4; ++r) c2[r] = __builtin_amdgcn_exp2f(-L2g * (float)(4 * (lane >> 4) + r));
    bf16x8 Vf[4][2];
    if (sg > 0) {
        const char* sb_ = (const char*)WSB(F, WS_ST) + ((size_t)(((b * NH + h) * 3 + (sg - 1)) * DVH + 64 * w) * DK) * 2;
        const unsigned soff = (unsigned)(fr * (DK * 2) + fq * 16);
#pragma unroll
        for (int ef = 0; ef < 4; ++ef)
#pragma unroll
            for (int ks = 0; ks < 2; ++ks) Vf[ef][ks] = *(const bf16x8*)(sb_ + (size_t)ef * (16 * DK * 2) + ks * 64 + soff);
        VM_WAIT(); RAW_BAR();
#pragma unroll
        for (int ks = 0; ks < 8; ++ks) {
#pragma unroll
            for (int qf = 0; qf < 8; ++qf) { const bf16x8 Qf = *(const LAS bf16x8*)(lds + FL_QBUF + (16 * qf + fr) * 512 + (((ks * 4 + fq) ^ fr) * 16));
#pragma unroll
                for (int ef = 0; ef < 4; ++ef) acc[ef][qf] = __builtin_amdgcn_mfma_f32_16x16x32_bf16(Vf[ef][ks & 1], Qf, acc[ef][qf], 0, 0, 0); }
            if (ks < 6) {
#pragma unroll
                for (int ef = 0; ef < 4; ++ef) Vf[ef][ks & 1] = *(const bf16x8*)(sb_ + (size_t)ef * (16 * DK * 2) + (ks + 2) * 64 + soff); } }
#pragma unroll
        for (int qf = 0; qf < 8; ++qf) { const float lam = __builtin_amdgcn_exp2f(L2g * (float)(i0 + 16 * qf + fr - 512 * sg + 1));
#pragma unroll
            for (int ef = 0; ef < 4; ++ef) acc[ef][qf] *= lam; }
    }
    { const char* v0_ = vbase + (size_t)jb0 * 128; const unsigned voff = (unsigned)((lane & 15) * (LDV * 2) + (lane >> 4) * 16);
#pragma unroll
      for (int ef = 0; ef < 4; ++ef)
#pragma unroll
          for (int ks = 0; ks < 2; ++ks) Vf[ef][ks] = *(const bf16x8*)(v0_ + (size_t)ef * (16 * LDV * 2) + ks * 64 + voff); }
    VM_WAIT();
    for (int jb = jb0; jb < nkb; ++jb) {
        RAW_BAR();
        const bool more = jb + 1 < nkb;
        if (more) FL_STAGE_K(jb + 1, (jb + 1) & 1);
        int fr = lane & 15, fq = lane >> 4; asm volatile("" : "+v"(fr), "+v"(fq));
        f32x4 sacc[4];
        const LAS unsigned char* kl = lds + FL_KBUF + (jb & 1) * 32768 + fr * 512;
        const LAS unsigned char* ql_ = lds + FL_QBUF + w * 8192 + fr * 512;
#pragma unroll
        for (int kf = 0; kf < 4; ++kf) sacc[kf] = (f32x4){0.f, 0.f, 0.f, 0.f};
        if (!(ABL & 2)) {
          bf16x8 Qn, Kn[4];
          { const int sw = (fq ^ fr) * 16; Qn = *(const LAS bf16x8*)(ql_ + sw);
#pragma unroll
            for (int kf = 0; kf < 4; ++kf) Kn[kf] = *(const LAS bf16x8*)(kl + kf * 8192 + sw); }
#pragma unroll
          for (int ks = 0; ks < 8; ++ks) { const bf16x8 Qc = Qn; bf16x8 Kc[4];
#pragma unroll
              for (int kf = 0; kf < 4; ++kf) Kc[kf] = Kn[kf];
              if (ks < 7) { const int sw = (((ks + 1) * 4 + fq) ^ fr) * 16; Qn = *(const LAS bf16x8*)(ql_ + sw);
#pragma unroll
                  for (int kf = 0; kf < 4; ++kf) Kn[kf] = *(const LAS bf16x8*)(kl + kf * 8192 + sw); }
              __builtin_amdgcn_sched_barrier(0);
#pragma unroll
              for (int kf = 0; kf < 4; ++kf) sacc[kf] = __builtin_amdgcn_mfma_f32_16x16x32_bf16(Kc[kf], Qc, sacc[kf], 0, 0, 0);
              __builtin_amdgcn_sched_barrier(0); } }
        { const int ql = 16 * w + fr, iq = i0 + ql;
          const float rowf = __builtin_amdgcn_exp2f(L2g * (float)(iq - 64 * jb));
          const bool diag = jb >= 2 * qb;
#pragma unroll
          for (int kf = 0; kf < 4; ++kf) { const int jbase = 64 * jb + 16 * kf + 4 * fq; float pv[4];
              const float rk = rowf * __builtin_amdgcn_exp2f(L2g * (float)(-16 * kf));
#pragma unroll
              for (int r = 0; r < 4; ++r) { if (ABL & 8) { pv[r] = sacc[kf][r]; continue; } pv[r] = sacc[kf][r] * (rk * c2[r]); if (diag) pv[r] = (iq - (jbase + r)) >= 0 ? pv[r] : 0.f; }
              u32x2 pw; pw.x = cvt_pk_bf16(pv[0], pv[1]); pw.y = cvt_pk_bf16(pv[2], pv[3]);
              *(LAS u32x2*)(lds + FL_PBUF + ql * 128 + (((kf * 2 + (fq >> 1)) ^ ((ql >> 1) & 7)) * 16) + (fq & 1) * 8) = pw; } }
        LDS_WAIT(); RAW_BAR();
        { const LAS unsigned char* pl = lds + FL_PBUF + fr * 128;
          const char* vn_ = vbase + (size_t)(jb + 1) * 128; const unsigned voff = (unsigned)(fr * (LDV * 2) + fq * 16);
#pragma unroll
          for (int ks = 0; ks < 2; ++ks) { const int sw = (((ks * 4 + fq) ^ ((fr >> 1) & 7)) * 16);
              bf16x8 Pn0 = *(const LAS bf16x8*)(pl + sw), Pn1 = *(const LAS bf16x8*)(pl + 2048 + sw);
#pragma unroll
              for (int qf = 0; qf < 8; ++qf) { const bf16x8 Pc = Pn0; Pn0 = Pn1;
                  if (qf < 6) Pn1 = *(const LAS bf16x8*)(pl + (qf + 2) * 2048 + sw);
                  __builtin_amdgcn_sched_barrier(0);
#pragma unroll
                  for (int ef = 0; ef < 4; ++ef) { if (ABL & 4) { asm volatile("" :: "v"(Pc)); continue; } acc[ef][qf] = __builtin_amdgcn_mfma_f32_16x16x32_bf16(Vf[ef][ks], Pc, acc[ef][qf], 0, 0, 0); }
                  __builtin_amdgcn_sched_barrier(0); }
              if (more && !(ABL & 1)) {
#pragma unroll
                  for (int ef = 0; ef < 4; ++ef) Vf[ef][ks] = *(const bf16x8*)(vn_ + (size_t)ef * (16 * LDV * 2) + ks * 64 + voff); } } }
        asm volatile("s_waitcnt vmcnt(8)" ::: "memory");
    }
#undef FL_STAGE_K
    LAS float* red = (LAS float*)(lds + FL_RED);
    float ss[8];
#pragma unroll
    for (int qf = 0; qf < 8; ++qf) { float s = 0.f;
#pragma unroll
        for (int ef = 0; ef < 4; ++ef) { const f32x4 a = acc[ef][qf]; s += (a[0] * a[0] + a[1] * a[1]) + (a[2] * a[2] + a[3] * a[3]); }
        s += __shfl_xor(s, 16); s += __shfl_xor(s, 32); ss[qf] = s; }
    if (fq == 0) {
#pragma unroll
        for (int qf = 0; qf < 8; ++qf) red[w * 128 + 16 * qf + fr] = ss[qf]; }
    LDS_WAIT(); RAW_BAR();
    { const size_t ub = ((size_t)(mrow0 + i0) * DVT + h * DVH + 64 * w) * 2;
      const char* gbase = (const char*)WSB(F, WS_GR) + ub; char* obase = (char*)WSB(F, WS_ARET) + ub;
      const unsigned loff = (unsigned)(fr * (DVT * 2) + fq * 8);
#pragma unroll
      for (int qf = 0; qf < 8; ++qf) { float tot = 0.f;
#pragma unroll
          for (int ww = 0; ww < 8; ++ww) tot += red[ww * 128 + 16 * qf + fr];
          const float rstd = rsqrtf(tot * (1.0f / DVH) + EPS);
#pragma unroll
          for (int ef = 0; ef < 4; ++ef) { const size_t uo = (size_t)qf * (16 * DVT * 2) + ef * 32;
              const u32x2 g = *(const u32x2*)(gbase + uo + loff); const f32x4 a = acc[ef][qf];
              u32x2 o; o.x = cvt_pk_bf16(a[0] * rstd * bf_lo(g.x), a[1] * rstd * bf_hi(g.x)); o.y = cvt_pk_bf16(a[2] * rstd * bf_lo(g.y), a[3] * rstd * bf_hi(g.y));
              *(u32x2*)(obase + uo + loff) = o; }
          CFENCE(); } }
    LDS_WAIT(); RAW_BAR();
}

constexpr int SS_Q = 110592, SS_K = 126976, SS_D = 143360, SS_RED = 143616;
struct StreamSt {
    f32x4 cr[4], vd[4], bc[4];
    const char* s0; char* s1;
    unsigned toff; int git;
    const LAS float* sq; const LAS float* sk; float g4;
};
__device__ __forceinline__ void stream_load(StreamSt& T, int it) {
#pragma unroll
    for (int k = 0; k < 4; ++k) T.bc[k] = __builtin_nontemporal_load((const f32x4*)(T.s0 + (size_t)((4 * it + k) * (DVH * 4)) + T.toff));
}
__device__ __forceinline__ void stream_proc(StreamSt& T, int it) {
#pragma unroll
    for (int k = 0; k < 4; ++k) { const int d = 4 * it + k; const f32x4 s = T.bc[k]; f32x4 sn = s * T.g4;
#pragma unroll
        for (int j = 0; j < 4; ++j) { T.cr[j] += s * T.sq[j * 256 + d]; sn += T.vd[j] * T.sk[j * 256 + d]; }
        __builtin_nontemporal_store(sn, (f32x4*)(T.s1 + (size_t)(d * (DVH * 4)) + T.toff)); }
}
constexpr int F6_KBUF = 0, F6_PBUF = 65536, F6_RED = 73728, F6_QBUF = 77824;
template <bool STREAM>
__device__ __forceinline__ void flash64_unit(const Frame& F, int b, int h, int qb, StreamSt& T) {
    LAS unsigned char* lds = F.lds;
    const int lane = opaque_tid() & 63;
    const int w = F.wave, qfw = w & 3, kf0 = 2 * (w >> 2);
    const int i0 = qb * 64; const int mrow0 = b * SEQ;
    const float L2g = log2gamma(h);
    { const char* qb_ = (const char*)WSB(F, WS_Q) + ((size_t)(mrow0 + i0) * DM + h * DK) * 2;
      const int r0 = lane >> 5, cp = lane & 31;
#pragma unroll
      for (int i = 0; i < 4; ++i) { const int row = 8 * w + 2 * i + r0; const unsigned off = (unsigned)(row * (DM * 2) + ((cp ^ (row & 15)) * 16));
          __builtin_amdgcn_global_load_lds((const unsigned*)(qb_ + off), (LAS unsigned*)(lds + F6_QBUF + (4 * w + i) * 1024), 16, 0, 0); } }
    f32x4 acc[4][4];
#pragma unroll
    for (int ef = 0; ef < 4; ++ef)
#pragma unroll
        for (int qf = 0; qf < 4; ++qf) acc[ef][qf] = (f32x4){0.f, 0.f, 0.f, 0.f};
    const int nkb = qb + 1;
    const char* kbase = (const char*)WSB(F, WS_K) + ((size_t)mrow0 * DM + h * DK) * 2;
    const int krow0 = 2 * w + (lane >> 5);
    const unsigned ksrc = (unsigned)(krow0 * (DM * 2) + (((lane & 31) ^ (krow0 & 15)) * 16));
#define F6_STAGE_K(jb, buf) do { const char* kb_ = kbase + (size_t)(jb) * (64 * DM * 2); _Pragma("unroll") for (int i = 0; i < 4; ++i) \
        __builtin_amdgcn_global_load_lds((const unsigned*)(kb_ + (size_t)i * (16 * DM * 2) + ksrc), (LAS unsigned*)(lds + F6_KBUF + (buf) * 32768 + i * 8192 + w * 1024), 16, 0, 0); } while (0)
    F6_STAGE_K(0, 0);
    const char* vbase = (const char*)WSB(F, WS_VT) + ((size_t)(h * DVH + 64 * w) * LDV + mrow0) * 2;
    float c2[4];
#pragma unroll
    for (int r = 0; r < 4; ++r) c2[r] = __builtin_amdgcn_exp2f(-L2g * (float)(4 * (lane >> 4) + r));
    bf16x8 Vf[4][2];
    { const unsigned voff = (unsigned)((lane & 15) * (LDV * 2) + (lane >> 4) * 16);
#pragma unroll
      for (int ef = 0; ef < 4; ++ef)
#pragma unroll
          for (int ks = 0; ks < 2; ++ks) Vf[ef][ks] = *(const bf16x8*)(vbase + (size_t)ef * (16 * LDV * 2) + ks * 64 + voff); }
    VM_WAIT();
    for (int jb = 0; jb < nkb; ++jb) {
        RAW_BAR();
        const bool more = jb + 1 < nkb;
        if (more) F6_STAGE_K(jb + 1, (jb + 1) & 1);
        int fr = lane & 15, fq = lane >> 4; asm volatile("" : "+v"(fr), "+v"(fq));
        f32x4 sacc[2];
        sacc[0] = (f32x4){0.f, 0.f, 0.f, 0.f}; sacc[1] = (f32x4){0.f, 0.f, 0.f, 0.f};
        { const LAS unsigned char* kl = lds + F6_KBUF + (jb & 1) * 32768 + (16 * kf0 + fr) * 512;
          const LAS unsigned char* ql_ = lds + F6_QBUF + (16 * qfw + fr) * 512;
          bf16x8 Qa, Ka0, Ka1, Qb, Kb0, Kb1;
          { const int s0 = (fq ^ fr) * 16, s1 = ((4 + fq) ^ fr) * 16;
            Qa = *(const LAS bf16x8*)(ql_ + s0); Ka0 = *(const LAS bf16x8*)(kl + s0); Ka1 = *(const LAS bf16x8*)(kl + 8192 + s0);
            Qb = *(const LAS bf16x8*)(ql_ + s1); Kb0 = *(const LAS bf16x8*)(kl + s1); Kb1 = *(const LAS bf16x8*)(kl + 8192 + s1); }
#pragma unroll
          for (int ks = 0; ks < 8; ++ks) { const bf16x8 Qc = Qa, Kc0 = Ka0, Kc1 = Ka1;
              Qa = Qb; Ka0 = Kb0; Ka1 = Kb1;
              if (ks < 6) { const int sw = (((ks + 2) * 4 + fq) ^ fr) * 16; Qb = *(const LAS bf16x8*)(ql_ + sw); Kb0 = *(const LAS bf16x8*)(kl + sw); Kb1 = *(const LAS bf16x8*)(kl + 8192 + sw); }
              __builtin_amdgcn_sched_barrier(0);
              sacc[0] = __builtin_amdgcn_mfma_f32_16x16x32_bf16(Kc0, Qc, sacc[0], 0, 0, 0);
              sacc[1] = __builtin_amdgcn_mfma_f32_16x16x32_bf16(Kc1, Qc, sacc[1], 0, 0, 0);
              __builtin_amdgcn_sched_barrier(0); } }
        { const int ql = 16 * qfw + fr, iq = i0 + ql;
          const float rowf = __builtin_amdgcn_exp2f(L2g * (float)(iq - 64 * jb));
          const bool diag = jb == qb;
#pragma unroll
          for (int kk = 0; kk < 2; ++kk) { const int kf = kf0 + kk; const int jbase = 64 * jb + 16 * kf + 4 * fq; float pv[4];
              const float rk = rowf * __builtin_amdgcn_exp2f(L2g * (float)(-16 * kf));
#pragma unroll
              for (int r = 0; r < 4; ++r) { pv[r] = sacc[kk][r] * (rk * c2[r]); if (diag) pv[r] = (iq - (jbase + r)) >= 0 ? pv[r] : 0.f; }
              u32x2 pw; pw.x = cvt_pk_bf16(pv[0], pv[1]); pw.y = cvt_pk_bf16(pv[2], pv[3]);
              *(LAS u32x2*)(lds + F6_PBUF + ql * 128 + (((kf * 2 + (fq >> 1)) ^ ((ql >> 1) & 7)) * 16) + (fq & 1) * 8) = pw; } }
        LDS_WAIT(); RAW_BAR();
        { const LAS unsigned char* pl = lds + F6_PBUF + fr * 128;
          const char* vn_ = vbase + (size_t)(jb + 1) * 128; const unsigned voff = (unsigned)(fr * (LDV * 2) + fq * 16);
          bf16x8 Pf[2][4];
#pragma unroll
          for (int ks = 0; ks < 2; ++ks) { const int sw = (((ks * 4 + fq) ^ ((fr >> 1) & 7)) * 16);
#pragma unroll
              for (int qf = 0; qf < 4; ++qf) Pf[ks][qf] = *(const LAS bf16x8*)(pl + qf * 2048 + sw); }
#pragma unroll
          for (int ks = 0; ks < 2; ++ks) {
#pragma unroll
              for (int qf = 0; qf < 4; ++qf)
#pragma unroll
                  for (int ef = 0; ef < 4; ++ef) acc[ef][qf] = __builtin_amdgcn_mfma_f32_16x16x32_bf16(Vf[ef][ks], Pf[ks][qf], acc[ef][qf], 0, 0, 0);
              if (more) {
#pragma unroll
                  for (int ef = 0; ef < 4; ++ef) Vf[ef][ks] = *(const bf16x8*)(vn_ + (size_t)ef * (16 * LDV * 2) + ks * 64 + voff); } } }
        if constexpr (STREAM) {
            const int it = T.git; T.git = it + 1;
            if (it < 63) { stream_proc(T, it); stream_load(T, it + 1); if (more) asm volatile("s_waitcnt vmcnt(16)" ::: "memory"); }
            else if (it == 63) { stream_proc(T, it); if (more) asm volatile("s_waitcnt vmcnt(12)" ::: "memory"); }
            else { if (more) asm volatile("s_waitcnt vmcnt(8)" ::: "memory"); }
        } else {
            asm volatile("s_waitcnt vmcnt(8)" ::: "memory");
        }
    }
#undef F6_STAGE_K
    LAS float* red = (LAS float*)(lds + F6_RED);
    { const int fr = lane & 15, fq = lane >> 4;
      float ss[4];
#pragma unroll
      for (int qf = 0; qf < 4; ++qf) { float s = 0.f;
#pragma unroll
          for (int ef = 0; ef < 4; ++ef) { const f32x4 a = acc[ef][qf]; s += (a[0] * a[0] + a[1] * a[1]) + (a[2] * a[2] + a[3] * a[3]); }
          s += __shfl_xor(s, 16); s += __shfl_xor(s, 32); ss[qf] = s; }
      if (fq == 0) {
#pragma unroll
          for (int qf = 0; qf < 4; ++qf) red[w * 64 + 16 * qf + fr] = ss[qf]; }
      LDS_WAIT(); RAW_BAR();
      const size_t ub = ((size_t)(mrow0 + i0) * DVT + h * DVH + 64 * w) * 2;
      const char* gbase = (const char*)WSB(F, WS_GR) + ub; char* obase = (char*)WSB(F, WS_ARET) + ub;
      const unsigned loff = (unsigned)(fr * (DVT * 2) + fq * 8);
#pragma unroll
      for (int qf = 0; qf < 4; ++qf) { float tot = 0.f;
#pragma unroll
          for (int ww = 0; ww < 8; ++ww) tot += red[ww * 64 + 16 * qf + fr];
          const float rstd = rsqrtf(tot * (1.0f / DVH) + EPS);
#pragma unroll
          for (int ef = 0; ef < 4; ++ef) { const size_t uo = (size_t)qf * (16 * DVT * 2) + ef * 32;
              const u32x2 g = *(const u32x2*)(gbase + uo + loff); const f32x4 a = acc[ef][qf];
              u32x2 o; o.x = cvt_pk_bf16(a[0] * rstd * bf_lo(g.x), a[1] * rstd * bf_hi(g.x)); o.y = cvt_pk_bf16(a[2] * rstd * bf_lo(g.y), a[3] * rstd * bf_hi(g.y));
              *(u32x2*)(obase + uo + loff) = o; }
          CFENCE(); } }
    LDS_WAIT(); RAW_BAR();
}

constexpr int SM_QS = 0, SM_KS = 4096, SM_VS = 8192, SM_SD = 16384, SM_RED = 16640, SM_XR = 32768;
__device__ __forceinline__ void sample_unit(const Frame& F, int b, int h) {
    LAS unsigned char* lds = F.lds;
    const int tid = opaque_tid();
    const int lane = tid & 63, w = tid >> 6;
    LAS float* qs = (LAS float*)(lds + SM_QS); LAS float* ks = (LAS float*)(lds + SM_KS); LAS float* vs = (LAS float*)(lds + SM_VS);
    LAS float* sd = (LAS float*)(lds + SM_SD); LAS float* red = (LAS float*)(lds + SM_RED); LAS float* xr = (LAS float*)(lds + SM_XR);
    const int m0 = MP + 4 * b;
    const float L2g = log2gamma(h);
    const int e4 = (tid & 127) * 4, dg = tid >> 7;
    const char* s0 = (const char*)(INP(F, I_SRET) + ((size_t)(b * NH + h) * DK) * DVH);
    char* s1 = (char*)(F.out + OFF_RS + ((size_t)(b * NH + h) * DK) * DVH);
    const unsigned toff = (unsigned)((dg * DVH + e4) * 4);
    f32x4 bA[16], bB[16];
#define SM_LOAD(buf, bt) do { _Pragma("unroll") for (int k_ = 0; k_ < 16; ++k_) buf[k_] = __builtin_nontemporal_load((const f32x4*)(s0 + (size_t)(((bt) * 16 + k_) * (4 * DVH * 4)) + toff)); } while (0)
    SM_LOAD(bA, 0); SM_LOAD(bB, 1);
    for (int e = tid; e < 1024; e += NTHREADS) { const int t = e >> 8, d = e & 255, dp = d < 128 ? 2 * d : 2 * (d - 128) + 1;
        qs[e] = bf1(WSB(F, WS_Q)[(size_t)(m0 + t) * DM + h * DK + dp]); ks[e] = bf1(WSB(F, WS_K)[(size_t)(m0 + t) * DM + h * DK + dp]); }
    { const int e = tid; const u32x2 vv = *(const u32x2*)(WSB(F, WS_VT) + (size_t)(h * DVH + e) * LDV + m0);
      vs[0 * 512 + e] = bf_lo(vv.x); vs[1 * 512 + e] = bf_hi(vv.x); vs[2 * 512 + e] = bf_lo(vv.y); vs[3 * 512 + e] = bf_hi(vv.y); }
    LDS_WAIT(); RAW_BAR();
#pragma unroll
    for (int pp = 0; pp < 2; ++pp) { const int pr = 2 * w + pp, t = pr >> 2, j = pr & 3; float s = 0.f;
#pragma unroll
        for (int i = 0; i < 4; ++i) s += qs[t * 256 + lane + 64 * i] * ks[j * 256 + lane + 64 * i];
        s = wave_sum(s);
        if (lane == 0) sd[pr] = (j <= t) ? s * __builtin_amdgcn_exp2f(L2g * (float)(t - j)) : 0.f; }
    f32x4 vd[4];
#pragma unroll
    for (int j = 0; j < 4; ++j) { const float dj = __builtin_amdgcn_exp2f(L2g * (float)(3 - j)); vd[j] = (f32x4){vs[j * 512 + e4], vs[j * 512 + e4 + 1], vs[j * 512 + e4 + 2], vs[j * 512 + e4 + 3]} * dj; }
    const float g4 = __builtin_amdgcn_exp2f(L2g * 4.0f);
    f32x4 cr[4];
#pragma unroll
    for (int t = 0; t < 4; ++t) cr[t] = (f32x4){0.f, 0.f, 0.f, 0.f};
#define SM_PROC(buf, bt) do { _Pragma("unroll") for (int k_ = 0; k_ < 16; ++k_) { const int d = ((bt) * 16 + k_) * 4 + dg; const f32x4 s = buf[k_]; f32x4 sn = s * g4; \
        _Pragma("unroll") for (int j = 0; j < 4; ++j) { cr[j] += s * qs[j * 256 + d]; sn += vd[j] * ks[j * 256 + d]; } \
        __builtin_nontemporal_store(sn, (f32x4*)(s1 + (size_t)(((bt) * 16 + k_) * (4 * DVH * 4)) + toff)); } } while (0)
    SM_PROC(bA, 0); SM_LOAD(bA, 2);
    SM_PROC(bB, 1); SM_LOAD(bB, 3);
    SM_PROC(bA, 2);
    SM_PROC(bB, 3);
#undef SM_LOAD
#undef SM_PROC
#pragma unroll
    for (int t = 0; t < 4; ++t) *(LAS f32x4*)(xr + (dg * 4 + t) * 512 + e4) = cr[t];
    LDS_WAIT(); RAW_BAR();
    { const int e = tid; float o[4];
#pragma unroll
      for (int t = 0; t < 4; ++t) { float c = (xr[(0 * 4 + t) * 512 + e] + xr[(1 * 4 + t) * 512 + e]) + (xr[(2 * 4 + t) * 512 + e] + xr[(3 * 4 + t) * 512 + e]);
          float in = 0.f;
#pragma unroll
          for (int j = 0; j < 4; ++j) in += sd[t * 4 + j] * vs[j * 512 + e];
          o[t] = in + c * __builtin_amdgcn_exp2f(L2g * (float)(t + 1)); }
#pragma unroll
      for (int t = 0; t < 4; ++t) { const float s = wave_sum(o[t] * o[t]); if (lane == 0) red[w * 4 + t] = s; }
      LDS_WAIT(); RAW_BAR();
#pragma unroll
      for (int t = 0; t < 4; ++t) { float tot = 0.f;
#pragma unroll
          for (int ww = 0; ww < 8; ++ww) tot += red[ww * 4 + t];
          const float rstd = rsqrtf(tot * (1.0f / DVH) + EPS);
          const size_t off = (size_t)(m0 + t) * DVT + h * DVH + e;
          const float val = o[t] * rstd * bf1(WSB(F, WS_GR)[off]);
          WSB(F, WS_ARET)[off] = (bf16_t)(cvt_pk_bf16(val, 0.f) & 0xffffu); } }
    LDS_WAIT(); RAW_BAR();
}

__device__ __forceinline__ void conv_branch_range(const Frame& F, int i0, int i1) {
#pragma unroll 2
    for (int it = i0 + opaque_tid(); it < i1; it += NTHREADS) { const int m = it >> 8, c = (it & 255) * 8;
        f32x4 u2a, u2b, u1a, u1b, u0a, u0b;
        unpack8(*(const u32x4*)(WSB(F, WS_CPR) + (size_t)m * DM + c), u2a, u2b);
        const f32x4 z = (f32x4){0.f, 0.f, 0.f, 0.f}; u1a = z; u1b = z; u0a = z; u0b = z;
        if (m < MP) { const int t = m & (SEQ - 1);
            if (t >= 1) unpack8(*(const u32x4*)(WSB(F, WS_CPR) + (size_t)(m - 1) * DM + c), u1a, u1b);
            if (t >= 2) unpack8(*(const u32x4*)(WSB(F, WS_CPR) + (size_t)(m - 2) * DM + c), u0a, u0b);
        } else { const int ms = m - MP, b = ms >> 2, t = ms & 3;
            if (t + 1 >= 2) unpack8(*(const u32x4*)(WSB(F, WS_CPR) + (size_t)(m - 1) * DM + c), u1a, u1b); else { const float* sp = INP(F, I_SCONV) + ((size_t)b * 2 + (t + 1)) * DM + c; u1a = *(const f32x4*)sp; u1b = *(const f32x4*)(sp + 4); }
            if (t >= 2) unpack8(*(const u32x4*)(WSB(F, WS_CPR) + (size_t)(m - 2) * DM + c), u0a, u0b); else { const float* sp = INP(F, I_SCONV) + ((size_t)b * 2 + t) * DM + c; u0a = *(const f32x4*)sp; u0b = *(const f32x4*)(sp + 4); } }
        const f32x4 w0a = *(const f32x4*)(INP(F, I_CONVW) + c), w0b = *(const f32x4*)(INP(F, I_CONVW) + c + 4), w1a = *(const f32x4*)(INP(F, I_CONVW) + DM + c), w1b = *(const f32x4*)(INP(F, I_CONVW) + DM + c + 4),
                    w2a = *(const f32x4*)(INP(F, I_CONVW) + 2 * DM + c), w2b = *(const f32x4*)(INP(F, I_CONVW) + 2 * DM + c + 4);
        f32x4 ga, gb; unpack8(__builtin_nontemporal_load((const u32x4*)(WSB(F, WS_GB) + (size_t)m * DM + c)), ga, gb);
        const f32x4 oa = (w0a * u0a + w1a * u1a + w2a * u2a) * ga, ob = (w0b * u0b + w1b * u1b + w2b * u2b) * gb;
        *(u32x4*)(WSB(F, WS_ACONV) + (size_t)m * DM + c) = pack8(oa, ob); }
}
__device__ __forceinline__ void kht_prep(const Frame& F) {
    LAS float* scr = (LAS float*)(F.lds + F.wave * 16640);
    const int lane = opaque_tid() & 63;
    const int gw = F.vcu * NWAVES + F.wave, NGW = F.G * NWAVES;
    constexpr int NIT = NBATCH * NH * (SEQ / 64) * (DK / 64);
    for (int it = gw; it < NIT; it += NGW) { const int db = it & 3, tb = (it >> 2) & 31, bh = it >> 7, b = bh >> 3, h = bh & 7;
        const float L2g = log2gamma(h);
        const int t0 = 64 * tb, d0 = 64 * db;
#pragma unroll
        for (int i = 0; i < 8; ++i) { const int tr = (lane >> 3) + 8 * i, cc = lane & 7;
            f32x4 a, bq; unpack8(*(const u32x4*)(WSB(F, WS_K) + (size_t)(b * SEQ + t0 + tr) * DM + h * DK + d0 + 8 * cc), a, bq);
            const float dec = __builtin_amdgcn_exp2f(L2g * (float)(SEQ - 1 - (t0 + tr)));
            LAS float* sp = scr + tr * 65 + 8 * cc;
            sp[0] = a[0] * dec; sp[1] = a[1] * dec; sp[2] = a[2] * dec; sp[3] = a[3] * dec; sp[4] = bq[0] * dec; sp[5] = bq[1] * dec; sp[6] = bq[2] * dec; sp[7] = bq[3] * dec; }
        LDS_WAIT(); CFENCE();
#pragma unroll
        for (int j = 0; j < 8; ++j) { const int n = (lane >> 3) + 8 * j, cc = lane & 7; const LAS float* s = scr + (8 * cc) * 65 + n;
            u32x4 o; o.x = cvt_pk_bf16(s[0 * 65], s[1 * 65]); o.y = cvt_pk_bf16(s[2 * 65], s[3 * 65]); o.z = cvt_pk_bf16(s[4 * 65], s[5 * 65]); o.w = cvt_pk_bf16(s[6 * 65], s[7 * 65]);
            *(u32x4*)(WSB(F, WS_KHT) + ((size_t)bh * DK + d0 + n) * SEQ + t0 + 8 * cc) = o; }
        LDS_WAIT(); CFENCE(); }
}

__device__ __forceinline__ void p2_merged(const Frame& F) {
    LAS unsigned char* lds = F.lds;
    const int tid = opaque_tid(), lane = tid & 63, g = tid >> 7, wg = (tid >> 6) & 1, e4 = (tid & 127) * 4;
    const int su = 4 * F.vcu + g, bS = su >> 3, hS = su & 7, m0 = MP + 4 * bS;
    const float L2g = log2gamma(hS);
    LAS float* sq = (LAS float*)(lds + SS_Q) + g * 1024; LAS float* sk = (LAS float*)(lds + SS_K) + g * 1024;
    LAS float* sd = (LAS float*)(lds + SS_D) + g * 16; LAS float* sred = (LAS float*)(lds + SS_RED);
    for (int e = (tid & 127); e < 1024; e += 128) { const int t = e >> 8, d = e & 255, dp = d < 128 ? 2 * d : 2 * (d - 128) + 1;
        sq[e] = bf1(WSB(F, WS_Q)[(size_t)(m0 + t) * DM + hS * DK + dp]); sk[e] = bf1(WSB(F, WS_K)[(size_t)(m0 + t) * DM + hS * DK + dp]); }
    StreamSt T;
    {
      f32x4 v[4];
#pragma unroll
      for (int c = 0; c < 4; ++c) { const u32x2 vv = *(const u32x2*)(WSB(F, WS_VT) + (size_t)(hS * DVH + e4 + c) * LDV + m0);
          v[0][c] = bf_lo(vv.x); v[1][c] = bf_hi(vv.x); v[2][c] = bf_lo(vv.y); v[3][c] = bf_hi(vv.y); }
#pragma unroll
      for (int j = 0; j < 4; ++j) T.vd[j] = v[j] * __builtin_amdgcn_exp2f(L2g * (float)(3 - j)); }
#pragma unroll
    for (int t = 0; t < 4; ++t) T.cr[t] = (f32x4){0.f, 0.f, 0.f, 0.f};
    T.s0 = (const char*)(INP(F, I_SRET) + ((size_t)(bS * NH + hS) * DK) * DVH); T.s1 = (char*)(F.out + OFF_RS + ((size_t)(bS * NH + hS) * DK) * DVH);
    T.toff = (unsigned)(e4 * 4); T.git = 0; T.sq = sq; T.sk = sk; T.g4 = __builtin_amdgcn_exp2f(L2g * 4.0f);
    stream_load(T, 0);
    LDS_WAIT(); RAW_BAR();
#pragma unroll
    for (int i = 0; i < 8; ++i) { const int pr = 8 * wg + i, t = pr >> 2, j = pr & 3; float sc = 0.f;
#pragma unroll
        for (int i4 = 0; i4 < 4; ++i4) sc += sq[t * 256 + lane + 64 * i4] * sk[j * 256 + lane + 64 * i4];
        sc = wave_sum(sc);
        if (lane == 0) sd[pr] = (j <= t) ? sc * __builtin_amdgcn_exp2f(L2g * (float)((t - j) - (3 - j))) : 0.f; }
    LDS_WAIT(); RAW_BAR();
    { const int p = F.vcu, bh = p >> 3, ql = p & 7, b_ = bh >> 3, h_ = bh & 7;
#pragma unroll 1
      for (int u = 0; u < 4; ++u) { const int qb = u == 0 ? 31 - ql : u == 1 ? 16 + ql : u == 2 ? 15 - ql : ql; flash64_unit<true>(F, b_, h_, qb, T); } }
    while (T.git < 64) { const int it = T.git; T.git = it + 1; stream_proc(T, it); if (it < 63) stream_load(T, it + 1); }
    f32x4 o[4];
    float L2e = L2g; asm volatile("" : "+v"(L2e));
#pragma unroll
    for (int t = 0; t < 4; ++t) { f32x4 in = (f32x4){0.f, 0.f, 0.f, 0.f};
#pragma unroll
        for (int j = 0; j < 4; ++j) in += T.vd[j] * sd[t * 4 + j];
        o[t] = in + T.cr[t] * __builtin_amdgcn_exp2f(L2e * (float)(t + 1));
        const float ps = wave_sum((o[t][0] * o[t][0] + o[t][1] * o[t][1]) + (o[t][2] * o[t][2] + o[t][3] * o[t][3]));
        if (lane == 0) sred[(g * 2 + wg) * 4 + t] = ps; }
    LDS_WAIT(); RAW_BAR();
#pragma unroll
    for (int t = 0; t < 4; ++t) { const float tot = sred[(g * 2) * 4 + t] + sred[(g * 2 + 1) * 4 + t];
        const float rstd = rsqrtf(tot * (1.0f / DVH) + EPS);
        const size_t off = (size_t)(m0 + t) * DVT + hS * DVH + e4;
        const u32x2 gg = *(const u32x2*)(WSB(F, WS_GR) + off);
        u32x2 ow; ow.x = cvt_pk_bf16(o[t][0] * rstd * bf_lo(gg.x), o[t][1] * rstd * bf_hi(gg.x)); ow.y = cvt_pk_bf16(o[t][2] * rstd * bf_lo(gg.y), o[t][3] * rstd * bf_hi(gg.y));
        *(u32x2*)(WSB(F, WS_ARET) + off) = ow; }
    LDS_WAIT(); RAW_BAR();
}

__device__ __forceinline__ void conv_branch_range(const Frame& F, int i0, int i1);

__device__ __forceinline__ void p2_main(const Frame& F, int c) {
    unsigned* cnt = (unsigned*)(F.ws + WS_STCNT);
    { SchedState S{(const char*)WSB(F, WS_KHT), (const char*)WSB(F, WS_VT), c}; EpiState E{WSB(F, WS_ST)}; gemm_phase<false>(F.lds, S, E); }
    if (c < 192) {
        if (threadIdx.x == 0) { __builtin_amdgcn_fence(__ATOMIC_RELEASE, "agent"); asm volatile("s_waitcnt vmcnt(0)" ::: "memory");
            __hip_atomic_fetch_add(cnt, 1u, __ATOMIC_RELAXED, __HIP_MEMORY_SCOPE_AGENT); }
    }
    const int vc = F.vcu;
    const int nS = vc < DECB * NH ? (DECB * NH - vc + F.G - 1) / F.G : 0, nP = vc < 256 ? (256 - vc + F.G - 1) / F.G : 0;
    const int typ = (vc >> 3) % 3, fpos = typ == 0 ? (nS < 1 ? nS : 1) : typ == 1 ? nS / 2 : nS;
    int ns = 0, nf = 0;
#pragma unroll 1
    for (int slot = 0; slot < nS + 2 * nP; ++slot) {
        if (slot >= fpos && nf < 2 * nP) {
            if (nf == 0) {
                if (threadIdx.x == 0) { unsigned sp = 0;
                    while (__hip_atomic_load(cnt, __ATOMIC_RELAXED, __HIP_MEMORY_SCOPE_AGENT) < 192u) { __builtin_amdgcn_s_sleep(2); if (++sp > (1u << 22)) break; }
                    __builtin_amdgcn_fence(__ATOMIC_ACQUIRE, "agent"); asm volatile("s_waitcnt vmcnt(0)" ::: "memory"); }
                __syncthreads(); }
            const int p = vc + (nf >> 1) * F.G, bh = p >> 3, ql = p & 7;
            flash_unit(F, bh >> 3, bh & 7, (nf & 1) ? ql : 15 - ql); ++nf;
        } else { const int su = vc + ns * F.G; ++ns; sample_unit(F, su >> 3, su & 7); }
    }
    { constexpr int NIT = MT * (DM / 8), PER = (NIT + 383) / 384;
      if (F.G == 256) { const int wgt = c >> 6, u0 = c < 64 ? 0 : c < 128 ? (c - 64) : c < 192 ? 64 + 2 * (c - 128) : 192 + 3 * (c - 192);
          const int i0 = u0 * PER, i1 = (u0 + wgt) * PER < NIT ? (u0 + wgt) * PER : NIT; conv_branch_range(F, i0, i1); }
      else { const int per = (NIT + F.G - 1) / F.G; const int i0 = c * per, i1 = (c + 1) * per < NIT ? (c + 1) * per : NIT; conv_branch_range(F, i0, i1); } }
}

__device__ __forceinline__ void p5_rows(const Frame& F) {
    const int gw = F.vcu * NWAVES + F.wave, NGW = F.G * NWAVES, lane = opaque_tid() & 63;
#pragma unroll 2
    for (int m = gw; m < MT; m += NGW) {
        const u32x2* mr = (const u32x2*)(WSB(F, WS_MIX) + (size_t)m * DM) + lane; const f32x4* xr = (const f32x4*)xrow(F, m) + lane;
        f32x4 v[8]; float s = 0.f;
#pragma unroll
        for (int j = 0; j < 8; ++j) { const u32x2 w_ = mr[64 * j]; v[j] = (f32x4){bf_lo(w_.x), bf_hi(w_.x), bf_lo(w_.y), bf_hi(w_.y)}; s += (v[j][0] * v[j][0] + v[j][1] * v[j][1]) + (v[j][2] * v[j][2] + v[j][3] * v[j][3]); }
        const float r1 = rsqrtf(wave_sum(s) * (1.0f / DM) + EPS); float s2 = 0.f;
#pragma unroll
        for (int j = 0; j < 8; ++j) { const f32x4 g = ((const f32x4*)INP(F, I_GPOSTMIX))[lane + 64 * j]; v[j] = __builtin_nontemporal_load(xr + 64 * j) + v[j] * r1 * g;
            s2 += (v[j][0] * v[j][0] + v[j][1] * v[j][1]) + (v[j][2] * v[j][2] + v[j][3] * v[j][3]); __builtin_nontemporal_store(v[j], (f32x4*)(WSF(F, WS_X1) + (size_t)m * DM) + lane + 64 * j); }
        const float r2 = rsqrtf(wave_sum(s2) * (1.0f / DM) + EPS);
#pragma unroll
        for (int j = 0; j < 8; ++j) { const f32x4 g = ((const f32x4*)INP(F, I_GPREFFN))[lane + 64 * j]; const f32x4 y = v[j] * r2 * g;
            u32x2 w; w.x = cvt_pk_bf16(y[0], y[1]); w.y = cvt_pk_bf16(y[2], y[3]); ((u32x2*)(WSB(F, WS_HN) + (size_t)m * DM))[lane + 64 * j] = w; }
    }
}
__device__ __forceinline__ float gelu_tanh(float v) { const float u = 1.5957691216057308f * (v + 0.044715f * v * v * v); return v * __builtin_amdgcn_rcpf(1.0f + __builtin_amdgcn_exp2f(u * -1.4426950408889634f)); }
__device__ __forceinline__ void p7_elementwise(const Frame& F, int wi, int nw) {
    const int gt = wi * NTHREADS + opaque_tid(), NGT = nw * NTHREADS;
    constexpr int CPR8 = DFF / 8;
    constexpr int NFIX = 2 * (MP / 256) + 2 * DECB;
    for (int it = gt; it < NFIX * CPR8; it += NGT) { const int k = it / CPR8, c = (it - k * CPR8) * 8;
        const int m = k < 64 ? (k >> 1) * 256 + (k & 1) : MP + ((k - 64) >> 1) * 4 + ((k - 64) & 1);
        f32x4 u2a, u2b, u1a, u1b, u0a, u0b;
        unpack8(*(const u32x4*)(WSB(F, WS_U) + (size_t)m * DFF + c), u2a, u2b);
        const f32x4 z = (f32x4){0.f, 0.f, 0.f, 0.f}; u1a = z; u1b = z; u0a = z; u0b = z;
        if (m < MP) { const int t = m & (SEQ - 1);
            if (t >= 1) unpack8(*(const u32x4*)(WSB(F, WS_U) + (size_t)(m - 1) * DFF + c), u1a, u1b);
            if (t >= 2) unpack8(*(const u32x4*)(WSB(F, WS_U) + (size_t)(m - 2) * DFF + c), u0a, u0b);
        } else { const int ms = m - MP, b = ms >> 2, t = ms & 3;
            if (t + 1 >= 2) unpack8(*(const u32x4*)(WSB(F, WS_U) + (size_t)(m - 1) * DFF + c), u1a, u1b); else { const float* sp = INP(F, I_SFFN) + ((size_t)b * 2 + (t + 1)) * DFF + c; u1a = *(const f32x4*)sp; u1b = *(const f32x4*)(sp + 4); }
            if (t >= 2) unpack8(*(const u32x4*)(WSB(F, WS_U) + (size_t)(m - 2) * DFF + c), u0a, u0b); else { const float* sp = INP(F, I_SFFN) + ((size_t)b * 2 + t) * DFF + c; u0a = *(const f32x4*)sp; u0b = *(const f32x4*)(sp + 4); } }
        const float* cw = INP(F, I_FCW) + c;
        const f32x4 w0a = *(const f32x4*)cw, w0b = *(const f32x4*)(cw + 4), w1a = *(const f32x4*)(cw + DFF), w1b = *(const f32x4*)(cw + DFF + 4), w2a = *(const f32x4*)(cw + 2 * DFF), w2b = *(const f32x4*)(cw + 2 * DFF + 4);
        const f32x4 ba = *(const f32x4*)(INP(F, I_FCB) + c), bb = *(const f32x4*)(INP(F, I_FCB) + c + 4);
        f32x4 ga, gb; unpack8(__builtin_nontemporal_load((const u32x4*)(WSB(F, WS_G) + (size_t)m * DFF + c)), ga, gb);
        f32x4 va = w0a * u0a + w1a * u1a + w2a * u2a + ba, vb = w0b * u0b + w1b * u1b + w2b * u2b + bb, oa, ob;
#pragma unroll
        for (int j = 0; j < 4; ++j) { oa[j] = gelu_tanh(va[j]) * ga[j]; ob[j] = gelu_tanh(vb[j]) * gb[j]; }
        *(u32x4*)(WSB(F, WS_AFF) + (size_t)m * DFF + c) = pack8(oa, ob); }
}
__device__ __forceinline__ void p9_rows(const Frame& F) {
    const int gw = F.vcu * NWAVES + F.wave, NGW = F.G * NWAVES, lane = opaque_tid() & 63;
#pragma unroll 2
    for (int m = gw; m < MT; m += NGW) {
        const u32x2* fr_ = (const u32x2*)(WSB(F, WS_F) + (size_t)m * DM) + lane; const f32x4* xr = (const f32x4*)(WSF(F, WS_X1) + (size_t)m * DM) + lane;
        f32x4 v[8]; float s = 0.f;
#pragma unroll
        for (int j = 0; j < 8; ++j) { const u32x2 w_ = fr_[64 * j]; v[j] = (f32x4){bf_lo(w_.x), bf_hi(w_.x), bf_lo(w_.y), bf_hi(w_.y)}; s += (v[j][0] * v[j][0] + v[j][1] * v[j][1]) + (v[j][2] * v[j][2] + v[j][3] * v[j][3]); }
        const float r1 = rsqrtf(wave_sum(s) * (1.0f / DM) + EPS);
#pragma unroll
        for (int j = 0; j < 8; ++j) { const f32x4 g = ((const f32x4*)INP(F, I_GPOSTFFN))[lane + 64 * j]; __builtin_nontemporal_store(__builtin_nontemporal_load(xr + 64 * j) + v[j] * r1 * g, (f32x4*)(F.out + (size_t)m * DM) + lane + 64 * j); }
    }
}

__global__ void __launch_bounds__(NTHREADS, 2) fwd_kernel(Params P) {
    extern __shared__ __attribute__((aligned(16))) unsigned char lds_raw[];
    cg::grid_group grid = cg::this_grid();
    Frame F;
    F.lds = (LAS unsigned char*)lds_raw;
    F.wave = __builtin_amdgcn_readfirstlane((int)threadIdx.x >> 6);
    F.G = gridDim.x; { const int bx = blockIdx.x; F.vcu = (F.G % 8 == 0) ? (bx % 8) * (F.G / 8) + bx / 8 : bx; }
    F.P = &P; F.ws = P.ws; F.out = P.out;
    volatile LAS unsigned* bst = (volatile LAS unsigned*)(F.lds + LDS_BYTES - 64);
    if (threadIdx.x < 2) bst[threadIdx.x] = 0u;
    __syncthreads();
    const XcdBarrier xbar = xcd_barrier_post((unsigned*)(P.ws + WS_CTL), bst);
    const int lo = P.ph_lo, hi = P.ph_hi;
#define IN(k) (lo <= (k) && (k) < hi)
#define SEAM(k) do { if (IN(k) && IN((k) + 1)) xcd_barrier(xbar); } while (0)
    const int c = (int)blockIdx.x;
#ifndef PROBE_PH
#define PROBE_PH (-1)
#endif
#define REPS(k) (((k) == PROBE_PH) ? 2 : 1)
#define PHASE(k, ...) do { if (IN(k)) { for (int rep_ = 0; rep_ < REPS(k); ++rep_) { if (rep_) grid.sync(); __VA_ARGS__ } } SEAM(k); } while (0)
    PHASE(0, { p0_prologue(F); __syncthreads(); });
    PHASE(1, {
        Sched1 S{(const char*)WSB(F, WS_HN), (const char*)WSB(F, WS_WINT), F.G, c};
        Epi1 E{WSB(F, WS_Q), WSB(F, WS_K), WSB(F, WS_GR), WSB(F, WS_GB), WSB(F, WS_CPR), WSB(F, WS_GA), WSB(F, WS_GBT), WSB(F, WS_VT), WSF(F, WS_ROPE), F.out};
        gemm_phase<false>(F.lds, S, E); });
    PHASE(2, { kht_prep(F); xcd_barrier(xbar); p2_main(F, c); __syncthreads(); });
    PHASE(3, {
        Sched3 S{(const char*)WSB(F, WS_ARET), (const char*)WSB(F, WS_PRETT), (const char*)WSB(F, WS_ACONV), (const char*)WSB(F, WS_PCONVT), F.G, c};
        Epi3 E{WSB(F, WS_GA), WSB(F, WS_GBT), WSF(F, WS_MTMP), WSB(F, WS_MBUF)};
        gemm_phase<true>(F.lds, S, E); });
    PHASE(4, {
        SchedX S{(const char*)WSB(F, WS_MBUF), (const char*)WSB(F, WS_WOT), 32, F.G, c, K_MIX};
        EpiB16 E{WSB(F, WS_MIX)};
        gemm_phase<true>(F.lds, S, E); });
    PHASE(5, { p5_rows(F); });
    PHASE(6, {
        Sched6 S{(const char*)WSB(F, WS_HN), (const char*)WSB(F, WS_WUGT), (const char*)WSB(F, WS_KHT), (const char*)WSB(F, WS_VT), F.G, c};
        Epi6 E{WSB(F, WS_U), WSB(F, WS_G), F.out, WSB(F, WS_ST), WSB(F, WS_AFF), INP(F, I_FCW), INP(F, I_FCB)};
        gemm_phase<false>(F.lds, S, E); });
    PHASE(7, {
        p7_elementwise(F, c, F.G); });
    PHASE(8, {
        SchedX S{(const char*)WSB(F, WS_AFF), (const char*)WSB(F, WS_WDT), 88, F.G, c, K_DOWN};
        Epi8 E{WSF(F, WS_X1), F.out, INP(F, I_GPOSTFFN), (unsigned long long*)(F.ws + WS_PART0)};
        gemm_phase<true>(F.lds, S, E); });
#undef PHASE
#undef REPS
#undef IN
#undef SEAM
}

extern "C" void kernel_launch(void* const* d_in, const int* in_sizes, int n_in, void* d_out, int out_size, void* d_ws, size_t ws_size, hipStream_t stream) {
    static int grid = 0;
    if (grid == 0) {
        if (n_in != 19 || (size_t)out_size != OUT_TOTAL || ws_size < WS_END) { fprintf(stderr, "kernel_launch: unexpected problem: n_in %d out %d ws %zu (need %zu)\n", n_in, out_size, ws_size, (size_t)WS_END); grid = -1; return; }
        int dev = 0, cus = 0, per_cu = 0;
        if (hipGetDevice(&dev) != hipSuccess || hipDeviceGetAttribute(&cus, hipDeviceAttributeMultiprocessorCount, dev) != hipSuccess) { grid = -1; return; }
        if (hipFuncSetAttribute((const void*)fwd_kernel, hipFuncAttributeMaxDynamicSharedMemorySize, LDS_BYTES) != hipSuccess) { fprintf(stderr, "kernel_launch: hipFuncSetAttribute failed\n"); grid = -1; return; }
        if (hipOccupancyMaxActiveBlocksPerMultiprocessor(&per_cu, (const void*)fwd_kernel, NTHREADS, LDS_BYTES) != hipSuccess || per_cu < 1) { fprintf(stderr, "kernel_launch: occupancy query failed (%d)\n", per_cu); (void)hipGetLastError(); grid = -1; return; }
        grid = cus * per_cu;
        fprintf(stderr, "kernel_launch: %d CUs x %d blocks/CU -> grid %d\n", cus, per_cu, grid);
    }
    if (grid < 0) return;
    if (hipMemsetAsync((char*)d_ws + WS_CTL, 0, WS_CTL_BYTES, stream) != hipSuccess) { fprintf(stderr, "kernel_launch: hipMemsetAsync failed\n"); return; }
    Params p{};
    for (int i = 0; i < 19; ++i) p.in[i] = (const float*)d_in[i];
    p.out = (float*)d_out; p.ws = (unsigned char*)d_ws; p.ph_lo = 0; p.ph_hi = 9;
    void* args[] = {&p};
    hipError_t e = hipLaunchCooperativeKernel((const void*)fwd_kernel, dim3(grid), dim3(NTHREADS), args, LDS_BYTES, stream);
    if (e != hipSuccess) fprintf(stderr, "kernel_launch: cooperative launch failed: %s (grid %d)\n", hipGetErrorString(e), grid);
}
```

```cpp
#include <hip/hip_runtime.h>
#include <hip/hip_cooperative_groups.h>
#include <cstdio>
#include <cstdint>
namespace cg = cooperative_groups;

#define LAS __attribute__((address_space(3)))
typedef unsigned short bf16_t;
typedef short bf16x8 __attribute__((ext_vector_type(8)));
typedef float f32x4 __attribute__((ext_vector_type(4)));
typedef float f32x2 __attribute__((ext_vector_type(2)));
typedef unsigned u32x4 __attribute__((ext_vector_type(4)));
typedef unsigned u32x2 __attribute__((ext_vector_type(2)));

constexpr int DM = 2048, SEQ = 2048, NBATCH = 4, MP = NBATCH * SEQ, DECB = 128, DECT = 4, MS = DECB * DECT, MT = MP + MS;
constexpr int DIN = 22528, NH = 8, DK = 256, DVH = 512, DVT = 4096, DFF = 5632;
constexpr int LDV = MT;
constexpr float EPS = 1e-6f;
constexpr int NWAVES = 8, NTHREADS = 512;
constexpr int LDS_BYTES = 163840;

constexpr size_t OFF_YP = 0, OFF_YS = 16777216, OFF_RP = 17825792, OFF_CP = 22020096, OFF_FP = 22036480, OFF_RS = 22081536, OFF_CS = 156299264, OFF_FS = 156823552, OUT_TOTAL = 158265344;

constexpr size_t al256(size_t x) { return (x + 255) & ~(size_t)255; }
constexpr size_t WS_CTL = 0;
constexpr size_t WS_WINT = 2u << 20;
constexpr size_t WS_PRETT = WS_WINT + al256((size_t)DIN * DM * 2);
constexpr size_t WS_PCONVT = WS_PRETT + al256((size_t)DM * DVT * 2);
constexpr size_t WS_WOT = WS_PCONVT + al256((size_t)DM * DM * 2);
constexpr size_t WS_WUGT = WS_WOT + al256((size_t)DM * DM * 2);
constexpr size_t WS_WDT = WS_WUGT + al256((size_t)2 * DFF * DM * 2);
constexpr size_t WS_HN = WS_WDT + al256((size_t)DM * DFF * 2);
constexpr size_t WS_Q = WS_HN + al256((size_t)MT * DM * 2);
constexpr size_t WS_K = WS_Q + al256((size_t)MT * DM * 2);
constexpr size_t WS_VT = WS_K + al256((size_t)MT * DM * 2);
constexpr size_t WS_GR = WS_VT + al256((size_t)DVT * LDV * 2);
constexpr size_t WS_GB = WS_GR + al256((size_t)MT * DVT * 2);
constexpr size_t WS_CPR = WS_GB + al256((size_t)MT * DM * 2);
constexpr size_t WS_GA = WS_CPR + al256((size_t)MT * DM * 2);
constexpr size_t WS_GBT = WS_GA + al256((size_t)MT * DM * 2);
constexpr size_t WS_KHT = WS_GBT + al256((size_t)MT * DM * 2);
constexpr size_t WS_ARET = WS_KHT + al256((size_t)NBATCH * NH * DK * SEQ * 2);
constexpr size_t WS_ACONV = WS_ARET + al256((size_t)MT * DVT * 2);
constexpr size_t WS_MTMP = WS_ACONV + al256((size_t)MT * DM * 2);
constexpr size_t WS_MBUF = WS_MTMP + al256((size_t)MT * DM * 4);
constexpr size_t WS_MIX = WS_MBUF + al256((size_t)MT * DM * 2);
constexpr size_t WS_X1 = WS_MIX + al256((size_t)MT * DM * 4);
constexpr size_t WS_U = WS_X1 + al256((size_t)MT * DM * 4);
constexpr size_t WS_G = WS_U + al256((size_t)MT * DFF * 2);
constexpr size_t WS_AFF = WS_G + al256((size_t)MT * DFF * 2);
constexpr size_t WS_F = WS_AFF + al256((size_t)MT * DFF * 2);
constexpr size_t WS_ROPE = WS_F + al256((size_t)MT * DM * 4);
constexpr size_t WS_ST = WS_ROPE + al256((size_t)2052 * 128 * 2 * 4);
constexpr size_t WS_END = WS_ST + al256((size_t)32 * 3 * DVH * DK * 2);
constexpr size_t WS_P1CNT = 16384 + 256;
constexpr size_t WS_STCNT = 16384;
constexpr size_t PART_BYTES = (size_t)32 * 272 * 8 * 8;
constexpr size_t WS_PART0 = 65536, WS_PART1 = WS_PART0 + PART_BYTES, WS_PART2 = WS_PART1 + PART_BYTES;
constexpr size_t WS_CTL_BYTES = 2u << 20;

typedef __bf16 bf16x2n_t __attribute__((ext_vector_type(2)));
__device__ __forceinline__ unsigned cvt_pk_bf16(float lo, float hi) { const f32x2 v = {lo, hi}; return __builtin_bit_cast(unsigned, __builtin_convertvector(v, bf16x2n_t)); }
__device__ __forceinline__ float bf_lo(unsigned w) { return __uint_as_float(w << 16); }
__device__ __forceinline__ float bf_hi(unsigned w) { return __uint_as_float(w & 0xffff0000u); }
__device__ __forceinline__ float bf1(bf16_t x) { return __uint_as_float((unsigned)x << 16); }
#define LDS_WAIT() asm volatile("s_waitcnt lgkmcnt(0)" ::: "memory")
#define VM_WAIT() asm volatile("s_waitcnt vmcnt(0)" ::: "memory")
#define CFENCE() asm volatile("" ::: "memory")
#define RAW_BAR() do { asm volatile("" ::: "memory"); __builtin_amdgcn_s_barrier(); asm volatile("" ::: "memory"); } while (0)
__device__ __forceinline__ float wave_sum(float v) {
#pragma unroll
    for (int o = 1; o < 64; o <<= 1) v += __shfl_xor(v, o);
    return v;
}
__device__ __forceinline__ float log2gamma(int h) {
    const float t[8] = {-0.04580368961312479f, -0.02272007650008353f, -0.011315313227834146f, -0.005646563141142063f,
                        -0.0028205190623786626f, -0.0014095702546713536f, -0.0007046129765893727f, -0.0003522634716290214f};
    float r = t[0];
#pragma unroll
    for (int i = 1; i < 8; ++i) r = (h == i) ? t[i] : r;
    return r;
}
__device__ __forceinline__ int opaque_tid() { int t = threadIdx.x; asm volatile("" : "+v"(t)); return t; }
__device__ __forceinline__ float sigmoidf_(float v) { return __builtin_amdgcn_rcpf(1.0f + __builtin_amdgcn_exp2f(v * -1.4426950408889634f)); }

struct Params { const float* in[19]; float* out; unsigned char* ws; int ph_lo, ph_hi; };

struct Frame {
    LAS unsigned char* lds;
    int wave, vcu, G;
    const Params* P;
    unsigned char* ws; float* out;
};
#define WSB(F, off) ((bf16_t*)((F).ws + (off)))
#define WSF(F, off) ((float*)((F).ws + (off)))
#define INP(F, k) ((F).P->in[k])
enum { I_XP = 0, I_XS, I_SRET, I_SCONV, I_SFFN, I_GPREMIX, I_WIN, I_CONVW, I_PRET, I_PCONV, I_WO, I_GPOSTMIX, I_GPREFFN, I_WUP, I_WGATE, I_FCW, I_FCB, I_WDOWN, I_GPOSTFFN };
__device__ __forceinline__ const float* xrow(const Frame& F, int m) { return m < MP ? INP(F, I_XP) + (size_t)m * DM : INP(F, I_XS) + (size_t)(m - MP) * DM; }

constexpr int BM = 256, BK = 64, HALF = 128, HTB = HALF * BK * 2, STAGE_BYTES = 8 * HTB;
__device__ __forceinline__ int lds_byte(int r, int c) { const int st = (r >> 4) * 2 + (c >> 5), rr = r & 15, cc = c & 31, ob = rr * 64 + cc * 2; return st * 1024 + (ob ^ (((ob >> 9) & 1) << 5)); }
__device__ __forceinline__ void stage_rc(int b, int& R, int& C) { const int st = b / 1024, sb = b % 1024, swz = sb ^ (((sb >> 9) & 1) << 5); R = (st >> 1) * 16 + swz / 64; C = (st & 1) * 32 + (swz % 64) / 2; }
__device__ __forceinline__ int perm32(int rho) { const int n = rho >> 4, i = rho & 15; return 8 * (i >> 2) + 4 * n + (i & 3); }

struct GUnit { const char* a; const char* b; const char* x; unsigned lda, ldb; int nt, kind, pm, pn; };

__device__ __forceinline__ void tile_of(int L, int nM, int nN, int& pm, int& pn) {
    const int nwg = nM * nN; int wgid = L;
    { const int q = nwg / 8, r = nwg % 8, xcd = wgid % 8, off = wgid / 8; wgid = (xcd < r ? xcd * (q + 1) : r * (q + 1) + (xcd - r) * q) + off; }
    const int nig = 4 * nN, gid = wgid / nig, fm = gid * 4, gsz = (nM - fm) < 4 ? (nM - fm) : 4;
    pm = fm + ((wgid % nig) % gsz); pn = (wgid % nig) / gsz;
}

constexpr int XA_OFF = STAGE_BYTES;
template <bool XR, class Sched, class Epi>
__device__ __forceinline__ void gemm_phase(LAS unsigned char* lds, const Sched& S, const Epi& E) {
    const int tid = threadIdx.x, wid = __builtin_amdgcn_readfirstlane(tid >> 6), lane = tid & 63, wr = wid >> 2, wc = wid & 3, fr = lane & 15, fq = lane >> 4;
    int R0, C0; stage_rc(tid * 16, R0, C0);
    const unsigned RA = (unsigned)R0, RB = (unsigned)((R0 & ~31) + perm32(R0 & 31)), C2 = (unsigned)C0 * 2u;
    const unsigned ldsw = (unsigned)wid * 1024u;
    const int aoff = lds_byte(wr * 64 + fr, fq * 8), boff = lds_byte(wc * 32 + fr, fq * 8);
    const int xoff = XA_OFF + fr * 128 + fq * 16;
#define G_SA(b, h) (((b) * 2 + (h)) * HTB)
#define G_SB(b, h) ((4 + (b) * 2 + (h)) * HTB)
#define G_STAGE(bufoff, gbase, voff, ld64) do { \
        __builtin_amdgcn_global_load_lds((const unsigned*)((const char*)(gbase) + (voff)), (LAS unsigned*)(lds + (bufoff) + ldsw), 16, 0, 0); \
        __builtin_amdgcn_global_load_lds((const unsigned*)((const char*)(gbase) + (ld64) + (voff)), (LAS unsigned*)(lds + (bufoff) + ldsw + 8192), 16, 0, 0); } while (0)
#define G_STAGEX(b, gbase, ld) do { if constexpr (XR) { int t_ = threadIdx.x; asm volatile("" : "+v"(t_));     \
        const unsigned vx_ = (unsigned)(((t_ >> 5) & 1) + 2 * wid) * (ld) + (unsigned)(t_ & 31) * 4u; \
        __builtin_amdgcn_global_load_lds((const unsigned*)((const char*)(gbase) + vx_), (LAS unsigned*)(lds + XA_OFF + (b) * 2048 + wid * 256), 4, 0, 0); } } while (0)
#define G_LDA(dst, b, h) do { _Pragma("unroll") for (int m = 0; m < 4; ++m) _Pragma("unroll") for (int k = 0; k < 2; ++k) dst[m][k] = *(const LAS bf16x8*)(lds + G_SA(b, h) + aoff + m * 2048 + k * 1024); } while (0)
#define G_LDB(dst, b, h) do { _Pragma("unroll") for (int n = 0; n < 2; ++n) _Pragma("unroll") for (int k = 0; k < 2; ++k) dst[n][k] = *(const LAS bf16x8*)(lds + G_SB(b, h) + boff + n * 2048 + k * 1024); } while (0)
#define G_LDX(b) do { if constexpr (XR) { Xf[0] = *(const LAS bf16x8*)(lds + xoff + (b) * 2048); Xf[1] = *(const LAS bf16x8*)(lds + xoff + (b) * 2048 + 64); } } while (0)
#define G_MMA(ai, bj, At, Bt) do { __builtin_amdgcn_s_setprio(1); _Pragma("unroll") for (int m = 0; m < 4; ++m) _Pragma("unroll") for (int n = 0; n < 2; ++n) _Pragma("unroll") for (int k = 0; k < 2; ++k) \
        acc[ai][bj][m][n] = __builtin_amdgcn_mfma_f32_16x16x32_bf16(Bt[n][k], At[m][k], acc[ai][bj][m][n], 0, 0, 0); __builtin_amdgcn_s_setprio(0); } while (0)
#define G_MMAX() do { if constexpr (XR) { if (wr == 0) { _Pragma("unroll") for (int n = 0; n < 2; ++n) _Pragma("unroll") for (int k = 0; k < 2; ++k) xacc[n] = __builtin_amdgcn_mfma_f32_16x16x32_bf16(B0[n][k], Xf[k], xacc[n], 0, 0, 0); } \
        else { _Pragma("unroll") for (int n = 0; n < 2; ++n) _Pragma("unroll") for (int k = 0; k < 2; ++k) xacc[n] = __builtin_amdgcn_mfma_f32_16x16x32_bf16(B1[n][k], Xf[k], xacc[n], 0, 0, 0); } } } while (0)
#define G_WAIT_V(n) asm volatile("s_waitcnt vmcnt(" #n ")" ::: "memory")
#define G_WAIT_VX(n, nx) do { if constexpr (XR) asm volatile("s_waitcnt vmcnt(" #nx ")" ::: "memory"); else asm volatile("s_waitcnt vmcnt(" #n ")" ::: "memory"); } while (0)
#define G_WAIT_L(n) asm volatile("s_waitcnt lgkmcnt(" #n ")" ::: "memory")
#define G_BAR __builtin_amdgcn_s_barrier()
#define G_SCHED __builtin_amdgcn_sched_barrier(0)
    GUnit cur, nxt; int ui = 0;
    if (!S.next(0, cur)) return;
    f32x4 acc[2][2][4][2]; f32x4 xacc[2];
#pragma unroll
    for (int a = 0; a < 2; ++a)
#pragma unroll
        for (int b = 0; b < 2; ++b)
#pragma unroll
            for (int m = 0; m < 4; ++m)
#pragma unroll
                for (int n = 0; n < 2; ++n) acc[a][b][m][n] = (f32x4){0.f, 0.f, 0.f, 0.f};
    xacc[0] = (f32x4){0.f, 0.f, 0.f, 0.f}; xacc[1] = (f32x4){0.f, 0.f, 0.f, 0.f};
    bf16x8 At[4][2], B0[2][2], B1[2][2], Xf[2];
    const char* cA = cur.a; const char* cB = cur.b; const char* cX = cur.x;
    unsigned vA = RA * cur.lda + C2, vB = RB * cur.ldb + C2; unsigned ldx = cur.lda;
    size_t hA = (size_t)HALF * cur.lda, hB = (size_t)HALF * cur.ldb;
    const size_t kstep = (size_t)(BK * 2);
    G_STAGE(G_SB(0, 0), cB, vB, hB / 2); G_STAGE(G_SB(0, 1), cB + hB, vB, hB / 2); G_STAGE(G_SA(0, 0), cA, vA, hA / 2); G_STAGE(G_SA(0, 1), cA + hA, vA, hA / 2); G_STAGEX(0, cX, ldx);
    if (wr == 1) G_BAR;
    G_WAIT_VX(2, 3); G_BAR;
    G_STAGE(G_SB(1, 0), cB + kstep, vB, hB / 2); G_STAGE(G_SA(1, 0), cA + kstep, vA, hA / 2); G_STAGE(G_SB(1, 1), cB + hB + kstep, vB, hB / 2);
    G_WAIT_V(6); G_BAR;
    for (;;) {
        const bool has_next = S.next(ui + 1, nxt);
        const char* nA = has_next ? nxt.a : cA; const char* nB = has_next ? nxt.b : cB; const char* nX = has_next ? nxt.x : cX;
        const unsigned nlda = has_next ? nxt.lda : cur.lda, nldb = has_next ? nxt.ldb : cur.ldb;
        const unsigned nvA = RA * nlda + C2, nvB = RB * nldb + C2;
        const size_t nhA = (size_t)HALF * nlda, nhB = (size_t)HALF * nldb;
        const int nt = cur.nt;
        for (int t = 0; t < nt; t += 2) {
            const bool last = (t == nt - 2);
            const char* a1 = cA + (size_t)(t + 1) * kstep; const char* x1 = cX + (size_t)(t + 1) * kstep;
            const char* a2 = last ? nA : cA + (size_t)(t + 2) * kstep; const char* b2 = last ? nB : cB + (size_t)(t + 2) * kstep; const char* x2 = last ? nX : cX + (size_t)(t + 2) * kstep;
            const unsigned vA2 = last ? nvA : vA, vB2 = last ? nvB : vB, ldx2 = last ? nlda : ldx;
            const size_t hA2 = last ? nhA : hA, hB2 = last ? nhB : hB;
            const char* a3 = a2 + kstep; const char* b3 = b2 + kstep;
            G_LDB(B0, 0, 0); G_LDB(B1, 0, 1); G_SCHED; G_LDA(At, 0, 0); G_STAGE(G_SA(1, 1), a1 + hA, vA, hA / 2); G_STAGEX(1, x1, ldx);
            G_WAIT_VX(8, 9); G_WAIT_L(0); G_BAR; G_MMA(0, 0, At, B0); G_MMA(0, 1, At, B1); G_BAR; G_SCHED;
            G_LDA(At, 0, 1); G_LDX(0); G_STAGE(G_SB(0, 0), b2, vB2, hB2 / 2); G_STAGE(G_SB(0, 1), b2 + hB2, vB2, hB2 / 2); G_STAGE(G_SA(0, 0), a2, vA2, hA2 / 2);
            G_WAIT_VX(8, 9); G_WAIT_L(0); G_BAR; G_MMA(1, 0, At, B0); G_MMA(1, 1, At, B1); G_MMAX(); G_BAR; G_SCHED;
            G_LDB(B0, 1, 0); G_LDB(B1, 1, 1); G_SCHED; G_LDA(At, 1, 0); G_STAGE(G_SA(0, 1), a2 + hA2, vA2, hA2 / 2); G_STAGEX(0, x2, ldx2);
            G_WAIT_VX(8, 9); G_WAIT_L(0); G_BAR; G_MMA(0, 0, At, B0); G_MMA(0, 1, At, B1); G_BAR; G_SCHED;
            G_LDA(At, 1, 1); G_LDX(1); G_STAGE(G_SB(1, 0), b3, vB2, hB2 / 2); G_STAGE(G_SB(1, 1), b3 + hB2, vB2, hB2 / 2); G_STAGE(G_SA(1, 0), a3, vA2, hA2 / 2);
            G_WAIT_VX(8, 9); G_WAIT_L(0); G_BAR; G_MMA(1, 0, At, B0); G_MMA(1, 1, At, B1); G_MMAX(); G_BAR; G_SCHED;
        }
        if (wr == 0) G_BAR;
        { int fre = fr, fqe = fq; asm volatile("" : "+v"(fre), "+v"(fqe));
          bool tiled = false;
          if constexpr (Epi::HAS_TILE) { if (E.is_tile(cur)) { tiled = true; E.tile(cur, acc, xacc, lds, wr, wc, fre, fqe); } }
          if (!tiled) {
              constexpr int NBJ = Epi::NBJ;
#pragma unroll
              for (int ai = 0; ai < 2; ++ai)
#pragma unroll
                  for (int b0 = 0; b0 < 2; b0 += NBJ) {
                      typename Epi::Pre pre[4][NBJ];
#pragma unroll
                      for (int m = 0; m < 4; ++m)
#pragma unroll
                          for (int bb = 0; bb < NBJ; ++bb) pre[m][bb] = E.pre(cur, cur.pm * BM + ai * HALF + wr * 64 + m * 16 + fre, (b0 + bb) * HALF + wc * 32 + 8 * fqe);
#pragma unroll
                      for (int m = 0; m < 4; ++m)
#pragma unroll
                          for (int bb = 0; bb < NBJ; ++bb) E.row(cur, cur.pm * BM + ai * HALF + wr * 64 + m * 16 + fre, (b0 + bb) * HALF + wc * 32 + 8 * fqe, acc[ai][b0 + bb][m][0], acc[ai][b0 + bb][m][1], pre[m][bb]);
                      CFENCE();
                  }
              if constexpr (XR) { const typename Epi::Pre px = E.pre(cur, MP + 16 * cur.pm + fre, wr * HALF + wc * 32 + 8 * fqe); E.row(cur, MP + 16 * cur.pm + fre, wr * HALF + wc * 32 + 8 * fqe, xacc[0], xacc[1], px); }
          } }
        if constexpr (Epi::HAS_DONE) { if (E.publishes(ui)) {
            asm volatile("s_waitcnt vmcnt(0)" ::: "memory"); RAW_BAR();
            if (threadIdx.x == 0) { __builtin_amdgcn_fence(__ATOMIC_RELEASE, "agent"); asm volatile("s_waitcnt vmcnt(0)" ::: "memory"); __hip_atomic_fetch_add(E.done_counter(), 1u, __ATOMIC_RELAXED, __HIP_MEMORY_SCOPE_AGENT); } } }
        if (!has_next) break;
#pragma unroll
        for (int a = 0; a < 2; ++a)
#pragma unroll
            for (int b = 0; b < 2; ++b)
#pragma unroll
                for (int m = 0; m < 4; ++m)
#pragma unroll
                    for (int n = 0; n < 2; ++n) acc[a][b][m][n] = (f32x4){0.f, 0.f, 0.f, 0.f};
        xacc[0] = (f32x4){0.f, 0.f, 0.f, 0.f}; xacc[1] = (f32x4){0.f, 0.f, 0.f, 0.f};
        cur = nxt; cA = nA; cB = nB; cX = nX; vA = nvA; vB = nvB; ldx = nlda; hA = nhA; hB = nhB; ++ui;
        if (wr == 1) G_BAR;
    }
    G_WAIT_V(0);
    G_BAR;
    CFENCE();
#undef G_SA
#undef G_SB
#undef G_STAGE
#undef G_STAGEX
#undef G_LDA
#undef G_LDB
#undef G_LDX
#undef G_MMA
#undef G_MMAX
#undef G_WAIT_V
#undef G_WAIT_VX
#undef G_WAIT_L
#undef G_BAR
#undef G_SCHED
}

enum { K_ROTQ = 0, K_ROTK, K_SILU, K_PLAIN, K_PROD, K_SIGA, K_SIGB, K_VT, K_YA, K_YB, K_RETP, K_MIX, K_UP, K_GATE, K_DOWN, K_STATE };

__device__ __forceinline__ u32x4 pack8(f32x4 a, f32x4 b) { u32x4 w; w.x = cvt_pk_bf16(a[0], a[1]); w.y = cvt_pk_bf16(a[2], a[3]); w.z = cvt_pk_bf16(b[0], b[1]); w.w = cvt_pk_bf16(b[2], b[3]); return w; }
__device__ __forceinline__ void unpack8(u32x4 w, f32x4& a, f32x4& b) { a = (f32x4){bf_lo(w.x), bf_hi(w.x), bf_lo(w.y), bf_hi(w.y)}; b = (f32x4){bf_lo(w.z), bf_hi(w.z), bf_lo(w.w), bf_hi(w.w)}; }
#define GP(T, base, byteoff) ((T*)((char*)(base) + (unsigned)(byteoff)))
#define GPC(T, base, byteoff) ((const T*)((const char*)(base) + (unsigned)(byteoff)))

struct Epi1 {
    static constexpr bool HAS_TILE = false; static constexpr int NBJ = 2; static constexpr bool HAS_DONE = true;
    bf16_t *Q, *K, *GR, *GB, *CPR, *GA, *GBT, *VT; const float* rope; float* out; unsigned* cnt; int ulast;
    __device__ __forceinline__ bool publishes(int ui) const { return ui == ulast; }
    __device__ __forceinline__ unsigned* done_counter() const { return cnt; }
    struct Pre {};
    __device__ __forceinline__ Pre pre(const GUnit& u, int row, int lc) const { return Pre{}; }
    __device__ __forceinline__ void row(const GUnit& u, int row, int lc, const f32x4 v0, const f32x4 v1, const Pre& pr_) const {
        const int kind = u.kind;
        if (kind == K_ROTQ || kind == K_ROTK) {
            bf16_t* dst = ((kind == K_ROTQ) ? Q : K) + (u.pn & 7) * 256; const float sc = (kind == K_ROTQ) ? 1.0f : 0.0625f;
            const int pidx = row < MP ? (row & (SEQ - 1)) : SEQ + ((row - MP) & 3);
            const f32x4 c01 = *GPC(f32x4, rope, (pidx * 128 + (lc >> 1)) * 8), c23 = *GPC(f32x4, rope, (pidx * 128 + (lc >> 1)) * 8 + 16);
            f32x4 o0, o1;
            o0[0] = (v0[0] * c01[0] - v0[1] * c01[1]) * sc; o0[1] = (v0[1] * c01[0] + v0[0] * c01[1]) * sc;
            o0[2] = (v0[2] * c01[2] - v0[3] * c01[3]) * sc; o0[3] = (v0[3] * c01[2] + v0[2] * c01[3]) * sc;
            o1[0] = (v1[0] * c23[0] - v1[1] * c23[1]) * sc; o1[1] = (v1[1] * c23[0] + v1[0] * c23[1]) * sc;
            o1[2] = (v1[2] * c23[2] - v1[3] * c23[3]) * sc; o1[3] = (v1[3] * c23[2] + v1[2] * c23[3]) * sc;
            *GP(u32x4, dst, (row * DM + lc) * 2) = pack8(o0, o1);
            CFENCE();
        } else if (kind == K_SILU) {
            f32x4 o0, o1;
#pragma unroll
            for (int j = 0; j < 4; ++j) { o0[j] = v0[j] * sigmoidf_(v0[j]); o1[j] = v1[j] * sigmoidf_(v1[j]); }
            *GP(u32x4, GR + (u.pn - 32) * 256, (row * DVT + lc) * 2) = pack8(o0, o1);
        } else if (kind == K_PLAIN) {
            *GP(u32x4, GB + (u.pn - 48) * 256, (row * DM + lc) * 2) = pack8(v0, v1);
        } else if (kind == K_SIGA || kind == K_SIGB) {
            bf16_t* dst = (kind == K_SIGA) ? GA + (u.pn - 72) * 256 : GBT + (u.pn - 80) * 256;
            f32x4 o0, o1;
#pragma unroll
            for (int j = 0; j < 4; ++j) { o0[j] = sigmoidf_(v0[j]); o1[j] = sigmoidf_(v1[j]); }
            __builtin_nontemporal_store(pack8(o0, o1), GP(u32x4, dst, (row * DM + lc) * 2));
        } else if (kind == K_PROD) {
            const int col = (u.pn - 56) * 128 + (lc >> 1);
            const f32x4 pr = (f32x4){v0[0] * v0[1], v0[2] * v0[3], v1[0] * v1[1], v1[2] * v1[3]};
            u32x2 w; w.x = cvt_pk_bf16(pr[0], pr[1]); w.y = cvt_pk_bf16(pr[2], pr[3]);
            *GP(u32x2, CPR, (row * DM + col) * 2) = w;
            if (row < MP) { const int t = row & (SEQ - 1); if (t >= SEQ - 2) *GP(f32x4, out + OFF_CP, (((row >> 11) * 2 + (t - (SEQ - 2))) * DM + col) * 4) = pr; }
            else { const int ms = row - MP, t = ms & 3; if (t >= 2) *GP(f32x4, out + OFF_CS, (((ms >> 2) * 2 + (t - 2)) * DM + col) * 4) = pr; }
        } else {
            *GP(u32x4, VT, (row * LDV + u.pn * BM + lc) * 2) = pack8(v0, v1);
        }
    }
};

struct Epi3 {
    static constexpr bool HAS_DONE = false;
    static constexpr bool HAS_TILE = false; static constexpr int NBJ = 1;
    const bf16_t *GA, *GBT; float* MTMP; bf16_t* MBUF;
    struct Pre { u32x4 g; f32x4 t0, t1; };
    __device__ __forceinline__ Pre pre(const GUnit& u, int row, int lc) const {
        const unsigned off = (unsigned)(row * DM + u.pn * BM + lc);
        Pre p; p.t0 = (f32x4){0.f, 0.f, 0.f, 0.f}; p.t1 = p.t0;
        if (u.kind == K_YA) p.g = __builtin_nontemporal_load(GPC(u32x4, GA, off * 2));
        else { p.g = __builtin_nontemporal_load(GPC(u32x4, GBT, off * 2)); p.t0 = *GPC(f32x4, MTMP, off * 4); p.t1 = *GPC(f32x4, MTMP, off * 4 + 16); }
        return p;
    }
    __device__ __forceinline__ void row(const GUnit& u, int row, int lc, const f32x4 v0, const f32x4 v1, const Pre& p) const {
        const unsigned off = (unsigned)(row * DM + u.pn * BM + lc);
        f32x4 g0, g1; unpack8(p.g, g0, g1);
        if (u.kind == K_YA) { *GP(f32x4, MTMP, off * 4) = v0 * g0; *GP(f32x4, MTMP, off * 4 + 16) = v1 * g1; }
        else *GP(u32x4, MBUF, off * 2) = pack8(p.t0 + v0 * g0, p.t1 + v1 * g1);
    }
};

struct EpiB16 {
    static constexpr bool HAS_DONE = false;
    static constexpr bool HAS_TILE = false; static constexpr int NBJ = 2;
    bf16_t* C;
    struct Pre {};
    __device__ __forceinline__ Pre pre(const GUnit& u, int row, int lc) const { return Pre{}; }
    __device__ __forceinline__ void row(const GUnit& u, int row, int lc, const f32x4 v0, const f32x4 v1, const Pre&) const {
        *GP(u32x4, C, (unsigned)(row * DM + u.pn * BM + lc) * 2u) = pack8(v0, v1);
    }
};

constexpr int LDS_RED = 139264;
template <class ACC, class XACC>
__device__ __forceinline__ void panel_rstd(LAS unsigned char* lds, unsigned long long* part, int pm, int pn, ACC& acc, XACC& xacc, int wr, int wc, int fr, int fq) {
    LAS float* red = (LAS float*)(lds + LDS_RED);
#pragma unroll
    for (int ai = 0; ai < 2; ++ai)
#pragma unroll
        for (int m = 0; m < 4; ++m) { float sq = 0.f;
#pragma unroll
            for (int bj = 0; bj < 2; ++bj)
#pragma unroll
                for (int n = 0; n < 2; ++n) { const f32x4 v = acc[ai][bj][m][n]; sq += (v[0] * v[0] + v[1] * v[1]) + (v[2] * v[2] + v[3] * v[3]); }
            sq += __shfl_xor(sq, 16); sq += __shfl_xor(sq, 32);
            if (fq == 0) red[wc * 256 + ai * HALF + wr * 64 + m * 16 + fr] = sq; }
    { float sq = 0.f;
#pragma unroll
      for (int n = 0; n < 2; ++n) { const f32x4 v = xacc[n]; sq += (v[0] * v[0] + v[1] * v[1]) + (v[2] * v[2] + v[3] * v[3]); }
      sq += __shfl_xor(sq, 16); sq += __shfl_xor(sq, 32);
      if (fq == 0) red[1024 + (wr * 4 + wc) * 16 + fr] = sq; }
    LDS_WAIT(); RAW_BAR();
    { const int t = opaque_tid();
      if (t < 272) {
          float tot;
          if (t < 256) tot = (red[t] + red[256 + t]) + (red[512 + t] + red[768 + t]);
          else { tot = 0.f;
#pragma unroll
              for (int w = 0; w < 8; ++w) tot += red[1024 + w * 16 + (t - 256)]; }
          unsigned long long* pw = part + ((size_t)(pm * 272 + t)) * 8;
          __hip_atomic_store(pw + pn, ((unsigned long long)1u << 32) | (unsigned long long)__float_as_uint(tot), __ATOMIC_RELAXED, __HIP_MEMORY_SCOPE_AGENT);
          unsigned long long w[8]; unsigned sp = 0;
          for (;;) {
              bool ok = true;
#pragma unroll
              for (int k = 0; k < 8; ++k) w[k] = __hip_atomic_load(pw + k, __ATOMIC_RELAXED, __HIP_MEMORY_SCOPE_AGENT);
#pragma unroll
              for (int k = 0; k < 8; ++k) ok = ok && ((unsigned)(w[k] >> 32) == 1u);
              if (ok || ++sp > (1u << 22)) break;
              __builtin_amdgcn_s_sleep(1); }
          float sum = 0.f;
#pragma unroll
          for (int k = 0; k < 8; ++k) sum += __uint_as_float((unsigned)w[k]);
          red[1280 + t] = rsqrtf(sum * (1.0f / DM) + EPS);
      } }
    LDS_WAIT(); RAW_BAR();
}

struct Epi8 {
    static constexpr bool HAS_DONE = false;
    static constexpr bool HAS_TILE = true;
    const float* X1; float* Y; const float* g; unsigned long long* part;
    static constexpr int NBJ = 2;
    struct Pre {};
    __device__ __forceinline__ Pre pre(const GUnit& u, int row, int lc) const { return Pre{}; }
    __device__ __forceinline__ bool is_tile(const GUnit& u) const { return true; }
    __device__ __forceinline__ void row(const GUnit& u, int row, int lc, const f32x4 v0, const f32x4 v1, const Pre&) const {}
    template <class ACC, class XACC>
    __device__ __forceinline__ void tile(const GUnit& u, ACC& acc, XACC& xacc, LAS unsigned char* lds, int wr, int wc, int fr, int fq) const {
        f32x4 xa[2][4], xb[2][4];
#define E8_LOAD(buf, bj_, ai_) do { _Pragma("unroll") for (int m = 0; m < 4; ++m) { const unsigned o_ = (unsigned)(((u.pm * BM + (ai_) * HALF + wr * 64 + fr + 16 * m) * DM + u.pn * BM + (bj_) * HALF + wc * 32 + 8 * fq) * 4); \
            xa[buf][m] = __builtin_nontemporal_load(GPC(f32x4, X1, o_)); xb[buf][m] = __builtin_nontemporal_load(GPC(f32x4, X1, o_ + 16)); } } while (0)
        E8_LOAD(0, 0, 0);
        panel_rstd(lds, part, u.pm, u.pn, acc, xacc, wr, wc, fr, fq);
        const LAS float* rs = (const LAS float*)(lds + LDS_RED) + 1280;
#pragma unroll
        for (int bt = 0; bt < 4; ++bt) { const int bj = bt >> 1, ai = bt & 1, buf = bt & 1;
            if (bt < 3) { if (buf == 0) E8_LOAD(1, (bt + 1) >> 1, (bt + 1) & 1); else E8_LOAD(0, (bt + 1) >> 1, (bt + 1) & 1); }
            const int col = u.pn * BM + bj * HALF + wc * 32 + 8 * fq;
            const f32x4 g0 = *(const f32x4*)(g + col), g1 = *(const f32x4*)(g + col + 4);
            const int rl0 = ai * HALF + wr * 64 + fr;
#pragma unroll
            for (int m = 0; m < 4; ++m) { const unsigned o = (unsigned)(((u.pm * BM + rl0 + 16 * m) * DM + col) * 4); const float r = rs[rl0 + 16 * m];
                __builtin_nontemporal_store(xa[buf][m] + acc[ai][bj][m][0] * r * g0, GP(f32x4, Y, o)); __builtin_nontemporal_store(xb[buf][m] + acc[ai][bj][m][1] * r * g1, GP(f32x4, Y, o + 16)); }
        }
#undef E8_LOAD
        {
            const int col = u.pn * BM + wr * HALF + wc * 32 + 8 * fq; const unsigned o = (unsigned)(((MP + 16 * u.pm + fr) * DM + col) * 4);
            const f32x4 g0 = *(const f32x4*)(g + col), g1 = *(const f32x4*)(g + col + 4); const float r = rs[256 + fr];
            const f32x4 xa = __builtin_nontemporal_load(GPC(f32x4, X1, o)), xb = __builtin_nontemporal_load(GPC(f32x4, X1, o + 16));
            __builtin_nontemporal_store(xa + xacc[0] * r * g0, GP(f32x4, Y, o)); __builtin_nontemporal_store(xb + xacc[1] * r * g1, GP(f32x4, Y, o + 16));
        }
    }
};

struct EpiState {
    static constexpr bool HAS_DONE = false;
    static constexpr bool HAS_TILE = false; static constexpr int NBJ = 2;
    bf16_t* ST;
    struct Pre {};
    __device__ __forceinline__ Pre pre(const GUnit& u, int row, int lc) const { return Pre{}; }
    __device__ __forceinline__ void row(const GUnit& u, int row, int lc, const f32x4 v0, const f32x4 v1, const Pre&) const {
        const int bh = u.pm, pe = u.pn & 1, sg = u.pn >> 4, rl = row - bh * BM;
        const float sc = __builtin_amdgcn_exp2f(-log2gamma(bh & 7) * (float)(SEQ - 512 * sg));
        *GP(u32x4, ST, ((((bh * 3 + (sg - 1)) * DVH + pe * BM + rl) * DK) + lc) * 2) = pack8(v0 * sc, v1 * sc);
    }
};

__device__ __forceinline__ unsigned dpp_ror1(unsigned v) { return (unsigned)__builtin_amdgcn_update_dpp(0, (int)v, 0x121, 0xf, 0xf, false); }
__device__ __forceinline__ unsigned dpp_ror2(unsigned v) { return (unsigned)__builtin_amdgcn_update_dpp(0, (int)v, 0x122, 0xf, 0xf, false); }
struct Epi6 {
    static constexpr bool HAS_DONE = false;
    static constexpr bool HAS_TILE = true;
    bf16_t *U, *GG; float* out; const bf16_t* ST; bf16_t* AFF; const float *fcw, *fcb;
    __device__ __forceinline__ bool is_tile(const GUnit& u) const { return u.kind == K_GATE; }
    template <class ACC, class XACC>
    __device__ __forceinline__ void tile(const GUnit& u, ACC& acc, XACC& xacc, LAS unsigned char* lds, int wr, int wc, int fr, int fq) const {
        const bool f15 = fr == 15, f14 = fr >= 14;
#pragma unroll
        for (int bj = 0; bj < 2; ++bj) {
            const int col = (u.pn - 22) * BM + bj * HALF + wc * 32 + 8 * fq;
            f32x2 w0[4], w1[4], w2[4], bb[4];
            { const float* cw = fcw + col; const float* cb = fcb + col;
#pragma unroll
              for (int j = 0; j < 4; ++j) { w0[j] = *(const f32x2*)(cw + 2 * j); w1[j] = *(const f32x2*)(cw + DFF + 2 * j); w2[j] = *(const f32x2*)(cw + 2 * DFF + 2 * j); bb[j] = *(const f32x2*)(cb + 2 * j); } }
#pragma unroll
            for (int ai = 0; ai < 2; ++ai) {
                const int rb = u.pm * BM + ai * HALF + wr * 64 + fr;
                u32x4 blk[5];
#pragma unroll
                for (int mm = 0; mm < 5; ++mm) { int r = rb + 16 * (mm - 1); r = r < 0 ? 0 : r; blk[mm] = *GPC(u32x4, U, (r * DFF + col) * 2); }
#pragma unroll
                for (int m = 0; m < 4; ++m) {
                    const int row = rb + 16 * m;
                    const u32x4 c0 = blk[m + 1], pv = blk[m];
                    const f32x4 g0 = acc[ai][bj][m][0], g1 = acc[ai][bj][m][1];
                    f32x4 o0, o1;
#pragma unroll
                    for (int j = 0; j < 4; ++j) {
                        const unsigned q1 = dpp_ror1(f15 ? pv[j] : c0[j]), q2 = dpp_ror2(f14 ? pv[j] : c0[j]);
                        const f32x2 x0 = (f32x2){bf_lo(c0[j]), bf_hi(c0[j])}, x1 = (f32x2){bf_lo(q1), bf_hi(q1)}, x2 = (f32x2){bf_lo(q2), bf_hi(q2)};
                        const f32x2 v = w0[j] * x2 + (w1[j] * x1 + (w2[j] * x0 + bb[j]));
                        const f32x2 z = v * (v * v * (-2.3022082f * 0.044715f) + (-2.3022082f));
                        f32x2 e; e[0] = __builtin_amdgcn_exp2f(z[0]); e[1] = __builtin_amdgcn_exp2f(z[1]);
                        const f32x2 d = e + 1.0f; f32x2 r; r[0] = __builtin_amdgcn_rcpf(d[0]); r[1] = __builtin_amdgcn_rcpf(d[1]);
                        const f32x2 gg = j < 2 ? (f32x2){g0[2 * (j & 1)], g0[2 * (j & 1) + 1]} : (f32x2){g1[2 * (j & 1)], g1[2 * (j & 1) + 1]};
                        const f32x2 o = v * r * gg;
                        if (j < 2) { o0[2 * (j & 1)] = o[0]; o0[2 * (j & 1) + 1] = o[1]; } else { o1[2 * (j & 1)] = o[0]; o1[2 * (j & 1) + 1] = o[1]; }
                    }
                    *GP(u32x4, AFF, (row * DFF + col) * 2) = pack8(o0, o1);
                    const bool fix = row < MP ? (row & 255) < 2 : ((row - MP) & 3) < 2;
                    if (fix) *GP(u32x4, GG, (row * DFF + col) * 2) = pack8(g0, g1);
                }
            }
        }
    }
    static constexpr int NBJ = 2;
    struct Pre { u32x4 st; };
    __device__ __forceinline__ Pre pre(const GUnit& u, int row, int lc) const {
        Pre p; p.st = (u32x4){0u, 0u, 0u, 0u};
        if (u.kind == K_RETP) p.st = *GPC(u32x4, ST, ((((u.pm * 3 + 2) * DVH + u.pn * BM + (row - u.pm * BM)) * DK) + lc) * 2);
        return p;
    }
    __device__ __forceinline__ void row(const GUnit& u, int row, int lc, const f32x4 v0, const f32x4 v1, const Pre& p) const {
        if (u.kind == K_UP) {
            const int col = u.pn * BM + lc;
            *GP(u32x4, U, (row * DFF + col) * 2) = pack8(v0, v1);
            if (row < MP) { const int t = row & (SEQ - 1); if (t >= SEQ - 2) { const unsigned o = (unsigned)((((row >> 11) * 2 + (t - (SEQ - 2))) * DFF + col) * 4); *GP(f32x4, out + OFF_FP, o) = v0; *GP(f32x4, out + OFF_FP, o + 16) = v1; } }
            else { const int ms = row - MP, t = ms & 3; if (t >= 2) { const unsigned o = (unsigned)((((ms >> 2) * 2 + (t - 2)) * DFF + col) * 4); *GP(f32x4, out + OFF_FS, o) = v0; *GP(f32x4, out + OFF_FS, o + 16) = v1; } }
        } else {
            const int e = u.pn * BM + (row - u.pm * BM);
            const float g512 = __builtin_amdgcn_exp2f(log2gamma(u.pm & 7) * 512.0f);
            f32x4 s0, s1; unpack8(p.st, s0, s1);
            const f32x4 a = v0 + s0 * g512, b = v1 + s1 * g512;
            float* ob = out + OFF_RP + (size_t)u.pm * DK * DVH;
#pragma unroll
            for (int j = 0; j < 4; ++j) { const int d0 = lc + j, d1 = lc + 4 + j;
                __builtin_nontemporal_store(a[j], GP(float, ob, (((d0 >> 1) + 128 * (d0 & 1)) * DVH + e) * 4)); __builtin_nontemporal_store(b[j], GP(float, ob, (((d1 >> 1) + 128 * (d1 & 1)) * DVH + e) * 4)); }
        }
    }
};

struct Sched1 {
    const char *HN, *WINT; int G, c;
    __device__ __forceinline__ bool next(int i, GUnit& u) const {
        const int L = i * G + c; if (L >= 2992) return false;
        const bool mainp = L < 2448;
        int pm, pn; tile_of(mainp ? L : L - 2448, mainp ? 34 : 16, mainp ? 72 : 34, pm, pn);
        const int t = pn < 16 ? pn : pn + 16;
        const char* am = HN + (size_t)pm * (256 * 4096); const char* bm = WINT + (size_t)t * (256 * 4096);
        const char* av = WINT + (size_t)(16 + pm) * (256 * 4096); const char* bv = HN + (size_t)pn * (256 * 4096);
        const int km = t < 8 ? K_ROTQ : t < 16 ? K_ROTK : t < 48 ? K_SILU : t < 56 ? K_PLAIN : t < 72 ? K_PROD : t < 80 ? K_SIGA : K_SIGB;
        GUnit r; r.a = mainp ? am : av; r.b = mainp ? bm : bv; r.x = r.a; r.lda = 4096; r.ldb = 4096; r.nt = 32; r.kind = mainp ? km : K_VT; r.pm = pm; r.pn = mainp ? t : pn;
        u = r; return true;
    }
};
struct Sched3 {
    const char *ARET, *PRETT, *ACONV, *PCONVT; int G, c;
    __device__ __forceinline__ bool next(int i, GUnit& u) const {
        const int L = (i >> 1) * G + c, sub = i & 1; if (L >= 256) return false;
        int pm, pn; tile_of(L, 32, 8, pm, pn);
        GUnit r;
        r.a = sub ? ACONV + (size_t)pm * (256 * 4096) : ARET + (size_t)pm * (256 * 8192);
        r.x = sub ? ACONV + (size_t)(MP + 16 * pm) * 4096 : ARET + (size_t)(MP + 16 * pm) * 8192;
        r.b = sub ? PCONVT + (size_t)pn * (256 * 4096) : PRETT + (size_t)pn * (256 * 8192);
        r.lda = sub ? 4096u : 8192u; r.ldb = r.lda; r.nt = sub ? 32 : 64; r.kind = sub ? K_YB : K_YA; r.pm = pm; r.pn = pn;
        u = r; return true;
    }
};
struct SchedX {
    const char *A, *B; int nt, G, c, kind;
    __device__ __forceinline__ bool next(int i, GUnit& u) const {
        const int L = i * G + c; if (L >= 256) return false;
        int pm, pn; tile_of(L, 32, 8, pm, pn);
        const unsigned ld = (unsigned)nt * 128u;
        GUnit r; r.a = A + (size_t)pm * 256 * ld; r.x = A + (size_t)(MP + 16 * pm) * ld; r.b = B + (size_t)pn * 256 * ld; r.lda = ld; r.ldb = ld; r.nt = nt; r.pm = pm; r.pn = pn; r.kind = kind;
        u = r; return true;
    }
};
struct SchedSimple {
    const char *A, *B; int nN, nt, G, c, kind_split, kind_lo, kind_hi;
    __device__ __forceinline__ bool next(int i, GUnit& u) const {
        const int L = i * G + c; if (L >= 34 * nN) return false;
        int pm, pn; tile_of(L, 34, nN, pm, pn);
        const unsigned ld = (unsigned)nt * 128u;
        GUnit r; r.a = A + (size_t)pm * 256 * ld; r.x = r.a; r.b = B + (size_t)pn * 256 * ld; r.lda = ld; r.ldb = ld; r.nt = nt; r.pm = pm; r.pn = pn; r.kind = pn < kind_split ? kind_lo : kind_hi;
        u = r; return true;
    }
};
struct Sched6 {
    const char *A, *B, *KHT, *VT; int G, c;
    __device__ __forceinline__ bool next(int i, GUnit& u) const {
        const int q = (i >> 1) * G + c, sub = i & 1; const bool tile = q < 748;
        const int je = (G == 256) ? ((c >= 236 && i >= 4) ? (i - 4) * 20 + (c - 236) : 64) : (q - 748) * 2 + sub;
        const int j = tile ? 0 : je;
        if (j >= 64) return false;
        int pm, pn; tile_of(tile ? q : 0, 34, 22, pm, pn);
        pn += 22 * sub;
        const int bh = j >> 1, pe = j & 1, b = bh >> 3, h = bh & 7;
        GUnit r;
        r.a = tile ? A + (size_t)pm * (256 * 4096) : VT + ((size_t)(h * DVH + pe * 256) * LDV + (size_t)b * SEQ + (SEQ - 512)) * 2; r.x = r.a;
        r.b = tile ? B + (size_t)pn * (256 * 4096) : KHT + (size_t)bh * (DK * SEQ * 2) + (SEQ - 512) * 2;
        r.lda = tile ? 4096u : (unsigned)(LDV * 2); r.ldb = 4096u; r.nt = tile ? 32 : 8; r.kind = tile ? (sub ? K_GATE : K_UP) : K_RETP; r.pm = tile ? pm : bh; r.pn = tile ? pn : pe;
        u = r; return true;
    }
};
struct SchedState {
    const char *KHT, *VT; int c;
    __device__ __forceinline__ bool next(int i, GUnit& u) const {
        if (i != 0 || c >= 192) return false;
        const int sg = 3 - (c >> 6), k = c & 63, bh = k >> 1, pe = k & 1, b = bh >> 3, h = bh & 7;
        GUnit r; r.a = VT + ((size_t)(h * DVH + pe * 256) * LDV + (size_t)b * SEQ) * 2; r.x = r.a; r.b = KHT + (size_t)bh * (DK * SEQ * 2);
        r.lda = (unsigned)(LDV * 2); r.ldb = (unsigned)(SEQ * 2); r.nt = 8 * sg; r.kind = K_STATE; r.pm = bh; r.pn = pe | (sg << 4);
        u = r; return true;
    }
};
#define XB_TMO      128
#define XB_XCNT(j)  (256  + 64 * (j))
#define XB_XSUB(j)  (1280 + 64 * (j))
#define XB_XGEN(j)  (2304 + 64 * (j))
#define XB_TOP      3328
#define XB_TOPGEN   3392
#define XCD_BAR_WORDS 3456
#define XB_SPIN_CAP (1u << 18)
__device__ __forceinline__ unsigned xb_ld(unsigned* p)              { return __hip_atomic_load(p, __ATOMIC_RELAXED, __HIP_MEMORY_SCOPE_AGENT); }
__device__ __forceinline__ unsigned xb_add(unsigned* p, unsigned v) { return __hip_atomic_fetch_add(p, v, __ATOMIC_RELAXED, __HIP_MEMORY_SCOPE_AGENT); }
__device__ __forceinline__ unsigned xb_xcc_id() { return (unsigned)__builtin_amdgcn_s_getreg((3 << 11) | 20) & 0xFu; }
#define XB_SPIN(cond, bar) do { unsigned _sp = 0; while (cond) { __builtin_amdgcn_s_sleep(1); \
    if ((++_sp & 255u) == 0u) { if (xb_ld(&(bar)[XB_TMO])) break; if (_sp > XB_SPIN_CAP) { atomicAdd(&(bar)[XB_TMO], 1u); break; } } } } while (0)
struct XcdBarrier { unsigned* bar; unsigned x; volatile LAS unsigned* st; };
__device__ __forceinline__ XcdBarrier xcd_barrier_post(unsigned* bar, volatile LAS unsigned* st) {
    XcdBarrier b; b.bar = bar; b.x = xb_xcc_id(); b.st = st;
    if (threadIdx.x == 0) (void)xb_add(&bar[XB_XCNT(b.x)], 1u);
    return b;
}
__device__ __forceinline__ void xcd_barrier_complete(unsigned* bar, unsigned x, unsigned& nloc, unsigned& nx) {
    const unsigned G = gridDim.x * gridDim.y * gridDim.z;
    unsigned sum, cnt, mine, sp = 0u;
    for (;;) {
        sum = 0u; cnt = 0u; mine = 0u;
#pragma unroll
        for (unsigned j = 0; j < 16; ++j) { const unsigned c = xb_ld(&bar[XB_XCNT(j)]); sum += c; cnt += (c > 0u) ? 1u : 0u; mine = (j == x) ? c : mine; }
        if (sum == G) break;
        __builtin_amdgcn_s_sleep(1);
        if ((++sp & 255u) == 0u) { if (xb_ld(&bar[XB_TMO])) break; if (sp > XB_SPIN_CAP) { atomicAdd(&bar[XB_TMO], 1u); break; } }
    }
    nloc = mine > 0u ? mine : 1u; nx = cnt > 0u ? cnt : 1u;
}
__device__ __forceinline__ void xcd_barrier(const XcdBarrier& b) {
    asm volatile("s_waitcnt vmcnt(0)" ::: "memory");
    __syncthreads();
    if (threadIdx.x == 0) {
        unsigned* bar = b.bar;
        __builtin_amdgcn_s_waitcnt(0);
        unsigned nloc = b.st[0], nx = b.st[1];
        if (nloc == 0u) { xcd_barrier_complete(bar, b.x, nloc, nx); b.st[0] = nloc; b.st[1] = nx; }
        const unsigned old = xb_add(&bar[XB_XSUB(b.x)], 1u);
        const unsigned gen = old / nloc;
        if (old + 1u == (gen + 1u) * nloc) {
            __builtin_amdgcn_fence(__ATOMIC_RELEASE, "agent");
            asm volatile("s_waitcnt vmcnt(0)" ::: "memory");
            const unsigned og = xb_add(&bar[XB_TOP], 1u);
            const unsigned tg = og / nx;
            if (og + 1u == (tg + 1u) * nx) xb_add(&bar[XB_TOPGEN], 1u);
            else XB_SPIN(xb_ld(&bar[XB_TOPGEN]) == tg, bar);
            __builtin_amdgcn_fence(__ATOMIC_ACQUIRE, "agent");
            xb_add(&bar[XB_XGEN(b.x)], 1u);
            asm volatile("s_waitcnt vmcnt(0)" ::: "memory");
        } else {
            XB_SPIN(xb_ld(&bar[XB_XGEN(b.x)]) == gen, bar);
            __builtin_amdgcn_fence(__ATOMIC_ACQUIRE, "agent");
            asm volatile("s_waitcnt vmcnt(0)" ::: "memory");
        }
    }
    __syncthreads();
}

template <bool NTS, class ColMap>
__device__ __forceinline__ void transpose_item(const float* W, int N, int K, bf16_t* WT, LAS float* scr, int item, int lane, ColMap cm) {
    const int nblk = N / 64, kb = item / nblk, nb = item % nblk, k0 = 64 * kb, n0 = 64 * nb;
    const int sc = cm(n0 + lane);
    float wv[64];
#pragma unroll
    for (int kk = 0; kk < 64; ++kk) wv[kk] = __builtin_nontemporal_load(W + (size_t)(k0 + kk) * N + sc);
#pragma unroll
    for (int kk = 0; kk < 64; ++kk) scr[kk * 65 + lane] = wv[kk];
    LDS_WAIT(); CFENCE();
    const int c = lane & 7;
#pragma unroll
    for (int j = 0; j < 8; ++j) { const int n = (lane >> 3) + 8 * j; const LAS float* s = scr + (8 * c) * 65 + n;
        u32x4 o; o.x = cvt_pk_bf16(s[0 * 65], s[1 * 65]); o.y = cvt_pk_bf16(s[2 * 65], s[3 * 65]); o.z = cvt_pk_bf16(s[4 * 65], s[5 * 65]); o.w = cvt_pk_bf16(s[6 * 65], s[7 * 65]);
        if (NTS) __builtin_nontemporal_store(o, (u32x4*)(WT + (size_t)(n0 + n) * K + k0 + 8 * c)); else *(u32x4*)(WT + (size_t)(n0 + n) * K + k0 + 8 * c) = o; }
    LDS_WAIT(); CFENCE();
}
struct ColId { __device__ __forceinline__ int operator()(int n) const { return n; } };
struct ColWin {
    __device__ __forceinline__ int operator()(int np) const {
        if (np < 4096) { const int seg = np >> 11, w = np & 2047, h = w >> 8, r = w & 255; return seg * 2048 + h * 256 + (r >> 1) + 128 * (r & 1); }
        if (np < 14336 || np >= 18432) return np;
        const int w = np - 14336; return 14336 + (w >> 1) + 2048 * (w & 1);
    }
};
__device__ __forceinline__ void sincos_tab(int pidx, int i, float& c, float& s) {
    const int pos = pidx < SEQ ? pidx : 16384 + (pidx - SEQ);
    const float inv = (float)exp2(-(double)i * (13.287712379549449 / 128.0));
    const float ang = (float)pos * inv;
    const double a = (double)ang;
    const double n = rint(a * 0.15915494309189535);
    double r = fma(-n, 6.283185307179586, a); r = fma(-n, 2.4492935982947064e-16, r);
    const double r2 = r * r;
    double ps = -1.0 / 51090942171709440000.0;
    ps = ps * r2 + 1.0 / 121645100408832000.0; ps = ps * r2 - 1.0 / 355687428096000.0; ps = ps * r2 + 1.0 / 1307674368000.0; ps = ps * r2 - 1.0 / 6227020800.0;
    ps = ps * r2 + 1.0 / 39916800.0; ps = ps * r2 - 1.0 / 362880.0; ps = ps * r2 + 1.0 / 5040.0; ps = ps * r2 - 1.0 / 120.0; ps = ps * r2 + 1.0 / 6.0; ps = 1.0 - ps * r2;
    double pc = 1.0 / 1124000727777607680000.0;
    pc = pc * r2 - 1.0 / 2432902008176640000.0; pc = pc * r2 + 1.0 / 6402373705728000.0; pc = pc * r2 - 1.0 / 20922789888000.0; pc = pc * r2 + 1.0 / 87178291200.0;
    pc = pc * r2 - 1.0 / 479001600.0; pc = pc * r2 + 1.0 / 3628800.0; pc = pc * r2 - 1.0 / 40320.0; pc = pc * r2 + 1.0 / 720.0; pc = pc * r2 - 1.0 / 24.0; pc = pc * r2 + 0.5; pc = 1.0 - pc * r2;
    s = (float)(r * ps); c = (float)pc;
}
__device__ __forceinline__ void rms_row_to_bf16(const float* xr_, const float* g, bf16_t* orow, int lane) {
    const f32x4* xr = (const f32x4*)xr_ + lane; f32x4 v[8]; float s = 0.f;
#pragma unroll
    for (int j = 0; j < 8; ++j) { v[j] = __builtin_nontemporal_load(xr + 64 * j); s += (v[j][0] * v[j][0] + v[j][1] * v[j][1]) + (v[j][2] * v[j][2] + v[j][3] * v[j][3]); }
    const float r = rsqrtf(wave_sum(s) * (1.0f / DM) + EPS);
#pragma unroll
    for (int j = 0; j < 8; ++j) { const f32x4 gg = ((const f32x4*)g)[lane + 64 * j]; const f32x4 y = v[j] * r * gg;
        u32x2 w; w.x = cvt_pk_bf16(y[0], y[1]); w.y = cvt_pk_bf16(y[2], y[3]); ((u32x2*)orow)[lane + 64 * j] = w; }
}
__device__ __forceinline__ void p0_prologue(const Frame& F) {
    const int tid = opaque_tid(), lane = tid & 63;
    LAS float* scr = (LAS float*)(F.lds + F.wave * 16640);
    const int gw = F.vcu * NWAVES + F.wave, NGW = F.G * NWAVES;
    constexpr int I_IN = (DM / 64) * (DIN / 64), I_PR = (DVT / 64) * (DM / 64), I_SQ = (DM / 64) * (DM / 64), I_UP = (DM / 64) * (DFF / 64), I_DN = (DFF / 64) * (DM / 64);
    constexpr int NITEMS = I_IN + I_PR + 2 * I_SQ + 2 * I_UP + I_DN;
    for (int it = gw; it < NITEMS; it += NGW) {
        int r = it;
        if (r < I_IN) { transpose_item<false>(INP(F, I_WIN), DIN, DM, WSB(F, WS_WINT), scr, r, lane, ColWin()); continue; } r -= I_IN;
        if (r < I_PR) { transpose_item<true>(INP(F, I_PRET), DM, DVT, WSB(F, WS_PRETT), scr, r, lane, ColId()); continue; } r -= I_PR;
        if (r < I_SQ) { transpose_item<true>(INP(F, I_PCONV), DM, DM, WSB(F, WS_PCONVT), scr, r, lane, ColId()); continue; } r -= I_SQ;
        if (r < I_SQ) { transpose_item<true>(INP(F, I_WO), DM, DM, WSB(F, WS_WOT), scr, r, lane, ColId()); continue; } r -= I_SQ;
        if (r < I_UP) { transpose_item<true>(INP(F, I_WUP), DFF, DM, WSB(F, WS_WUGT), scr, r, lane, ColId()); continue; } r -= I_UP;
        if (r < I_UP) { transpose_item<true>(INP(F, I_WGATE), DFF, DM, WSB(F, WS_WUGT) + (size_t)DFF * DM, scr, r, lane, ColId()); continue; } r -= I_UP;
        transpose_item<true>(INP(F, I_WDOWN), DM, DFF, WSB(F, WS_WDT), scr, r, lane, ColId());
    }
    for (int m = gw; m < MT; m += NGW) rms_row_to_bf16(xrow(F, m), INP(F, I_GPREMIX), WSB(F, WS_HN) + (size_t)m * DM, lane);
    const int gt = F.vcu * NTHREADS + tid, NGT = F.G * NTHREADS;
    for (int e = gt; e < 2052 * 128; e += NGT) { float c, s; sincos_tab(e >> 7, e & 127, c, s); ((f32x2*)WSF(F, WS_ROPE))[e] = (f32x2){c, s}; }
}

constexpr int FL_KBUF = 0, FL_PBUF = 65536, FL_RED = 81920, FL_QBUF = 86016;
__device__ __forceinline__ void flash_unit(const Frame& F, int b, int h, int qb) {
    constexpr int ABL = 0;
    LAS unsigned char* lds = F.lds;
    const int lane = opaque_tid() & 63;
    const int w = F.wave, fr = lane & 15, fq = lane >> 4;
    const int i0 = qb * 128; const int mrow0 = b * SEQ;
    const float L2g = log2gamma(h);
    { const char* qb_ = (const char*)WSB(F, WS_Q) + ((size_t)(mrow0 + i0 + 16 * w) * DM + h * DK) * 2;
      const int r0 = lane >> 5, cp = lane & 31;
#pragma unroll
      for (int i = 0; i < 8; ++i) { const int row = r0 + 2 * i; const unsigned off = (unsigned)(row * (DM * 2) + ((cp ^ row) * 16));
          __builtin_amdgcn_global_load_lds((const unsigned*)(qb_ + off), (LAS unsigned*)(lds + FL_QBUF + w * 8192 + i * 1024), 16, 0, 0); } }
    f32x4 acc[4][8];
#pragma unroll
    for (int ef = 0; ef < 4; ++ef)
#pragma unroll
        for (int qf = 0; qf < 8; ++qf) acc[ef][qf] = (f32x4){0.f, 0.f, 0.f, 0.f};
    const int nkb = 2 * qb + 2, sg = qb >> 2, jb0 = 8 * sg;
    const char* kbase = (const char*)WSB(F, WS_K) + ((size_t)mrow0 * DM + h * DK) * 2;
    const int krow0 = 2 * w + (lane >> 5);
    const unsigned ksrc = (unsigned)(krow0 * (DM * 2) + (((lane & 31) ^ (krow0 & 15)) * 16));
#define FL_STAGE_K(jb, buf) do { if (ABL & 1) break; const char* kb_ = kbase + (size_t)(jb) * (64 * DM * 2); _Pragma("unroll") for (int i = 0; i < 4; ++i) \
        __builtin_amdgcn_global_load_lds((const unsigned*)(kb_ + (size_t)i * (16 * DM * 2) + ksrc), (LAS unsigned*)(lds + FL_KBUF + (buf) * 32768 + i * 8192 + w * 1024), 16, 0, 0); } while (0)
    FL_STAGE_K(jb0, 0);
    const char* vbase = (const char*)WSB(F, WS_VT) + ((size_t)(h * DVH + 64 * w) * LDV + mrow0) * 2;
    float c2[4];
#pragma unroll
    for (int r = 0; r < 4; ++r) c2[r] = __builtin_amdgcn_exp2f(-L2g * (float)(4 * (lane >> 4) + r));
    bf16x8 Vf[4][2];
    if (sg > 0) {
        const char* sb_ = (const char*)WSB(F, WS_ST) + ((size_t)(((b * NH + h) * 3 + (sg - 1)) * DVH + 64 * w) * DK) * 2;
        const unsigned soff = (unsigned)(fr * (DK * 2) + fq * 16);
#pragma unroll
        for (int ef = 0; ef < 4; ++ef)
#pragma unroll
            for (int ks = 0; ks < 2; ++ks) Vf[ef][ks] = *(const bf16x8*)(sb_ + (size_t)ef * (16 * DK * 2) + ks * 64 + soff);
        VM_WAIT(); RAW_BAR();
#pragma unroll
        for (int ks = 0; ks < 8; ++ks) {
#pragma unroll
            for (int qf = 0; qf < 8; ++qf) { const bf16x8 Qf = *(const LAS bf16x8*)(lds + FL_QBUF + (16 * qf + fr) * 512 + (((ks * 4 + fq) ^ fr) * 16));
#pragma unroll
                for (int ef = 0; ef < 4; ++ef) acc[ef][qf] = __builtin_amdgcn_mfma_f32_16x16x32_bf16(Vf[ef][ks & 1], Qf, acc[ef][qf], 0, 0, 0); }
            if (ks < 6) {
#pragma unroll
                for (int ef = 0; ef < 4; ++ef) Vf[ef][ks & 1] = *(const bf16x8*)(sb_ + (size_t)ef * (16 * DK * 2) + (ks + 2) * 64 + soff); } }
#pragma unroll
        for (int qf = 0; qf < 8; ++qf) { const float lam = __builtin_amdgcn_exp2f(L2g * (float)(i0 + 16 * qf + fr - 512 * sg + 1));
#pragma unroll
            for (int ef = 0; ef < 4; ++ef) acc[ef][qf] *= lam; }
    }
    { const char* v0_ = vbase + (size_t)jb0 * 128; const unsigned voff = (unsigned)((lane & 15) * (LDV * 2) + (lane >> 4) * 16);
#pragma unroll
      for (int ef = 0; ef < 4; ++ef)
#pragma unroll
          for (int ks = 0; ks < 2; ++ks) Vf[ef][ks] = *(const bf16x8*)(v0_ + (size_t)ef * (16 * LDV * 2) + ks * 64 + voff); }
    VM_WAIT();
    for (int jb = jb0; jb < nkb; ++jb) {
        RAW_BAR();
        const bool more = jb + 1 < nkb;
        if (more) FL_STAGE_K(jb + 1, (jb + 1) & 1);
        int fr = lane & 15, fq = lane >> 4; asm volatile("" : "+v"(fr), "+v"(fq));
        f32x4 sacc[4];
        const LAS unsigned char* kl = lds + FL_KBUF + (jb & 1) * 32768 + fr * 512;
        const LAS unsigned char* ql_ = lds + FL_QBUF + w * 8192 + fr * 512;
#pragma unroll
        for (int kf = 0; kf < 4; ++kf) sacc[kf] = (f32x4){0.f, 0.f, 0.f, 0.f};
        if (!(ABL & 2)) {
          bf16x8 Qn, Kn[4];
          { const int sw = (fq ^ fr) * 16; Qn = *(const LAS bf16x8*)(ql_ + sw);
#pragma unroll
            for (int kf = 0; kf < 4; ++kf) Kn[kf] = *(const LAS bf16x8*)(kl + kf * 8192 + sw); }
#pragma unroll
          for (int ks = 0; ks < 8; ++ks) { const bf16x8 Qc = Qn; bf16x8 Kc[4];
#pragma unroll
              for (int kf = 0; kf < 4; ++kf) Kc[kf] = Kn[kf];
              if (ks < 7) { const int sw = (((ks + 1) * 4 + fq) ^ fr) * 16; Qn = *(const LAS bf16x8*)(ql_ + sw);
#pragma unroll
                  for (int kf = 0; kf < 4; ++kf) Kn[kf] = *(const LAS bf16x8*)(kl + kf * 8192 + sw); }
              __builtin_amdgcn_sched_barrier(0);
#pragma unroll
              for (int kf = 0; kf < 4; ++kf) sacc[kf] = __builtin_amdgcn_mfma_f32_16x16x32_bf16(Kc[kf], Qc, sacc[kf], 0, 0, 0);
              __builtin_amdgcn_sched_barrier(0); } }
        { const int ql = 16 * w + fr, iq = i0 + ql;
          const float rowf = __builtin_amdgcn_exp2f(L2g * (float)(iq - 64 * jb));
          const bool diag = jb >= 2 * qb;
#pragma unroll
          for (int kf = 0; kf < 4; ++kf) { const int jbase = 64 * jb + 16 * kf + 4 * fq; float pv[4];
              const float rk = rowf * __builtin_amdgcn_exp2f(L2g * (float)(-16 * kf));
#pragma unroll
              for (int r = 0; r < 4; ++r) { if (ABL & 8) { pv[r] = sacc[kf][r]; continue; } pv[r] = sacc[kf][r] * (rk * c2[r]); if (diag) pv[r] = (iq - (jbase + r)) >= 0 ? pv[r] : 0.f; }
              u32x2 pw; pw.x = cvt_pk_bf16(pv[0], pv[1]); pw.y = cvt_pk_bf16(pv[2], pv[3]);
              *(LAS u32x2*)(lds + FL_PBUF + ql * 128 + (((kf * 2 + (fq >> 1)) ^ ((ql >> 1) & 7)) * 16) + (fq & 1) * 8) = pw; } }
        LDS_WAIT(); RAW_BAR();
        { const LAS unsigned char* pl = lds + FL_PBUF + fr * 128;
          const char* vn_ = vbase + (size_t)(jb + 1) * 128; const unsigned voff = (unsigned)(fr * (LDV * 2) + fq * 16);
#pragma unroll
          for (int ks = 0; ks < 2; ++ks) { const int sw = (((ks * 4 + fq) ^ ((fr >> 1) & 7)) * 16);
              bf16x8 Pn0 = *(const LAS bf16x8*)(pl + sw), Pn1 = *(const LAS bf16x8*)(pl + 2048 + sw);
#pragma unroll
              for (int qf = 0; qf < 8; ++qf) { const bf16x8 Pc = Pn0; Pn0 = Pn1;
                  if (qf < 6) Pn1 = *(const LAS bf16x8*)(pl + (qf + 2) * 2048 + sw);
                  __builtin_amdgcn_sched_barrier(0);
#pragma unroll
                  for (int ef = 0; ef < 4; ++ef) { if (ABL & 4) { asm volatile("" :: "v"(Pc)); continue; } acc[ef][qf] = __builtin_amdgcn_mfma_f32_16x16x32_bf16(Vf[ef][ks], Pc, acc[ef][qf], 0, 0, 0); }
                  __builtin_amdgcn_sched_barrier(0); }
              if (more && !(ABL & 1)) {
#pragma unroll
                  for (int ef = 0; ef < 4; ++ef) Vf[ef][ks] = *(const bf16x8*)(vn_ + (size_t)ef * (16 * LDV * 2) + ks * 64 + voff); } } }
        asm volatile("s_waitcnt vmcnt(8)" ::: "memory");
    }
#undef FL_STAGE_K
    LAS float* red = (LAS float*)(lds + FL_RED);
    float ss[8];
#pragma unroll
    for (int qf = 0; qf < 8; ++qf) { float s = 0.f;
#pragma unroll
        for (int ef = 0; ef < 4; ++ef) { const f32x4 a = acc[ef][qf]; s += (a[0] * a[0] + a[1] * a[1]) + (a[2] * a[2] + a[3] * a[3]); }
        s += __shfl_xor(s, 16); s += __shfl_xor(s, 32); ss[qf] = s; }
    if (fq == 0) {
#pragma unroll
        for (int qf = 0; qf < 8; ++qf) red[w * 128 + 16 * qf + fr] = ss[qf]; }
    LDS_WAIT(); RAW_BAR();
    { const size_t ub = ((size_t)(mrow0 + i0) * DVT + h * DVH + 64 * w) * 2;
      const char* gbase = (const char*)WSB(F, WS_GR) + ub; char* obase = (char*)WSB(F, WS_ARET) + ub;
      const unsigned loff = (unsigned)(fr * (DVT * 2) + fq * 8);
#pragma unroll
      for (int qf = 0; qf < 8; ++qf) { float tot = 0.f;
#pragma unroll
          for (int ww = 0; ww < 8; ++ww) tot += red[ww * 128 + 16 * qf + fr];
          const float rstd = rsqrtf(tot * (1.0f / DVH) + EPS);
#pragma unroll
          for (int ef = 0; ef < 4; ++ef) { const size_t uo = (size_t)qf * (16 * DVT * 2) + ef * 32;
              const u32x2 g = *(const u32x2*)(gbase + uo + loff); const f32x4 a = acc[ef][qf];
              u32x2 o; o.x = cvt_pk_bf16(a[0] * rstd * bf_lo(g.x), a[1] * rstd * bf_hi(g.x)); o.y = cvt_pk_bf16(a[2] * rstd * bf_lo(g.y), a[3] * rstd * bf_hi(g.y));
              *(u32x2*)(obase + uo + loff) = o; }
          CFENCE(); } }
    LDS_WAIT(); RAW_BAR();
}

constexpr int SS_Q = 110592, SS_K = 126976, SS_D = 143360, SS_RED = 143616;
struct StreamSt {
    f32x4 cr[4], vd[4], bc[4];
    const char* s0; char* s1;
    unsigned toff; int git;
    const LAS float* sq; const LAS float* sk; float g4;
};
__device__ __forceinline__ void stream_load(StreamSt& T, int it) {
#pragma unroll
    for (int k = 0; k < 4; ++k) T.bc[k] = __builtin_nontemporal_load((const f32x4*)(T.s0 + (size_t)((4 * it + k) * (DVH * 4)) + T.toff));
}
__device__ __forceinline__ void stream_proc(StreamSt& T, int it) {
#pragma unroll
    for (int k = 0; k < 4; ++k) { const int d = 4 * it + k; const f32x4 s = T.bc[k]; f32x4 sn = s * T.g4;
#pragma unroll
        for (int j = 0; j < 4; ++j) { T.cr[j] += s * T.sq[j * 256 + d]; sn += T.vd[j] * T.sk[j * 256 + d]; }
        __builtin_nontemporal_store(sn, (f32x4*)(T.s1 + (size_t)(d * (DVH * 4)) + T.toff)); }
}
constexpr int F6_KBUF = 0, F6_PBUF = 65536, F6_RED = 73728, F6_QBUF = 77824;
template <bool STREAM>
__device__ __forceinline__ void flash64_unit(const Frame& F, int b, int h, int qb, StreamSt& T) {
    LAS unsigned char* lds = F.lds;
    const int lane = opaque_tid() & 63;
    const int w = F.wave, qfw = w & 3, kf0 = 2 * (w >> 2);
    const int i0 = qb * 64; const int mrow0 = b * SEQ;
    const float L2g = log2gamma(h);
    { const char* qb_ = (const char*)WSB(F, WS_Q) + ((size_t)(mrow0 + i0) * DM + h * DK) * 2;
      const int r0 = lane >> 5, cp = lane & 31;
#pragma unroll
      for (int i = 0; i < 4; ++i) { const int row = 8 * w + 2 * i + r0; const unsigned off = (unsigned)(row * (DM * 2) + ((cp ^ (row & 15)) * 16));
          __builtin_amdgcn_global_load_lds((const unsigned*)(qb_ + off), (LAS unsigned*)(lds + F6_QBUF + (4 * w + i) * 1024), 16, 0, 0); } }
    f32x4 acc[4][4];
#pragma unroll
    for (int ef = 0; ef < 4; ++ef)
#pragma unroll
        for (int qf = 0; qf < 4; ++qf) acc[ef][qf] = (f32x4){0.f, 0.f, 0.f, 0.f};
    const int nkb = qb + 1;
    const char* kbase = (const char*)WSB(F, WS_K) + ((size_t)mrow0 * DM + h * DK) * 2;
    const int krow0 = 2 * w + (lane >> 5);
    const unsigned ksrc = (unsigned)(krow0 * (DM * 2) + (((lane & 31) ^ (krow0 & 15)) * 16));
#define F6_STAGE_K(jb, buf) do { const char* kb_ = kbase + (size_t)(jb) * (64 * DM * 2); _Pragma("unroll") for (int i = 0; i < 4; ++i) \
        __builtin_amdgcn_global_load_lds((const unsigned*)(kb_ + (size_t)i * (16 * DM * 2) + ksrc), (LAS unsigned*)(lds + F6_KBUF + (buf) * 32768 + i * 8192 + w * 1024), 16, 0, 0); } while (0)
    F6_STAGE_K(0, 0);
    const char* vbase = (const char*)WSB(F, WS_VT) + ((size_t)(h * DVH + 64 * w) * LDV + mrow0) * 2;
    float c2[4];
#pragma unroll
    for (int r = 0; r < 4; ++r) c2[r] = __builtin_amdgcn_exp2f(-L2g * (float)(4 * (lane >> 4) + r));
    bf16x8 Vf[4][2];
    { const unsigned voff = (unsigned)((lane & 15) * (LDV * 2) + (lane >> 4) * 16);
#pragma unroll
      for (int ef = 0; ef < 4; ++ef)
#pragma unroll
          for (int ks = 0; ks < 2; ++ks) Vf[ef][ks] = *(const bf16x8*)(vbase + (size_t)ef * (16 * LDV * 2) + ks * 64 + voff); }
    VM_WAIT();
    for (int jb = 0; jb < nkb; ++jb) {
        RAW_BAR();
        const bool more = jb + 1 < nkb;
        if (more) F6_STAGE_K(jb + 1, (jb + 1) & 1);
        int fr = lane & 15, fq = lane >> 4; asm volatile("" : "+v"(fr), "+v"(fq));
        f32x4 sacc[2];
        sacc[0] = (f32x4){0.f, 0.f, 0.f, 0.f}; sacc[1] = (f32x4){0.f, 0.f, 0.f, 0.f};
        { const LAS unsigned char* kl = lds + F6_KBUF + (jb & 1) * 32768 + (16 * kf0 + fr) * 512;
          const LAS unsigned char* ql_ = lds + F6_QBUF + (16 * qfw + fr) * 512;
          bf16x8 Qa, Ka0, Ka1, Qb, Kb0, Kb1;
          { const int s0 = (fq ^ fr) * 16, s1 = ((4 + fq) ^ fr) * 16;
            Qa = *(const LAS bf16x8*)(ql_ + s0); Ka0 = *(const LAS bf16x8*)(kl + s0); Ka1 = *(const LAS bf16x8*)(kl + 8192 + s0);
            Qb = *(const LAS bf16x8*)(ql_ + s1); Kb0 = *(const LAS bf16x8*)(kl + s1); Kb1 = *(const LAS bf16x8*)(kl + 8192 + s1); }
#pragma unroll
          for (int ks = 0; ks < 8; ++ks) { const bf16x8 Qc = Qa, Kc0 = Ka0, Kc1 = Ka1;
              Qa = Qb; Ka0 = Kb0; Ka1 = Kb1;
              if (ks < 6) { const int sw = (((ks + 2) * 4 + fq) ^ fr) * 16; Qb = *(const LAS bf16x8*)(ql_ + sw); Kb0 = *(const LAS bf16x8*)(kl + sw); Kb1 = *(const LAS bf16x8*)(kl + 8192 + sw); }
              __builtin_amdgcn_sched_barrier(0);
              sacc[0] = __builtin_amdgcn_mfma_f32_16x16x32_bf16(Kc0, Qc, sacc[0], 0, 0, 0);
              sacc[1] = __builtin_amdgcn_mfma_f32_16x16x32_bf16(Kc1, Qc, sacc[1], 0, 0, 0);
              __builtin_amdgcn_sched_barrier(0); } }
        { const int ql = 16 * qfw + fr, iq = i0 + ql;
          const float rowf = __builtin_amdgcn_exp2f(L2g * (float)(iq - 64 * jb));
          const bool diag = jb == qb;
#pragma unroll
          for (int kk = 0; kk < 2; ++kk) { const int kf = kf0 + kk; const int jbase = 64 * jb + 16 * kf + 4 * fq; float pv[4];
              const float rk = rowf * __builtin_amdgcn_exp2f(L2g * (float)(-16 * kf));
#pragma unroll
              for (int r = 0; r < 4; ++r) { pv[r] = sacc[kk][r] * (rk * c2[r]); if (diag) pv[r] = (iq - (jbase + r)) >= 0 ? pv[r] : 0.f; }
              u32x2 pw; pw.x = cvt_pk_bf16(pv[0], pv[1]); pw.y = cvt_pk_bf16(pv[2], pv[3]);
              *(LAS u32x2*)(lds + F6_PBUF + ql * 128 + (((kf * 2 + (fq >> 1)) ^ ((ql >> 1) & 7)) * 16) + (fq & 1) * 8) = pw; } }
        LDS_WAIT(); RAW_BAR();
        { const LAS unsigned char* pl = lds + F6_PBUF + fr * 128;
          const char* vn_ = vbase + (size_t)(jb + 1) * 128; const unsigned voff = (unsigned)(fr * (LDV * 2) + fq * 16);
          bf16x8 Pf[2][4];
#pragma unroll
          for (int ks = 0; ks < 2; ++ks) { const int sw = (((ks * 4 + fq) ^ ((fr >> 1) & 7)) * 16);
#pragma unroll
              for (int qf = 0; qf < 4; ++qf) Pf[ks][qf] = *(const LAS bf16x8*)(pl + qf * 2048 + sw); }
#pragma unroll
          for (int ks = 0; ks < 2; ++ks) {
#pragma unroll
              for (int qf = 0; qf < 4; ++qf)
#pragma unroll
                  for (int ef = 0; ef < 4; ++ef) acc[ef][qf] = __builtin_amdgcn_mfma_f32_16x16x32_bf16(Vf[ef][ks], Pf[ks][qf], acc[ef][qf], 0, 0, 0);
              if (more) {
#pragma unroll
                  for (int ef = 0; ef < 4; ++ef) Vf[ef][ks] = *(const bf16x8*)(vn_ + (size_t)ef * (16 * LDV * 2) + ks * 64 + voff); } } }
        if constexpr (STREAM) {
            const int it = T.git; T.git = it + 1;
            if (it < 63) { stream_proc(T, it); stream_load(T, it + 1); if (more) asm volatile("s_waitcnt vmcnt(16)" ::: "memory"); }
            else if (it == 63) { stream_proc(T, it); if (more) asm volatile("s_waitcnt vmcnt(12)" ::: "memory"); }
            else { if (more) asm volatile("s_waitcnt vmcnt(8)" ::: "memory"); }
        } else {
            asm volatile("s_waitcnt vmcnt(8)" ::: "memory");
        }
    }
#undef F6_STAGE_K
    LAS float* red = (LAS float*)(lds + F6_RED);
    { const int fr = lane & 15, fq = lane >> 4;
      float ss[4];
#pragma unroll
      for (int qf = 0; qf < 4; ++qf) { float s = 0.f;
#pragma unroll
          for (int ef = 0; ef < 4; ++ef) { const f32x4 a = acc[ef][qf]; s += (a[0] * a[0] + a[1] * a[1]) + (a[2] * a[2] + a[3] * a[3]); }
          s += __shfl_xor(s, 16); s += __shfl_xor(s, 32); ss[qf] = s; }
      if (fq == 0) {
#pragma unroll
          for (int qf = 0; qf < 4; ++qf) red[w * 64 + 16 * qf + fr] = ss[qf]; }
      LDS_WAIT(); RAW_BAR();
      const size_t ub = ((size_t)(mrow0 + i0) * DVT + h * DVH + 64 * w) * 2;
      const char* gbase = (const char*)WSB(F, WS_GR) + ub; char* obase = (char*)WSB(F, WS_ARET) + ub;
      const unsigned loff = (unsigned)(fr * (DVT * 2) + fq * 8);
#pragma unroll
      for (int qf = 0; qf < 4; ++qf) { float tot = 0.f;
#pragma unroll
          for (int ww = 0; ww < 8; ++ww) tot += red[ww * 64 + 16 * qf + fr];
          const float rstd = rsqrtf(tot * (1.0f / DVH) + EPS);
#pragma unroll
          for (int ef = 0; ef < 4; ++ef) { const size_t uo = (size_t)qf * (16 * DVT * 2) + ef * 32;
              const u32x2 g = *(const u32x2*)(gbase + uo + loff); const f32x4 a = acc[ef][qf];
              u32x2 o; o.x = cvt_pk_bf16(a[0] * rstd * bf_lo(g.x), a[1] * rstd * bf_hi(g.x)); o.y = cvt_pk_bf16(a[2] * rstd * bf_lo(g.y), a[3] * rstd * bf_hi(g.y));
              *(u32x2*)(obase + uo + loff) = o; }
          CFENCE(); } }
    LDS_WAIT(); RAW_BAR();
}

constexpr int SM_QS = 0, SM_KS = 4096, SM_VS = 8192, SM_SD = 16384, SM_RED = 16640, SM_XR = 32768;
__device__ __forceinline__ void sample_unit(const Frame& F, int b, int h) {
    LAS unsigned char* lds = F.lds;
    const int tid = opaque_tid();
    const int lane = tid & 63, w = tid >> 6;
    LAS float* qs = (LAS float*)(lds + SM_QS); LAS float* ks = (LAS float*)(lds + SM_KS); LAS float* vs = (LAS float*)(lds + SM_VS);
    LAS float* sd = (LAS float*)(lds + SM_SD); LAS float* red = (LAS float*)(lds + SM_RED); LAS float* xr = (LAS float*)(lds + SM_XR);
    const int m0 = MP + 4 * b;
    const float L2g = log2gamma(h);
    for (int e = tid; e < 1024; e += NTHREADS) { const int t = e >> 8, d = e & 255, dp = d < 128 ? 2 * d : 2 * (d - 128) + 1;
        qs[e] = bf1(WSB(F, WS_Q)[(size_t)(m0 + t) * DM + h * DK + dp]); ks[e] = bf1(WSB(F, WS_K)[(size_t)(m0 + t) * DM + h * DK + dp]); }
    { const int e = tid; const u32x2 vv = *(const u32x2*)(WSB(F, WS_VT) + (size_t)(h * DVH + e) * LDV + m0);
      vs[0 * 512 + e] = bf_lo(vv.x); vs[1 * 512 + e] = bf_hi(vv.x); vs[2 * 512 + e] = bf_lo(vv.y); vs[3 * 512 + e] = bf_hi(vv.y); }
    LDS_WAIT(); RAW_BAR();
#pragma unroll
    for (int pp = 0; pp < 2; ++pp) { const int pr = 2 * w + pp, t = pr >> 2, j = pr & 3; float s = 0.f;
#pragma unroll
        for (int i = 0; i < 4; ++i) s += qs[t * 256 + lane + 64 * i] * ks[j * 256 + lane + 64 * i];
        s = wave_sum(s);
        if (lane == 0) sd[pr] = (j <= t) ? s * __builtin_amdgcn_exp2f(L2g * (float)(t - j)) : 0.f; }
    const int e4 = (tid & 127) * 4, dg = tid >> 7;
    f32x4 vd[4];
#pragma unroll
    for (int j = 0; j < 4; ++j) { const float dj = __builtin_amdgcn_exp2f(L2g * (float)(3 - j)); vd[j] = (f32x4){vs[j * 512 + e4], vs[j * 512 + e4 + 1], vs[j * 512 + e4 + 2], vs[j * 512 + e4 + 3]} * dj; }
    const float g4 = __builtin_amdgcn_exp2f(L2g * 4.0f);
    f32x4 cr[4];
#pragma unroll
    for (int t = 0; t < 4; ++t) cr[t] = (f32x4){0.f, 0.f, 0.f, 0.f};
    const char* s0 = (const char*)(INP(F, I_SRET) + ((size_t)(b * NH + h) * DK) * DVH);
    char* s1 = (char*)(F.out + OFF_RS + ((size_t)(b * NH + h) * DK) * DVH);
    const unsigned toff = (unsigned)((dg * DVH + e4) * 4);
    f32x4 bA[16], bB[16];
#define SM_LOAD(buf, bt) do { _Pragma("unroll") for (int k_ = 0; k_ < 16; ++k_) buf[k_] = __builtin_nontemporal_load((const f32x4*)(s0 + (size_t)(((bt) * 16 + k_) * (4 * DVH * 4)) + toff)); } while (0)
#define SM_PROC(buf, bt) do { _Pragma("unroll") for (int k_ = 0; k_ < 16; ++k_) { const int d = ((bt) * 16 + k_) * 4 + dg; const f32x4 s = buf[k_]; f32x4 sn = s * g4; \
        _Pragma("unroll") for (int j = 0; j < 4; ++j) { cr[j] += s * qs[j * 256 + d]; sn += vd[j] * ks[j * 256 + d]; } \
        __builtin_nontemporal_store(sn, (f32x4*)(s1 + (size_t)(((bt) * 16 + k_) * (4 * DVH * 4)) + toff)); } } while (0)
    SM_LOAD(bA, 0); SM_LOAD(bB, 1);
    SM_PROC(bA, 0); SM_LOAD(bA, 2);
    SM_PROC(bB, 1); SM_LOAD(bB, 3);
    SM_PROC(bA, 2);
    SM_PROC(bB, 3);
#undef SM_LOAD
#undef SM_PROC
#pragma unroll
    for (int t = 0; t < 4; ++t) *(LAS f32x4*)(xr + (dg * 4 + t) * 512 + e4) = cr[t];
    LDS_WAIT(); RAW_BAR();
    { const int e = tid; float o[4];
#pragma unroll
      for (int t = 0; t < 4; ++t) { float c = (xr[(0 * 4 + t) * 512 + e] + xr[(1 * 4 + t) * 512 + e]) + (xr[(2 * 4 + t) * 512 + e] + xr[(3 * 4 + t) * 512 + e]);
          float in = 0.f;
#pragma unroll
          for (int j = 0; j < 4; ++j) in += sd[t * 4 + j] * vs[j * 512 + e];
          o[t] = in + c * __builtin_amdgcn_exp2f(L2g * (float)(t + 1)); }
#pragma unroll
      for (int t = 0; t < 4; ++t) { const float s = wave_sum(o[t] * o[t]); if (lane == 0) red[w * 4 + t] = s; }
      LDS_WAIT(); RAW_BAR();
#pragma unroll
      for (int t = 0; t < 4; ++t) { float tot = 0.f;
#pragma unroll
          for (int ww = 0; ww < 8; ++ww) tot += red[ww * 4 + t];
          const float rstd = rsqrtf(tot * (1.0f / DVH) + EPS);
          const size_t off = (size_t)(m0 + t) * DVT + h * DVH + e;
          const float val = o[t] * rstd * bf1(WSB(F, WS_GR)[off]);
          WSB(F, WS_ARET)[off] = (bf16_t)(cvt_pk_bf16(val, 0.f) & 0xffffu); } }
    LDS_WAIT(); RAW_BAR();
}

__device__ __forceinline__ void conv_branch_range(const Frame& F, int i0, int i1) {
#pragma unroll 2
    for (int it = i0 + opaque_tid(); it < i1; it += NTHREADS) { const int m = it >> 8, c = (it & 255) * 8;
        f32x4 u2a, u2b, u1a, u1b, u0a, u0b;
        unpack8(*(const u32x4*)(WSB(F, WS_CPR) + (size_t)m * DM + c), u2a, u2b);
        const f32x4 z = (f32x4){0.f, 0.f, 0.f, 0.f}; u1a = z; u1b = z; u0a = z; u0b = z;
        if (m < MP) { const int t = m & (SEQ - 1);
            if (t >= 1) unpack8(*(const u32x4*)(WSB(F, WS_CPR) + (size_t)(m - 1) * DM + c), u1a, u1b);
            if (t >= 2) unpack8(*(const u32x4*)(WSB(F, WS_CPR) + (size_t)(m - 2) * DM + c), u0a, u0b);
        } else { const int ms = m - MP, b = ms >> 2, t = ms & 3;
            if (t + 1 >= 2) unpack8(*(const u32x4*)(WSB(F, WS_CPR) + (size_t)(m - 1) * DM + c), u1a, u1b); else { const float* sp = INP(F, I_SCONV) + ((size_t)b * 2 + (t + 1)) * DM + c; u1a = *(const f32x4*)sp; u1b = *(const f32x4*)(sp + 4); }
            if (t >= 2) unpack8(*(const u32x4*)(WSB(F, WS_CPR) + (size_t)(m - 2) * DM + c), u0a, u0b); else { const float* sp = INP(F, I_SCONV) + ((size_t)b * 2 + t) * DM + c; u0a = *(const f32x4*)sp; u0b = *(const f32x4*)(sp + 4); } }
        const f32x4 w0a = *(const f32x4*)(INP(F, I_CONVW) + c), w0b = *(const f32x4*)(INP(F, I_CONVW) + c + 4), w1a = *(const f32x4*)(INP(F, I_CONVW) + DM + c), w1b = *(const f32x4*)(INP(F, I_CONVW) + DM + c + 4),
                    w2a = *(const f32x4*)(INP(F, I_CONVW) + 2 * DM + c), w2b = *(const f32x4*)(INP(F, I_CONVW) + 2 * DM + c + 4);
        f32x4 ga, gb; unpack8(__builtin_nontemporal_load((const u32x4*)(WSB(F, WS_GB) + (size_t)m * DM + c)), ga, gb);
        const f32x4 oa = (w0a * u0a + w1a * u1a + w2a * u2a) * ga, ob = (w0b * u0b + w1b * u1b + w2b * u2b) * gb;
        *(u32x4*)(WSB(F, WS_ACONV) + (size_t)m * DM + c) = pack8(oa, ob); }
}
__device__ __forceinline__ void kht_prep(const Frame& F, int wi, int nw) {
    LAS float* scr = (LAS float*)(F.lds + F.wave * 16640);
    const int lane = opaque_tid() & 63;
    const int gw = wi * NWAVES + F.wave, NGW = nw * NWAVES;
    constexpr int NIT = NBATCH * NH * (SEQ / 64) * (DK / 64);
    for (int it = gw; it < NIT; it += NGW) { const int db = it & 3, tb = (it >> 2) & 31, bh = it >> 7, b = bh >> 3, h = bh & 7;
        const float L2g = log2gamma(h);
        const int t0 = 64 * tb, d0 = 64 * db;
#pragma unroll
        for (int i = 0; i < 8; ++i) { const int tr = (lane >> 3) + 8 * i, cc = lane & 7;
            f32x4 a, bq; unpack8(*(const u32x4*)(WSB(F, WS_K) + (size_t)(b * SEQ + t0 + tr) * DM + h * DK + d0 + 8 * cc), a, bq);
            const float dec = __builtin_amdgcn_exp2f(L2g * (float)(SEQ - 1 - (t0 + tr)));
            LAS float* sp = scr + tr * 65 + 8 * cc;
            sp[0] = a[0] * dec; sp[1] = a[1] * dec; sp[2] = a[2] * dec; sp[3] = a[3] * dec; sp[4] = bq[0] * dec; sp[5] = bq[1] * dec; sp[6] = bq[2] * dec; sp[7] = bq[3] * dec; }
        LDS_WAIT(); CFENCE();
#pragma unroll
        for (int j = 0; j < 8; ++j) { const int n = (lane >> 3) + 8 * j, cc = lane & 7; const LAS float* s = scr + (8 * cc) * 65 + n;
            u32x4 o; o.x = cvt_pk_bf16(s[0 * 65], s[1 * 65]); o.y = cvt_pk_bf16(s[2 * 65], s[3 * 65]); o.z = cvt_pk_bf16(s[4 * 65], s[5 * 65]); o.w = cvt_pk_bf16(s[6 * 65], s[7 * 65]);
            *(u32x4*)(WSB(F, WS_KHT) + ((size_t)bh * DK + d0 + n) * SEQ + t0 + 8 * cc) = o; }
        LDS_WAIT(); CFENCE(); }
}

__device__ __forceinline__ void p2_merged(const Frame& F) {
    LAS unsigned char* lds = F.lds;
    const int tid = opaque_tid(), lane = tid & 63, g = tid >> 7, wg = (tid >> 6) & 1, e4 = (tid & 127) * 4;
    const int su = 4 * F.vcu + g, bS = su >> 3, hS = su & 7, m0 = MP + 4 * bS;
    const float L2g = log2gamma(hS);
    LAS float* sq = (LAS float*)(lds + SS_Q) + g * 1024; LAS float* sk = (LAS float*)(lds + SS_K) + g * 1024;
    LAS float* sd = (LAS float*)(lds + SS_D) + g * 16; LAS float* sred = (LAS float*)(lds + SS_RED);
    for (int e = (tid & 127); e < 1024; e += 128) { const int t = e >> 8, d = e & 255, dp = d < 128 ? 2 * d : 2 * (d - 128) + 1;
        sq[e] = bf1(WSB(F, WS_Q)[(size_t)(m0 + t) * DM + hS * DK + dp]); sk[e] = bf1(WSB(F, WS_K)[(size_t)(m0 + t) * DM + hS * DK + dp]); }
    StreamSt T;
    {
      f32x4 v[4];
#pragma unroll
      for (int c = 0; c < 4; ++c) { const u32x2 vv = *(const u32x2*)(WSB(F, WS_VT) + (size_t)(hS * DVH + e4 + c) * LDV + m0);
          v[0][c] = bf_lo(vv.x); v[1][c] = bf_hi(vv.x); v[2][c] = bf_lo(vv.y); v[3][c] = bf_hi(vv.y); }
#pragma unroll
      for (int j = 0; j < 4; ++j) T.vd[j] = v[j] * __builtin_amdgcn_exp2f(L2g * (float)(3 - j)); }
#pragma unroll
    for (int t = 0; t < 4; ++t) T.cr[t] = (f32x4){0.f, 0.f, 0.f, 0.f};
    T.s0 = (const char*)(INP(F, I_SRET) + ((size_t)(bS * NH + hS) * DK) * DVH); T.s1 = (char*)(F.out + OFF_RS + ((size_t)(bS * NH + hS) * DK) * DVH);
    T.toff = (unsigned)(e4 * 4); T.git = 0; T.sq = sq; T.sk = sk; T.g4 = __builtin_amdgcn_exp2f(L2g * 4.0f);
    stream_load(T, 0);
    LDS_WAIT(); RAW_BAR();
#pragma unroll
    for (int i = 0; i < 8; ++i) { const int pr = 8 * wg + i, t = pr >> 2, j = pr & 3; float sc = 0.f;
#pragma unroll
        for (int i4 = 0; i4 < 4; ++i4) sc += sq[t * 256 + lane + 64 * i4] * sk[j * 256 + lane + 64 * i4];
        sc = wave_sum(sc);
        if (lane == 0) sd[pr] = (j <= t) ? sc * __builtin_amdgcn_exp2f(L2g * (float)((t - j) - (3 - j))) : 0.f; }
    LDS_WAIT(); RAW_BAR();
    { const int p = F.vcu, bh = p >> 3, ql = p & 7, b_ = bh >> 3, h_ = bh & 7;
#pragma unroll 1
      for (int u = 0; u < 4; ++u) { const int qb = u == 0 ? 31 - ql : u == 1 ? 16 + ql : u == 2 ? 15 - ql : ql; flash64_unit<true>(F, b_, h_, qb, T); } }
    while (T.git < 64) { const int it = T.git; T.git = it + 1; stream_proc(T, it); if (it < 63) stream_load(T, it + 1); }
    f32x4 o[4];
    float L2e = L2g; asm volatile("" : "+v"(L2e));
#pragma unroll
    for (int t = 0; t < 4; ++t) { f32x4 in = (f32x4){0.f, 0.f, 0.f, 0.f};
#pragma unroll
        for (int j = 0; j < 4; ++j) in += T.vd[j] * sd[t * 4 + j];
        o[t] = in + T.cr[t] * __builtin_amdgcn_exp2f(L2e * (float)(t + 1));
        const float ps = wave_sum((o[t][0] * o[t][0] + o[t][1] * o[t][1]) + (o[t][2] * o[t][2] + o[t][3] * o[t][3]));
        if (lane == 0) sred[(g * 2 + wg) * 4 + t] = ps; }
    LDS_WAIT(); RAW_BAR();
#pragma unroll
    for (int t = 0; t < 4; ++t) { const float tot = sred[(g * 2) * 4 + t] + sred[(g * 2 + 1) * 4 + t];
        const float rstd = rsqrtf(tot * (1.0f / DVH) + EPS);
        const size_t off = (size_t)(m0 + t) * DVT + hS * DVH + e4;
        const u32x2 gg = *(const u32x2*)(WSB(F, WS_GR) + off);
        u32x2 ow; ow.x = cvt_pk_bf16(o[t][0] * rstd * bf_lo(gg.x), o[t][1] * rstd * bf_hi(gg.x)); ow.y = cvt_pk_bf16(o[t][2] * rstd * bf_lo(gg.y), o[t][3] * rstd * bf_hi(gg.y));
        *(u32x2*)(WSB(F, WS_ARET) + off) = ow; }
    LDS_WAIT(); RAW_BAR();
}

__device__ __forceinline__ void conv_branch_range(const Frame& F, int i0, int i1);

__device__ __forceinline__ void p2_main(const Frame& F, int c) {
    unsigned* cnt = (unsigned*)(F.ws + WS_STCNT);
    { SchedState S{(const char*)WSB(F, WS_KHT), (const char*)WSB(F, WS_VT), c}; EpiState E{WSB(F, WS_ST)}; gemm_phase<false>(F.lds, S, E); }
    if (c < 192) {
        if (threadIdx.x == 0) { __builtin_amdgcn_fence(__ATOMIC_RELEASE, "agent"); asm volatile("s_waitcnt vmcnt(0)" ::: "memory");
            __hip_atomic_fetch_add(cnt, 1u, __ATOMIC_RELAXED, __HIP_MEMORY_SCOPE_AGENT); }
    }
    const int vc = F.vcu;
    const int nS = vc < DECB * NH ? (DECB * NH - vc + F.G - 1) / F.G : 0, nP = vc < 256 ? (256 - vc + F.G - 1) / F.G : 0;
    const int typ = (vc >> 3) % 3, fpos = typ == 0 ? (nS < 1 ? nS : 1) : typ == 1 ? nS / 2 : nS;
    int ns = 0, nf = 0;
#pragma unroll 1
    for (int slot = 0; slot < nS + 2 * nP; ++slot) {
        if (slot >= fpos && nf < 2 * nP) {
            if (nf == 0) {
                if (threadIdx.x == 0) { unsigned sp = 0;
                    while (__hip_atomic_load(cnt, __ATOMIC_RELAXED, __HIP_MEMORY_SCOPE_AGENT) < 192u) { __builtin_amdgcn_s_sleep(2); if (++sp > (1u << 22)) break; }
                    __builtin_amdgcn_fence(__ATOMIC_ACQUIRE, "agent"); asm volatile("s_waitcnt vmcnt(0)" ::: "memory"); }
                __syncthreads(); }
            const int p = vc + (nf >> 1) * F.G, bh = p >> 3, ql = p & 7;
            flash_unit(F, bh >> 3, bh & 7, (nf & 1) ? ql : 15 - ql); ++nf;
        } else { const int su = vc + ns * F.G; ++ns; sample_unit(F, su >> 3, su & 7); }
    }
    { constexpr int NIT = MT * (DM / 8), PER = (NIT + 383) / 384;
      if (F.G == 256) { const int wgt = c >> 6, u0 = c < 64 ? 0 : c < 128 ? (c - 64) : c < 192 ? 64 + 2 * (c - 128) : 192 + 3 * (c - 192);
          const int i0 = u0 * PER, i1 = (u0 + wgt) * PER < NIT ? (u0 + wgt) * PER : NIT; conv_branch_range(F, i0, i1); }
      else { const int per = (NIT + F.G - 1) / F.G; const int i0 = c * per, i1 = (c + 1) * per < NIT ? (c + 1) * per : NIT; conv_branch_range(F, i0, i1); } }
}

__device__ __forceinline__ void p5_rows(const Frame& F) {
    const int gw = F.vcu * NWAVES + F.wave, NGW = F.G * NWAVES, lane = opaque_tid() & 63;
#pragma unroll 2
    for (int m = gw; m < MT; m += NGW) {
        const u32x2* mr = (const u32x2*)(WSB(F, WS_MIX) + (size_t)m * DM) + lane; const f32x4* xr = (const f32x4*)xrow(F, m) + lane;
        f32x4 v[8]; float s = 0.f;
#pragma unroll
        for (int j = 0; j < 8; ++j) { const u32x2 w_ = mr[64 * j]; v[j] = (f32x4){bf_lo(w_.x), bf_hi(w_.x), bf_lo(w_.y), bf_hi(w_.y)}; s += (v[j][0] * v[j][0] + v[j][1] * v[j][1]) + (v[j][2] * v[j][2] + v[j][3] * v[j][3]); }
        const float r1 = rsqrtf(wave_sum(s) * (1.0f / DM) + EPS); float s2 = 0.f;
#pragma unroll
        for (int j = 0; j < 8; ++j) { const f32x4 g = ((const f32x4*)INP(F, I_GPOSTMIX))[lane + 64 * j]; v[j] = __builtin_nontemporal_load(xr + 64 * j) + v[j] * r1 * g;
            s2 += (v[j][0] * v[j][0] + v[j][1] * v[j][1]) + (v[j][2] * v[j][2] + v[j][3] * v[j][3]); __builtin_nontemporal_store(v[j], (f32x4*)(WSF(F, WS_X1) + (size_t)m * DM) + lane + 64 * j); }
        const float r2 = rsqrtf(wave_sum(s2) * (1.0f / DM) + EPS);
#pragma unroll
        for (int j = 0; j < 8; ++j) { const f32x4 g = ((const f32x4*)INP(F, I_GPREFFN))[lane + 64 * j]; const f32x4 y = v[j] * r2 * g;
            u32x2 w; w.x = cvt_pk_bf16(y[0], y[1]); w.y = cvt_pk_bf16(y[2], y[3]); ((u32x2*)(WSB(F, WS_HN) + (size_t)m * DM))[lane + 64 * j] = w; }
    }
}
__device__ __forceinline__ float gelu_tanh(float v) { const float u = 1.5957691216057308f * (v + 0.044715f * v * v * v); return v * __builtin_amdgcn_rcpf(1.0f + __builtin_amdgcn_exp2f(u * -1.4426950408889634f)); }
__device__ __forceinline__ void p7_elementwise(const Frame& F, int wi, int nw) {
    const int gt = wi * NTHREADS + opaque_tid(), NGT = nw * NTHREADS;
    constexpr int CPR8 = DFF / 8;
    constexpr int NFIX = 2 * (MP / 256) + 2 * DECB;
    for (int it = gt; it < NFIX * CPR8; it += NGT) { const int k = it / CPR8, c = (it - k * CPR8) * 8;
        const int m = k < 64 ? (k >> 1) * 256 + (k & 1) : MP + ((k - 64) >> 1) * 4 + ((k - 64) & 1);
        f32x4 u2a, u2b, u1a, u1b, u0a, u0b;
        unpack8(*(const u32x4*)(WSB(F, WS_U) + (size_t)m * DFF + c), u2a, u2b);
        const f32x4 z = (f32x4){0.f, 0.f, 0.f, 0.f}; u1a = z; u1b = z; u0a = z; u0b = z;
        if (m < MP) { const int t = m & (SEQ - 1);
            if (t >= 1) unpack8(*(const u32x4*)(WSB(F, WS_U) + (size_t)(m - 1) * DFF + c), u1a, u1b);
            if (t >= 2) unpack8(*(const u32x4*)(WSB(F, WS_U) + (size_t)(m - 2) * DFF + c), u0a, u0b);
        } else { const int ms = m - MP, b = ms >> 2, t = ms & 3;
            if (t + 1 >= 2) unpack8(*(const u32x4*)(WSB(F, WS_U) + (size_t)(m - 1) * DFF + c), u1a, u1b); else { const float* sp = INP(F, I_SFFN) + ((size_t)b * 2 + (t + 1)) * DFF + c; u1a = *(const f32x4*)sp; u1b = *(const f32x4*)(sp + 4); }
            if (t >= 2) unpack8(*(const u32x4*)(WSB(F, WS_U) + (size_t)(m - 2) * DFF + c), u0a, u0b); else { const float* sp = INP(F, I_SFFN) + ((size_t)b * 2 + t) * DFF + c; u0a = *(const f32x4*)sp; u0b = *(const f32x4*)(sp + 4); } }
        const float* cw = INP(F, I_FCW) + c;
        const f32x4 w0a = *(const f32x4*)cw, w0b = *(const f32x4*)(cw + 4), w1a = *(const f32x4*)(cw + DFF), w1b = *(const f32x4*)(cw + DFF + 4), w2a = *(const f32x4*)(cw + 2 * DFF), w2b = *(const f32x4*)(cw + 2 * DFF + 4);
        const f32x4 ba = *(const f32x4*)(INP(F, I_FCB) + c), bb = *(const f32x4*)(INP(F, I_FCB) + c + 4);
        f32x4 ga, gb; unpack8(__builtin_nontemporal_load((const u32x4*)(WSB(F, WS_G) + (size_t)m * DFF + c)), ga, gb);
        f32x4 va = w0a * u0a + w1a * u1a + w2a * u2a + ba, vb = w0b * u0b + w1b * u1b + w2b * u2b + bb, oa, ob;
#pragma unroll
        for (int j = 0; j < 4; ++j) { oa[j] = gelu_tanh(va[j]) * ga[j]; ob[j] = gelu_tanh(vb[j]) * gb[j]; }
        *(u32x4*)(WSB(F, WS_AFF) + (size_t)m * DFF + c) = pack8(oa, ob); }
}
__device__ __forceinline__ void p9_rows(const Frame& F) {
    const int gw = F.vcu * NWAVES + F.wave, NGW = F.G * NWAVES, lane = opaque_tid() & 63;
#pragma unroll 2
    for (int m = gw; m < MT; m += NGW) {
        const u32x2* fr_ = (const u32x2*)(WSB(F, WS_F) + (size_t)m * DM) + lane; const f32x4* xr = (const f32x4*)(WSF(F, WS_X1) + (size_t)m * DM) + lane;
        f32x4 v[8]; float s = 0.f;
#pragma unroll
        for (int j = 0; j < 8; ++j) { const u32x2 w_ = fr_[64 * j]; v[j] = (f32x4){bf_lo(w_.x), bf_hi(w_.x), bf_lo(w_.y), bf_hi(w_.y)}; s += (v[j][0] * v[j][0] + v[j][1] * v[j][1]) + (v[j][2] * v[j][2] + v[j][3] * v[j][3]); }
        const float r1 = rsqrtf(wave_sum(s) * (1.0f / DM) + EPS);
#pragma unroll
        for (int j = 0; j < 8; ++j) { const f32x4 g = ((const f32x4*)INP(F, I_GPOSTFFN))[lane + 64 * j]; __builtin_nontemporal_store(__builtin_nontemporal_load(xr + 64 * j) + v[j] * r1 * g, (f32x4*)(F.out + (size_t)m * DM) + lane + 64 * j); }
    }
}

__global__ void __launch_bounds__(NTHREADS, 2) fwd_kernel(Params P) {
    extern __shared__ __attribute__((aligned(16))) unsigned char lds_raw[];
    cg::grid_group grid = cg::this_grid();
    Frame F;
    F.lds = (LAS unsigned char*)lds_raw;
    F.wave = __builtin_amdgcn_readfirstlane((int)threadIdx.x >> 6);
    F.G = gridDim.x; { const int bx = blockIdx.x; F.vcu = (F.G % 8 == 0) ? (bx % 8) * (F.G / 8) + bx / 8 : bx; }
    F.P = &P; F.ws = P.ws; F.out = P.out;
    volatile LAS unsigned* bst = (volatile LAS unsigned*)(F.lds + LDS_BYTES - 64);
    if (threadIdx.x < 2) bst[threadIdx.x] = 0u;
    __syncthreads();
    const XcdBarrier xbar = xcd_barrier_post((unsigned*)(P.ws + WS_CTL), bst);
    const int lo = P.ph_lo, hi = P.ph_hi;
#define IN(k) (lo <= (k) && (k) < hi)
#define SEAM(k) do { if (IN(k) && IN((k) + 1)) xcd_barrier(xbar); } while (0)
    const int c = (int)blockIdx.x;
#ifndef PROBE_PH
#define PROBE_PH (-1)
#endif
#define REPS(k) (((k) == PROBE_PH) ? 2 : 1)
#define PHASE(k, ...) do { if (IN(k)) { for (int rep_ = 0; rep_ < REPS(k); ++rep_) { if (rep_) grid.sync(); __VA_ARGS__ } } SEAM(k); } while (0)
    PHASE(0, { p0_prologue(F); __syncthreads(); });
    PHASE(1, {
        const bool tailk = F.G == 256;
        Sched1 S{(const char*)WSB(F, WS_HN), (const char*)WSB(F, WS_WINT), F.G, c};
        Epi1 E{WSB(F, WS_Q), WSB(F, WS_K), WSB(F, WS_GR), WSB(F, WS_GB), WSB(F, WS_CPR), WSB(F, WS_GA), WSB(F, WS_GBT), WSB(F, WS_VT), WSF(F, WS_ROPE), F.out, (unsigned*)(F.ws + WS_P1CNT), tailk ? (2447 - c) / 256 : -1};
        gemm_phase<false>(F.lds, S, E);
        if (tailk && c >= 176) {
            if (threadIdx.x == 0) { unsigned* cnt = (unsigned*)(F.ws + WS_P1CNT); unsigned sp = 0;
                while (__hip_atomic_load(cnt, __ATOMIC_RELAXED, __HIP_MEMORY_SCOPE_AGENT) < 256u) { __builtin_amdgcn_s_sleep(8); if (++sp > (1u << 22)) break; }
                __builtin_amdgcn_fence(__ATOMIC_ACQUIRE, "agent"); asm volatile("s_waitcnt vmcnt(0)" ::: "memory"); }
            __syncthreads();
            kht_prep(F, c - 176, 80); } });
    PHASE(2, { if (F.G != 256) { kht_prep(F, F.vcu, F.G); xcd_barrier(xbar); } p2_main(F, c); __syncthreads(); });
    PHASE(3, {
        Sched3 S{(const char*)WSB(F, WS_ARET), (const char*)WSB(F, WS_PRETT), (const char*)WSB(F, WS_ACONV), (const char*)WSB(F, WS_PCONVT), F.G, c};
        Epi3 E{WSB(F, WS_GA), WSB(F, WS_GBT), WSF(F, WS_MTMP), WSB(F, WS_MBUF)};
        gemm_phase<true>(F.lds, S, E); });
    PHASE(4, {
        SchedX S{(const char*)WSB(F, WS_MBUF), (const char*)WSB(F, WS_WOT), 32, F.G, c, K_MIX};
        EpiB16 E{WSB(F, WS_MIX)};
        gemm_phase<true>(F.lds, S, E); });
    PHASE(5, { p5_rows(F); });
    PHASE(6, {
        Sched6 S{(const char*)WSB(F, WS_HN), (const char*)WSB(F, WS_WUGT), (const char*)WSB(F, WS_KHT), (const char*)WSB(F, WS_VT), F.G, c};
        Epi6 E{WSB(F, WS_U), WSB(F, WS_G), F.out, WSB(F, WS_ST), WSB(F, WS_AFF), INP(F, I_FCW), INP(F, I_FCB)};
        gemm_phase<false>(F.lds, S, E); });
    PHASE(7, {
        p7_elementwise(F, c, F.G); });
    PHASE(8, {
        SchedX S{(const char*)WSB(F, WS_AFF), (const char*)WSB(F, WS_WDT), 88, F.G, c, K_DOWN};
        Epi8 E{WSF(F, WS_X1), F.out, INP(F, I_GPOSTFFN), (unsigned long long*)(F.ws + WS_PART0)};
        gemm_phase<true>(F.lds, S, E); });
#undef PHASE
#undef REPS
#undef IN
#undef SEAM
}

extern "C" void kernel_launch(void* const* d_in, const int* in_sizes, int n_in, void* d_out, int out_size, void* d_ws, size_t ws_size, hipStream_t stream) {
    static int grid = 0;
    if (grid == 0) {
        if (n_in != 19 || (size_t)out_size != OUT_TOTAL || ws_size < WS_END) { fprintf(stderr, "kernel_launch: unexpected problem: n_in %d out %d ws %zu (need %zu)\n", n_in, out_size, ws_size, (size_t)WS_END); grid = -1; return; }
        int dev = 0, cus = 0, per_cu = 0;
        if (hipGetDevice(&dev) != hipSuccess || hipDeviceGetAttribute(&cus, hipDeviceAttributeMultiprocessorCount, dev) != hipSuccess) { grid = -1; return; }
        if (hipFuncSetAttribute((const void*)fwd_kernel, hipFuncAttributeMaxDynamicSharedMemorySize, LDS_BYTES) != hipSuccess) { fprintf(stderr, "kernel_launch: hipFuncSetAttribute failed\n"); grid = -1; return; }
        if (hipOccupancyMaxActiveBlocksPerMultiprocessor(&per_cu, (const void*)fwd_kernel, NTHREADS, LDS_BYTES) != hipSuccess || per_cu < 1) { fprintf(stderr, "kernel_launch: occupancy query failed (%d)\n", per_cu); (void)hipGetLastError(); grid = -1; return; }
        grid = cus * per_cu;
        fprintf(stderr, "kernel_launch: %d CUs x %d blocks/CU -> grid %d\n", cus, per_cu, grid);
    }
    if (grid < 0) return;
    if (hipMemsetAsync((char*)d_ws + WS_CTL, 0, WS_CTL_BYTES, stream) != hipSuccess) { fprintf(stderr, "kernel_launch: hipMemsetAsync failed\n"); return; }
    Params p{};
    for (int i = 0; i < 19; ++i) p.in[i] = (const float*)d_in[i];
    p.out = (float*)d_out; p.ws = (unsigned char*)d_ws; p.ph_lo = 0; p.ph_hi = 9;
    void* args[] = {&p};
    hipError_t e = hipLaunchCooperativeKernel((const void*)fwd_kernel, dim3(grid), dim3(NTHREADS), args, LDS_BYTES, stream);
    if (e != hipSuccess) fprintf(stderr, "kernel_launch: cooperative launch failed: %s (grid %d)\n", hipGetErrorString(e), grid);
}
```

```cpp
#include <hip/hip_runtime.h>
#include <hip/hip_cooperative_groups.h>
#include <cstdio>
#include <cstdint>
namespace cg = cooperative_groups;

#define LAS __attribute__((address_space(3)))
typedef unsigned short bf16_t;
typedef short bf16x8 __attribute__((ext_vector_type(8)));
typedef float f32x4 __attribute__((ext_vector_type(4)));
typedef float f32x2 __attribute__((ext_vector_type(2)));
typedef unsigned u32x4 __attribute__((ext_vector_type(4)));
typedef unsigned u32x2 __attribute__((ext_vector_type(2)));

constexpr int DM = 2048, SEQ = 2048, NBATCH = 4, MP = NBATCH * SEQ, DECB = 128, DECT = 4, MS = DECB * DECT, MT = MP + MS;
constexpr int DIN = 22528, NH = 8, DK = 256, DVH = 512, DVT = 4096, DFF = 5632;
constexpr int LDV = MT;
constexpr float EPS = 1e-6f;
constexpr int NWAVES = 8, NTHREADS = 512;
constexpr int LDS_BYTES = 163840;

constexpr size_t OFF_YP = 0, OFF_YS = 16777216, OFF_RP = 17825792, OFF_CP = 22020096, OFF_FP = 22036480, OFF_RS = 22081536, OFF_CS = 156299264, OFF_FS = 156823552, OUT_TOTAL = 158265344;

constexpr size_t al256(size_t x) { return (x + 255) & ~(size_t)255; }
constexpr size_t WS_CTL = 0;
constexpr size_t WS_WINT = 2u << 20;
constexpr size_t WS_PRETT = WS_WINT + al256((size_t)DIN * DM * 2);
constexpr size_t WS_PCONVT = WS_PRETT + al256((size_t)DM * DVT * 2);
constexpr size_t WS_WOT = WS_PCONVT + al256((size_t)DM * DM * 2);
constexpr size_t WS_WUGT = WS_WOT + al256((size_t)DM * DM * 2);
constexpr size_t WS_WDT = WS_WUGT + al256((size_t)2 * DFF * DM * 2);
constexpr size_t WS_HN = WS_WDT + al256((size_t)DM * DFF * 2);
constexpr size_t WS_Q = WS_HN + al256((size_t)MT * DM * 2);
constexpr size_t WS_K = WS_Q + al256((size_t)MT * DM * 2);
constexpr size_t WS_VT = WS_K + al256((size_t)MT * DM * 2);
constexpr size_t WS_GR = WS_VT + al256((size_t)DVT * LDV * 2);
constexpr size_t WS_GB = WS_GR + al256((size_t)MT * DVT * 2);
constexpr size_t WS_CPR = WS_GB + al256((size_t)MT * DM * 2);
constexpr size_t WS_GA = WS_CPR + al256((size_t)MT * DM * 2);
constexpr size_t WS_GBT = WS_GA + al256((size_t)MT * DM * 2);
constexpr size_t WS_KHT = WS_GBT + al256((size_t)MT * DM * 2);
constexpr size_t WS_ARET = WS_KHT + al256((size_t)NBATCH * NH * DK * SEQ * 2);
constexpr size_t WS_ACONV = WS_ARET + al256((size_t)MT * DVT * 2);
constexpr size_t WS_MTMP = WS_ACONV + al256((size_t)MT * DM * 2);
constexpr size_t WS_MBUF = WS_MTMP + al256((size_t)MT * DM * 4);
constexpr size_t WS_MIX = WS_MBUF + al256((size_t)MT * DM * 2);
constexpr size_t WS_X1 = WS_MIX + al256((size_t)MT * DM * 4);
constexpr size_t WS_U = WS_X1 + al256((size_t)MT * DM * 4);
constexpr size_t WS_G = WS_U + al256((size_t)MT * DFF * 2);
constexpr size_t WS_AFF = WS_G + al256((size_t)MT * DFF * 2);
constexpr size_t WS_F = WS_AFF + al256((size_t)MT * DFF * 2);
constexpr size_t WS_ROPE = WS_F + al256((size_t)MT * DM * 4);
constexpr size_t WS_ST = WS_ROPE + al256((size_t)2052 * 128 * 2 * 4);
constexpr size_t WS_END = WS_ST + al256((size_t)32 * 3 * DVH * DK * 2);
constexpr size_t WS_P1CNT = 16384 + 256;
constexpr size_t WS_STCNT = 16384;
constexpr size_t PART_BYTES = (size_t)32 * 272 * 8 * 8;
constexpr size_t WS_PART0 = 65536, WS_PART1 = WS_PART0 + PART_BYTES, WS_PART2 = WS_PART1 + PART_BYTES;
constexpr size_t WS_CTL_BYTES = 2u << 20;

typedef __bf16 bf16x2n_t __attribute__((ext_vector_type(2)));
__device__ __forceinline__ unsigned cvt_pk_bf16(float lo, float hi) { const f32x2 v = {lo, hi}; return __builtin_bit_cast(unsigned, __builtin_convertvector(v, bf16x2n_t)); }
__device__ __forceinline__ float bf_lo(unsigned w) { return __uint_as_float(w << 16); }
__device__ __forceinline__ float bf_hi(unsigned w) { return __uint_as_float(w & 0xffff0000u); }
__device__ __forceinline__ float bf1(bf16_t x) { return __uint_as_float((unsigned)x << 16); }
#define LDS_WAIT() asm volatile("s_waitcnt lgkmcnt(0)" ::: "memory")
#define VM_WAIT() asm volatile("s_waitcnt vmcnt(0)" ::: "memory")
#define CFENCE() asm volatile("" ::: "memory")
#define RAW_BAR() do { asm volatile("" ::: "memory"); __builtin_amdgcn_s_barrier(); asm volatile("" ::: "memory"); } while (0)
__device__ __forceinline__ float wave_sum(float v) {
#pragma unroll
    for (int o = 1; o < 64; o <<= 1) v += __shfl_xor(v, o);
    return v;
}
__device__ __forceinline__ float log2gamma(int h) {
    const float t[8] = {-0.04580368961312479f, -0.02272007650008353f, -0.011315313227834146f, -0.005646563141142063f,
                        -0.0028205190623786626f, -0.0014095702546713536f, -0.0007046129765893727f, -0.0003522634716290214f};
    float r = t[0];
#pragma unroll
    for (int i = 1; i < 8; ++i) r = (h == i) ? t[i] : r;
    return r;
}
__device__ __forceinline__ int opaque_tid() { int t = threadIdx.x; asm volatile("" : "+v"(t)); return t; }
__device__ __forceinline__ float sigmoidf_(float v) { return __builtin_amdgcn_rcpf(1.0f + __builtin_amdgcn_exp2f(v * -1.4426950408889634f)); }

struct Params { const float* in[19]; float* out; unsigned char* ws; int ph_lo, ph_hi; };

struct Frame {
    LAS unsigned char* lds;
    int wave, vcu, G;
    const Params* P;
    unsigned char* ws; float* out;
};
#define WSB(F, off) ((bf16_t*)((F).ws + (off)))
#define WSF(F, off) ((float*)((F).ws + (off)))
#define INP(F, k) ((F).P->in[k])
enum { I_XP = 0, I_XS, I_SRET, I_SCONV, I_SFFN, I_GPREMIX, I_WIN, I_CONVW, I_PRET, I_PCONV, I_WO, I_GPOSTMIX, I_GPREFFN, I_WUP, I_WGATE, I_FCW, I_FCB, I_WDOWN, I_GPOSTFFN };
__device__ __forceinline__ const float* xrow(const Frame& F, int m) { return m < MP ? INP(F, I_XP) + (size_t)m * DM : INP(F, I_XS) + (size_t)(m - MP) * DM; }

constexpr int BM = 256, BK = 64, HALF = 128, HTB = HALF * BK * 2, STAGE_BYTES = 8 * HTB;
__device__ __forceinline__ int lds_byte(int r, int c) { const int st = (r >> 4) * 2 + (c >> 5), rr = r & 15, cc = c & 31, ob = rr * 64 + cc * 2; return st * 1024 + (ob ^ (((ob >> 9) & 1) << 5)); }
__device__ __forceinline__ void stage_rc(int b, int& R, int& C) { const int st = b / 1024, sb = b % 1024, swz = sb ^ (((sb >> 9) & 1) << 5); R = (st >> 1) * 16 + swz / 64; C = (st & 1) * 32 + (swz % 64) / 2; }
__device__ __forceinline__ int perm32(int rho) { const int n = rho >> 4, i = rho & 15; return 8 * (i >> 2) + 4 * n + (i & 3); }

struct GUnit { const char* a; const char* b; const char* x; unsigned lda, ldb; int nt, kind, pm, pn; };

__device__ __forceinline__ void tile_of(int L, int nM, int nN, int& pm, int& pn) {
    const int nwg = nM * nN; int wgid = L;
    { const int q = nwg / 8, r = nwg % 8, xcd = wgid % 8, off = wgid / 8; wgid = (xcd < r ? xcd * (q + 1) : r * (q + 1) + (xcd - r) * q) + off; }
    const int nig = 4 * nN, gid = wgid / nig, fm = gid * 4, gsz = (nM - fm) < 4 ? (nM - fm) : 4;
    pm = fm + ((wgid % nig) % gsz); pn = (wgid % nig) / gsz;
}

constexpr int XA_OFF = STAGE_BYTES;
template <bool XR, class Sched, class Epi>
__device__ __forceinline__ void gemm_phase(LAS unsigned char* lds, const Sched& S, const Epi& E) {
    const int tid = threadIdx.x, wid = __builtin_amdgcn_readfirstlane(tid >> 6), lane = tid & 63, wr = wid >> 2, wc = wid & 3, fr = lane & 15, fq = lane >> 4;
    int R0, C0; stage_rc(tid * 16, R0, C0);
    const unsigned RA = (unsigned)R0, RB = (unsigned)((R0 & ~31) + perm32(R0 & 31)), C2 = (unsigned)C0 * 2u;
    const unsigned ldsw = (unsigned)wid * 1024u;
    const int aoff = lds_byte(wr * 64 + fr, fq * 8), boff = lds_byte(wc * 32 + fr, fq * 8);
    const int xoff = XA_OFF + fr * 128 + fq * 16;
#define G_SA(b, h) (((b) * 2 + (h)) * HTB)
#define G_SB(b, h) ((4 + (b) * 2 + (h)) * HTB)
#define G_STAGE(bufoff, gbase, voff, ld64) do { \
        __builtin_amdgcn_global_load_lds((const unsigned*)((const char*)(gbase) + (voff)), (LAS unsigned*)(lds + (bufoff) + ldsw), 16, 0, 0); \
        __builtin_amdgcn_global_load_lds((const unsigned*)((const char*)(gbase) + (ld64) + (voff)), (LAS unsigned*)(lds + (bufoff) + ldsw + 8192), 16, 0, 0); } while (0)
#define G_STAGEX(b, gbase, ld) do { if constexpr (XR) { int t_ = threadIdx.x; asm volatile("" : "+v"(t_));     \
        const unsigned vx_ = (unsigned)(((t_ >> 5) & 1) + 2 * wid) * (ld) + (unsigned)(t_ & 31) * 4u; \
        __builtin_amdgcn_global_load_lds((const unsigned*)((const char*)(gbase) + vx_), (LAS unsigned*)(lds + XA_OFF + (b) * 2048 + wid * 256), 4, 0, 0); } } while (0)
#define G_LDA(dst, b, h) do { _Pragma("unroll") for (int m = 0; m < 4; ++m) _Pragma("unroll") for (int k = 0; k < 2; ++k) dst[m][k] = *(const LAS bf16x8*)(lds + G_SA(b, h) + aoff + m * 2048 + k * 1024); } while (0)
#define G_LDB(dst, b, h) do { _Pragma("unroll") for (int n = 0; n < 2; ++n) _Pragma("unroll") for (int k = 0; k < 2; ++k) dst[n][k] = *(const LAS bf16x8*)(lds + G_SB(b, h) + boff + n * 2048 + k * 1024); } while (0)
#define G_LDX(b) do { if constexpr (XR) { Xf[0] = *(const LAS bf16x8*)(lds + xoff + (b) * 2048); Xf[1] = *(const LAS bf16x8*)(lds + xoff + (b) * 2048 + 64); } } while (0)
#define G_MMA(ai, bj, At, Bt) do { __builtin_amdgcn_s_setprio(1); _Pragma("unroll") for (int m = 0; m < 4; ++m) _Pragma("unroll") for (int n = 0; n < 2; ++n) _Pragma("unroll") for (int k = 0; k < 2; ++k) \
        acc[ai][bj][m][n] = __builtin_amdgcn_mfma_f32_16x16x32_bf16(Bt[n][k], At[m][k], acc[ai][bj][m][n], 0, 0, 0); __builtin_amdgcn_s_setprio(0); } while (0)
#define G_MMAX() do { if constexpr (XR) { if (wr == 0) { _Pragma("unroll") for (int n = 0; n < 2; ++n) _Pragma("unroll") for (int k = 0; k < 2; ++k) xacc[n] = __builtin_amdgcn_mfma_f32_16x16x32_bf16(B0[n][k], Xf[k], xacc[n], 0, 0, 0); } \
        else { _Pragma("unroll") for (int n = 0; n < 2; ++n) _Pragma("unroll") for (int k = 0; k < 2; ++k) xacc[n] = __builtin_amdgcn_mfma_f32_16x16x32_bf16(B1[n][k], Xf[k], xacc[n], 0, 0, 0); } } } while (0)
#define G_WAIT_V(n) asm volatile("s_waitcnt vmcnt(" #n ")" ::: "memory")
#define G_WAIT_VX(n, nx) do { if constexpr (XR) asm volatile("s_waitcnt vmcnt(" #nx ")" ::: "memory"); else asm volatile("s_waitcnt vmcnt(" #n ")" ::: "memory"); } while (0)
#define G_WAIT_L(n) asm volatile("s_waitcnt lgkmcnt(" #n ")" ::: "memory")
#define G_BAR __builtin_amdgcn_s_barrier()
#define G_SCHED __builtin_amdgcn_sched_barrier(0)
    GUnit cur, nxt; int ui = 0;
    if (!S.next(0, cur)) return;
    f32x4 acc[2][2][4][2]; f32x4 xacc[2];
#pragma unroll
    for (int a = 0; a < 2; ++a)
#pragma unroll
        for (int b = 0; b < 2; ++b)
#pragma unroll
            for (int m = 0; m < 4; ++m)
#pragma unroll
                for (int n = 0; n < 2; ++n) acc[a][b][m][n] = (f32x4){0.f, 0.f, 0.f, 0.f};
    xacc[0] = (f32x4){0.f, 0.f, 0.f, 0.f}; xacc[1] = (f32x4){0.f, 0.f, 0.f, 0.f};
    bf16x8 At[4][2], B0[2][2], B1[2][2], Xf[2];
    const char* cA = cur.a; const char* cB = cur.b; const char* cX = cur.x;
    unsigned vA = RA * cur.lda + C2, vB = RB * cur.ldb + C2; unsigned ldx = cur.lda;
    size_t hA = (size_t)HALF * cur.lda, hB = (size_t)HALF * cur.ldb;
    const size_t kstep = (size_t)(BK * 2);
    G_STAGE(G_SB(0, 0), cB, vB, hB / 2); G_STAGE(G_SB(0, 1), cB + hB, vB, hB / 2); G_STAGE(G_SA(0, 0), cA, vA, hA / 2); G_STAGE(G_SA(0, 1), cA + hA, vA, hA / 2); G_STAGEX(0, cX, ldx);
    if (wr == 1) G_BAR;
    G_WAIT_VX(2, 3); G_BAR;
    G_STAGE(G_SB(1, 0), cB + kstep, vB, hB / 2); G_STAGE(G_SA(1, 0), cA + kstep, vA, hA / 2); G_STAGE(G_SB(1, 1), cB + hB + kstep, vB, hB / 2);
    G_WAIT_V(6); G_BAR;
    for (;;) {
        const bool has_next = S.next(ui + 1, nxt);
        const char* nA = has_next ? nxt.a : cA; const char* nB = has_next ? nxt.b : cB; const char* nX = has_next ? nxt.x : cX;
        const unsigned nlda = has_next ? nxt.lda : cur.lda, nldb = has_next ? nxt.ldb : cur.ldb;
        const unsigned nvA = RA * nlda + C2, nvB = RB * nldb + C2;
        const size_t nhA = (size_t)HALF * nlda, nhB = (size_t)HALF * nldb;
        const int nt = cur.nt;
        for (int t = 0; t < nt; t += 2) {
            const bool last = (t == nt - 2);
            const char* a1 = cA + (size_t)(t + 1) * kstep; const char* x1 = cX + (size_t)(t + 1) * kstep;
            const char* a2 = last ? nA : cA + (size_t)(t + 2) * kstep; const char* b2 = last ? nB : cB + (size_t)(t + 2) * kstep; const char* x2 = last ? nX : cX + (size_t)(t + 2) * kstep;
            const unsigned vA2 = last ? nvA : vA, vB2 = last ? nvB : vB, ldx2 = last ? nlda : ldx;
            const size_t hA2 = last ? nhA : hA, hB2 = last ? nhB : hB;
            const char* a3 = a2 + kstep; const char* b3 = b2 + kstep;
            G_LDB(B0, 0, 0); G_LDB(B1, 0, 1); G_SCHED; G_LDA(At, 0, 0); G_STAGE(G_SA(1, 1), a1 + hA, vA, hA / 2); G_STAGEX(1, x1, ldx);
            G_WAIT_VX(8, 9); G_WAIT_L(0); G_BAR; G_MMA(0, 0, At, B0); G_MMA(0, 1, At, B1); G_BAR; G_SCHED;
            G_LDA(At, 0, 1); G_LDX(0); G_STAGE(G_SB(0, 0), b2, vB2, hB2 / 2); G_STAGE(G_SB(0, 1), b2 + hB2, vB2, hB2 / 2); G_STAGE(G_SA(0, 0), a2, vA2, hA2 / 2);
            G_WAIT_VX(8, 9); G_WAIT_L(0); G_BAR; G_MMA(1, 0, At, B0); G_MMA(1, 1, At, B1); G_MMAX(); G_BAR; G_SCHED;
            G_LDB(B0, 1, 0); G_LDB(B1, 1, 1); G_SCHED; G_LDA(At, 1, 0); G_STAGE(G_SA(0, 1), a2 + hA2, vA2, hA2 / 2); G_STAGEX(0, x2, ldx2);
            G_WAIT_VX(8, 9); G_WAIT_L(0); G_BAR; G_MMA(0, 0, At, B0); G_MMA(0, 1, At, B1); G_BAR; G_SCHED;
            G_LDA(At, 1, 1); G_LDX(1); G_STAGE(G_SB(1, 0), b3, vB2, hB2 / 2); G_STAGE(G_SB(1, 1), b3 + hB2, vB2, hB2 / 2); G_STAGE(G_SA(1, 0), a3, vA2, hA2 / 2);
            G_WAIT_VX(8, 9); G_WAIT_L(0); G_BAR; G_MMA(1, 0, At, B0); G_MMA(1, 1, At, B1); G_MMAX(); G_BAR; G_SCHED;
        }
        if (wr == 0) G_BAR;
        { int fre = fr, fqe = fq; asm volatile("" : "+v"(fre), "+v"(fqe));
          bool tiled = false;
          if constexpr (Epi::HAS_TILE) { if (E.is_tile(cur)) { tiled = true; E.tile(cur, acc, xacc, lds, wr, wc, fre, fqe); } }
          if (!tiled) {
              constexpr int NBJ = Epi::NBJ;
#pragma unroll
              for (int ai = 0; ai < 2; ++ai)
#pragma unroll
                  for (int b0 = 0; b0 < 2; b0 += NBJ) {
                      typename Epi::Pre pre[4][NBJ];
#pragma unroll
                      for (int m = 0; m < 4; ++m)
#pragma unroll
                          for (int bb = 0; bb < NBJ; ++bb) pre[m][bb] = E.pre(cur, cur.pm * BM + ai * HALF + wr * 64 + m * 16 + fre, (b0 + bb) * HALF + wc * 32 + 8 * fqe);
#pragma unroll
                      for (int m = 0; m < 4; ++m)
#pragma unroll
                          for (int bb = 0; bb < NBJ; ++bb) E.row(cur, cur.pm * BM + ai * HALF + wr * 64 + m * 16 + fre, (b0 + bb) * HALF + wc * 32 + 8 * fqe, acc[ai][b0 + bb][m][0], acc[ai][b0 + bb][m][1], pre[m][bb]);
                      CFENCE();
                  }
              if constexpr (XR) { const typename Epi::Pre px = E.pre(cur, MP + 16 * cur.pm + fre, wr * HALF + wc * 32 + 8 * fqe); E.row(cur, MP + 16 * cur.pm + fre, wr * HALF + wc * 32 + 8 * fqe, xacc[0], xacc[1], px); }
          } }
        if constexpr (Epi::HAS_DONE) { if (E.publishes(ui)) {
            asm volatile("s_waitcnt vmcnt(0)" ::: "memory"); RAW_BAR();
            if (threadIdx.x == 0) { __builtin_amdgcn_fence(__ATOMIC_RELEASE, "agent"); asm volatile("s_waitcnt vmcnt(0)" ::: "memory"); __hip_atomic_fetch_add(E.done_counter(), 1u, __ATOMIC_RELAXED, __HIP_MEMORY_SCOPE_AGENT); } } }
        if (!has_next) break;
#pragma unroll
        for (int a = 0; a < 2; ++a)
#pragma unroll
            for (int b = 0; b < 2; ++b)
#pragma unroll
                for (int m = 0; m < 4; ++m)
#pragma unroll
                    for (int n = 0; n < 2; ++n) acc[a][b][m][n] = (f32x4){0.f, 0.f, 0.f, 0.f};
        xacc[0] = (f32x4){0.f, 0.f, 0.f, 0.f}; xacc[1] = (f32x4){0.f, 0.f, 0.f, 0.f};
        cur = nxt; cA = nA; cB = nB; cX = nX; vA = nvA; vB = nvB; ldx = nlda; hA = nhA; hB = nhB; ++ui;
        if (wr == 1) G_BAR;
    }
    G_WAIT_V(0);
    G_BAR;
    CFENCE();
#undef G_SA
#undef G_SB
#undef G_STAGE
#undef G_STAGEX
#undef G_LDA
#undef G_LDB
#undef G_LDX
#undef G_MMA
#undef G_MMAX
#undef G_WAIT_V
#undef G_WAIT_VX
#undef G_WAIT_L
#undef G_BAR
#undef G_SCHED
}

enum { K_ROTQ = 0, K_ROTK, K_SILU, K_PLAIN, K_PROD, K_SIGA, K_SIGB, K_VT, K_YA, K_YB, K_RETP, K_MIX, K_UP, K_GATE, K_DOWN, K_STATE };

__device__ __forceinline__ u32x4 pack8(f32x4 a, f32x4 b) { u32x4 w; w.x = cvt_pk_bf16(a[0], a[1]); w.y = cvt_pk_bf16(a[2], a[3]); w.z = cvt_pk_bf16(b[0], b[1]); w.w = cvt_pk_bf16(b[2], b[3]); return w; }
__device__ __forceinline__ void unpack8(u32x4 w, f32x4& a, f32x4& b) { a = (f32x4){bf_lo(w.x), bf_hi(w.x), bf_lo(w.y), bf_hi(w.y)}; b = (f32x4){bf_lo(w.z), bf_hi(w.z), bf_lo(w.w), bf_hi(w.w)}; }
#define GP(T, base, byteoff) ((T*)((char*)(base) + (unsigned)(byteoff)))
#define GPC(T, base, byteoff) ((const T*)((const char*)(base) + (unsigned)(byteoff)))

struct Epi1 {
    static constexpr bool HAS_TILE = false; static constexpr int NBJ = 2; static constexpr bool HAS_DONE = true;
    bf16_t *Q, *K, *GR, *GB, *CPR, *GA, *GBT, *VT; const float* rope; float* out; unsigned* cnt; int ulast;
    __device__ __forceinline__ bool publishes(int ui) const { return ui == ulast; }
    __device__ __forceinline__ unsigned* done_counter() const { return cnt; }
    struct Pre {};
    __device__ __forceinline__ Pre pre(const GUnit& u, int row, int lc) const { return Pre{}; }
    __device__ __forceinline__ void row(const GUnit& u, int row, int lc, const f32x4 v0, const f32x4 v1, const Pre& pr_) const {
        const int kind = u.kind;
        if (kind == K_ROTQ || kind == K_ROTK) {
            bf16_t* dst = ((kind == K_ROTQ) ? Q : K) + (u.pn & 7) * 256; const float sc = (kind == K_ROTQ) ? 1.0f : 0.0625f;
            const int pidx = row < MP ? (row & (SEQ - 1)) : SEQ + ((row - MP) & 3);
            const f32x4 c01 = *GPC(f32x4, rope, (pidx * 128 + (lc >> 1)) * 8), c23 = *GPC(f32x4, rope, (pidx * 128 + (lc >> 1)) * 8 + 16);
            f32x4 o0, o1;
            o0[0] = (v0[0] * c01[0] - v0[1] * c01[1]) * sc; o0[1] = (v0[1] * c01[0] + v0[0] * c01[1]) * sc;
            o0[2] = (v0[2] * c01[2] - v0[3] * c01[3]) * sc; o0[3] = (v0[3] * c01[2] + v0[2] * c01[3]) * sc;
            o1[0] = (v1[0] * c23[0] - v1[1] * c23[1]) * sc; o1[1] = (v1[1] * c23[0] + v1[0] * c23[1]) * sc;
            o1[2] = (v1[2] * c23[2] - v1[3] * c23[3]) * sc; o1[3] = (v1[3] * c23[2] + v1[2] * c23[3]) * sc;
            *GP(u32x4, dst, (row * DM + lc) * 2) = pack8(o0, o1);
            CFENCE();
        } else if (kind == K_SILU) {
            f32x4 o0, o1;
#pragma unroll
            for (int j = 0; j < 4; ++j) { o0[j] = v0[j] * sigmoidf_(v0[j]); o1[j] = v1[j] * sigmoidf_(v1[j]); }
            *GP(u32x4, GR + (u.pn - 32) * 256, (row * DVT + lc) * 2) = pack8(o0, o1);
        } else if (kind == K_PLAIN) {
            *GP(u32x4, GB + (u.pn - 48) * 256, (row * DM + lc) * 2) = pack8(v0, v1);
        } else if (kind == K_SIGA || kind == K_SIGB) {
            bf16_t* dst = (kind == K_SIGA) ? GA + (u.pn - 72) * 256 : GBT + (u.pn - 80) * 256;
            f32x4 o0, o1;
#pragma unroll
            for (int j = 0; j < 4; ++j) { o0[j] = sigmoidf_(v0[j]); o1[j] = sigmoidf_(v1[j]); }
            __builtin_nontemporal_store(pack8(o0, o1), GP(u32x4, dst, (row * DM + lc) * 2));
        } else if (kind == K_PROD) {
            const int col = (u.pn - 56) * 128 + (lc >> 1);
            const f32x4 pr = (f32x4){v0[0] * v0[1], v0[2] * v0[3], v1[0] * v1[1], v1[2] * v1[3]};
            u32x2 w; w.x = cvt_pk_bf16(pr[0], pr[1]); w.y = cvt_pk_bf16(pr[2], pr[3]);
            *GP(u32x2, CPR, (row * DM + col) * 2) = w;
            if (row < MP) { const int t = row & (SEQ - 1); if (t >= SEQ - 2) *GP(f32x4, out + OFF_CP, (((row >> 11) * 2 + (t - (SEQ - 2))) * DM + col) * 4) = pr; }
            else { const int ms = row - MP, t = ms & 3; if (t >= 2) *GP(f32x4, out + OFF_CS, (((ms >> 2) * 2 + (t - 2)) * DM + col) * 4) = pr; }
        } else {
            *GP(u32x4, VT, (row * LDV + u.pn * BM + lc) * 2) = pack8(v0, v1);
        }
    }
};

struct Epi3 {
    static constexpr bool HAS_DONE = false;
    static constexpr bool HAS_TILE = false; static constexpr int NBJ = 1;
    const bf16_t *GA, *GBT; float* MTMP; bf16_t* MBUF;
    struct Pre { u32x4 g; f32x4 t0, t1; };
    __device__ __forceinline__ Pre pre(const GUnit& u, int row, int lc) const {
        const unsigned off = (unsigned)(row * DM + u.pn * BM + lc);
        Pre p; p.t0 = (f32x4){0.f, 0.f, 0.f, 0.f}; p.t1 = p.t0;
        if (u.kind == K_YA) p.g = __builtin_nontemporal_load(GPC(u32x4, GA, off * 2));
        else { p.g = __builtin_nontemporal_load(GPC(u32x4, GBT, off * 2)); p.t0 = *GPC(f32x4, MTMP, off * 4); p.t1 = *GPC(f32x4, MTMP, off * 4 + 16); }
        return p;
    }
    __device__ __forceinline__ void row(const GUnit& u, int row, int lc, const f32x4 v0, const f32x4 v1, const Pre& p) const {
        const unsigned off = (unsigned)(row * DM + u.pn * BM + lc);
        f32x4 g0, g1; unpack8(p.g, g0, g1);
        if (u.kind == K_YA) { *GP(f32x4, MTMP, off * 4) = v0 * g0; *GP(f32x4, MTMP, off * 4 + 16) = v1 * g1; }
        else *GP(u32x4, MBUF, off * 2) = pack8(p.t0 + v0 * g0, p.t1 + v1 * g1);
    }
};

struct EpiB16 {
    static constexpr bool HAS_DONE = false;
    static constexpr bool HAS_TILE = false; static constexpr int NBJ = 2;
    bf16_t* C;
    struct Pre {};
    __device__ __forceinline__ Pre pre(const GUnit& u, int row, int lc) const { return Pre{}; }
    __device__ __forceinline__ void row(const GUnit& u, int row, int lc, const f32x4 v0, const f32x4 v1, const Pre&) const {
        *GP(u32x4, C, (unsigned)(row * DM + u.pn * BM + lc) * 2u) = pack8(v0, v1);
    }
};

constexpr int LDS_RED = 139264;
template <class ACC, class XACC>
__device__ __forceinline__ void panel_rstd(LAS unsigned char* lds, unsigned long long* part, int pm, int pn, ACC& acc, XACC& xacc, int wr, int wc, int fr, int fq) {
    LAS float* red = (LAS float*)(lds + LDS_RED);
#pragma unroll
    for (int ai = 0; ai < 2; ++ai)
#pragma unroll
        for (int m = 0; m < 4; ++m) { float sq = 0.f;
#pragma unroll
            for (int bj = 0; bj < 2; ++bj)
#pragma unroll
                for (int n = 0; n < 2; ++n) { const f32x4 v = acc[ai][bj][m][n]; sq += (v[0] * v[0] + v[1] * v[1]) + (v[2] * v[2] + v[3] * v[3]); }
            sq += __shfl_xor(sq, 16); sq += __shfl_xor(sq, 32);
            if (fq == 0) red[wc * 256 + ai * HALF + wr * 64 + m * 16 + fr] = sq; }
    { float sq = 0.f;
#pragma unroll
      for (int n = 0; n < 2; ++n) { const f32x4 v = xacc[n]; sq += (v[0] * v[0] + v[1] * v[1]) + (v[2] * v[2] + v[3] * v[3]); }
      sq += __shfl_xor(sq, 16); sq += __shfl_xor(sq, 32);
      if (fq == 0) red[1024 + (wr * 4 + wc) * 16 + fr] = sq; }
    LDS_WAIT(); RAW_BAR();
    { const int t = opaque_tid();
      if (t < 272) {
          float tot;
          if (t < 256) tot = (red[t] + red[256 + t]) + (red[512 + t] + red[768 + t]);
          else { tot = 0.f;
#pragma unroll
              for (int w = 0; w < 8; ++w) tot += red[1024 + w * 16 + (t - 256)]; }
          unsigned long long* pw = part + ((size_t)(pm * 272 + t)) * 8;
          __hip_atomic_store(pw + pn, ((unsigned long long)1u << 32) | (unsigned long long)__float_as_uint(tot), __ATOMIC_RELAXED, __HIP_MEMORY_SCOPE_AGENT);
          unsigned long long w[8]; unsigned sp = 0;
          for (;;) {
              bool ok = true;
#pragma unroll
              for (int k = 0; k < 8; ++k) w[k] = __hip_atomic_load(pw + k, __ATOMIC_RELAXED, __HIP_MEMORY_SCOPE_AGENT);
#pragma unroll
              for (int k = 0; k < 8; ++k) ok = ok && ((unsigned)(w[k] >> 32) == 1u);
              if (ok || ++sp > (1u << 22)) break;
              __builtin_amdgcn_s_sleep(1); }
          float sum = 0.f;
#pragma unroll
          for (int k = 0; k < 8; ++k) sum += __uint_as_float((unsigned)w[k]);
          red[1280 + t] = rsqrtf(sum * (1.0f / DM) + EPS);
      } }
    LDS_WAIT(); RAW_BAR();
}

struct Epi8 {
    static constexpr bool HAS_DONE = false;
    static constexpr bool HAS_TILE = true;
    const float* X1; float* Y; const float* g; unsigned long long* part;
    static constexpr int NBJ = 2;
    struct Pre {};
    __device__ __forceinline__ Pre pre(const GUnit& u, int row, int lc) const { return Pre{}; }
    __device__ __forceinline__ bool is_tile(const GUnit& u) const { return true; }
    __device__ __forceinline__ void row(const GUnit& u, int row, int lc, const f32x4 v0, const f32x4 v1, const Pre&) const {}
    template <class ACC, class XACC>
    __device__ __forceinline__ void tile(const GUnit& u, ACC& acc, XACC& xacc, LAS unsigned char* lds, int wr, int wc, int fr, int fq) const {
        f32x4 xa[2][4], xb[2][4];
#define E8_LOAD(buf, bj_, ai_) do { _Pragma("unroll") for (int m = 0; m < 4; ++m) { const unsigned o_ = (unsigned)(((u.pm * BM + (ai_) * HALF + wr * 64 + fr + 16 * m) * DM + u.pn * BM + (bj_) * HALF + wc * 32 + 8 * fq) * 4); \
            xa[buf][m] = __builtin_nontemporal_load(GPC(f32x4, X1, o_)); xb[buf][m] = __builtin_nontemporal_load(GPC(f32x4, X1, o_ + 16)); } } while (0)
        E8_LOAD(0, 0, 0);
        panel_rstd(lds, part, u.pm, u.pn, acc, xacc, wr, wc, fr, fq);
        const LAS float* rs = (const LAS float*)(lds + LDS_RED) + 1280;
#pragma unroll
        for (int bt = 0; bt < 4; ++bt) { const int bj = bt >> 1, ai = bt & 1, buf = bt & 1;
            if (bt < 3) { if (buf == 0) E8_LOAD(1, (bt + 1) >> 1, (bt + 1) & 1); else E8_LOAD(0, (bt + 1) >> 1, (bt + 1) & 1); }
            const int col = u.pn * BM + bj * HALF + wc * 32 + 8 * fq;
            const f32x4 g0 = *(const f32x4*)(g + col), g1 = *(const f32x4*)(g + col + 4);
            const int rl0 = ai * HALF + wr * 64 + fr;
#pragma unroll
            for (int m = 0; m < 4; ++m) { const unsigned o = (unsigned)(((u.pm * BM + rl0 + 16 * m) * DM + col) * 4); const float r = rs[rl0 + 16 * m];
                __builtin_nontemporal_store(xa[buf][m] + acc[ai][bj][m][0] * r * g0, GP(f32x4, Y, o)); __builtin_nontemporal_store(xb[buf][m] + acc[ai][bj][m][1] * r * g1, GP(f32x4, Y, o + 16)); }
        }
#undef E8_LOAD
        {
            const int col = u.pn * BM + wr * HALF + wc * 32 + 8 * fq; const unsigned o = (unsigned)(((MP + 16 * u.pm + fr) * DM + col) * 4);
            const f32x4 g0 = *(const f32x4*)(g + col), g1 = *(const f32x4*)(g + col + 4); const float r = rs[256 + fr];
            const f32x4 xa = __builtin_nontemporal_load(GPC(f32x4, X1, o)), xb = __builtin_nontemporal_load(GPC(f32x4, X1, o + 16));
            __builtin_nontemporal_store(xa + xacc[0] * r * g0, GP(f32x4, Y, o)); __builtin_nontemporal_store(xb + xacc[1] * r * g1, GP(f32x4, Y, o + 16));
        }
    }
};

struct EpiState {
    static constexpr bool HAS_DONE = false;
    static constexpr bool HAS_TILE = false; static constexpr int NBJ = 2;
    bf16_t* ST;
    struct Pre {};
    __device__ __forceinline__ Pre pre(const GUnit& u, int row, int lc) const { return Pre{}; }
    __device__ __forceinline__ void row(const GUnit& u, int row, int lc, const f32x4 v0, const f32x4 v1, const Pre&) const {
        const int bh = u.pm, pe = u.pn & 1, sg = u.pn >> 4, rl = row - bh * BM;
        const float sc = __builtin_amdgcn_exp2f(-log2gamma(bh & 7) * (float)(SEQ - 512 * sg));
        *GP(u32x4, ST, ((((bh * 3 + (sg - 1)) * DVH + pe * BM + rl) * DK) + lc) * 2) = pack8(v0 * sc, v1 * sc);
    }
};

__device__ __forceinline__ unsigned dpp_ror1(unsigned v) { return (unsigned)__builtin_amdgcn_update_dpp(0, (int)v, 0x121, 0xf, 0xf, false); }
__device__ __forceinline__ unsigned dpp_ror2(unsigned v) { return (unsigned)__builtin_amdgcn_update_dpp(0, (int)v, 0x122, 0xf, 0xf, false); }
struct Epi6 {
    static constexpr bool HAS_DONE = false;
    static constexpr bool HAS_TILE = true;
    bf16_t *U, *GG; float* out; const bf16_t* ST; bf16_t* AFF; const float *fcw, *fcb;
    __device__ __forceinline__ bool is_tile(const GUnit& u) const { return u.kind == K_GATE; }
    template <class ACC, class XACC>
    __device__ __forceinline__ void tile(const GUnit& u, ACC& acc, XACC& xacc, LAS unsigned char* lds, int wr, int wc, int fr, int fq) const {
        const bool f15 = fr == 15, f14 = fr >= 14;
#pragma unroll
        for (int bj = 0; bj < 2; ++bj) {
            const int col = (u.pn - 22) * BM + bj * HALF + wc * 32 + 8 * fq;
            f32x2 w0[4], w1[4], w2[4], bb[4];
            { const float* cw = fcw + col; const float* cb = fcb + col;
#pragma unroll
              for (int j = 0; j < 4; ++j) { w0[j] = *(const f32x2*)(cw + 2 * j); w1[j] = *(const f32x2*)(cw + DFF + 2 * j); w2[j] = *(const f32x2*)(cw + 2 * DFF + 2 * j); bb[j] = *(const f32x2*)(cb + 2 * j); } }
#pragma unroll
            for (int ai = 0; ai < 2; ++ai) {
                const int rb = u.pm * BM + ai * HALF + wr * 64 + fr;
                u32x4 blk[5];
#pragma unroll
                for (int mm = 0; mm < 5; ++mm) { int r = rb + 16 * (mm - 1); r = r < 0 ? 0 : r; blk[mm] = *GPC(u32x4, U, (r * DFF + col) * 2); }
#pragma unroll
                for (int m = 0; m < 4; ++m) {
                    const int row = rb + 16 * m;
                    const u32x4 c0 = blk[m + 1], pv = blk[m];
                    const f32x4 g0 = acc[ai][bj][m][0], g1 = acc[ai][bj][m][1];
                    f32x4 o0, o1;
#pragma unroll
                    for (int j = 0; j < 4; ++j) {
                        const unsigned q1 = dpp_ror1(f15 ? pv[j] : c0[j]), q2 = dpp_ror2(f14 ? pv[j] : c0[j]);
                        const f32x2 x0 = (f32x2){bf_lo(c0[j]), bf_hi(c0[j])}, x1 = (f32x2){bf_lo(q1), bf_hi(q1)}, x2 = (f32x2){bf_lo(q2), bf_hi(q2)};
                        const f32x2 v = w0[j] * x2 + (w1[j] * x1 + (w2[j] * x0 + bb[j]));
                        const f32x2 z = v * (v * v * (-2.3022082f * 0.044715f) + (-2.3022082f));
                        f32x2 e; e[0] = __builtin_amdgcn_exp2f(z[0]); e[1] = __builtin_amdgcn_exp2f(z[1]);
                        const f32x2 d = e + 1.0f; f32x2 r; r[0] = __builtin_amdgcn_rcpf(d[0]); r[1] = __builtin_amdgcn_rcpf(d[1]);
                        const f32x2 gg = j < 2 ? (f32x2){g0[2 * (j & 1)], g0[2 * (j & 1) + 1]} : (f32x2){g1[2 * (j & 1)], g1[2 * (j & 1) + 1]};
                        const f32x2 o = v * r * gg;
                        if (j < 2) { o0[2 * (j & 1)] = o[0]; o0[2 * (j & 1) + 1] = o[1]; } else { o1[2 * (j & 1)] = o[0]; o1[2 * (j & 1) + 1] = o[1]; }
                    }
                    *GP(u32x4, AFF, (row * DFF + col) * 2) = pack8(o0, o1);
                    const bool fix = row < MP ? (row & 255) < 2 : ((row - MP) & 3) < 2;
                    if (fix) *GP(u32x4, GG, (row * DFF + col) * 2) = pack8(g0, g1);
                }
            }
        }
    }
    static constexpr int NBJ = 2;
    struct Pre { u32x4 st; };
    __device__ __forceinline__ Pre pre(const GUnit& u, int row, int lc) const {
        Pre p; p.st = (u32x4){0u, 0u, 0u, 0u};
        if (u.kind == K_RETP) p.st = *GPC(u32x4, ST, ((((u.pm * 3 + 2) * DVH + u.pn * BM + (row - u.pm * BM)) * DK) + lc) * 2);
        return p;
    }
    __device__ __forceinline__ void row(const GUnit& u, int row, int lc, const f32x4 v0, const f32x4 v1, const Pre& p) const {
        if (u.kind == K_UP) {
            const int col = u.pn * BM + lc;
            *GP(u32x4, U, (row * DFF + col) * 2) = pack8(v0, v1);
            if (row < MP) { const int t = row & (SEQ - 1); if (t >= SEQ - 2) { const unsigned o = (unsigned)((((row >> 11) * 2 + (t - (SEQ - 2))) * DFF + col) * 4); *GP(f32x4, out + OFF_FP, o) = v0; *GP(f32x4, out + OFF_FP, o + 16) = v1; } }
            else { const int ms = row - MP, t = ms & 3; if (t >= 2) { const unsigned o = (unsigned)((((ms >> 2) * 2 + (t - 2)) * DFF + col) * 4); *GP(f32x4, out + OFF_FS, o) = v0; *GP(f32x4, out + OFF_FS, o + 16) = v1; } }
        } else {
            const int e = u.pn * BM + (row - u.pm * BM);
            const float g512 = __builtin_amdgcn_exp2f(log2gamma(u.pm & 7) * 512.0f);
            f32x4 s0, s1; unpack8(p.st, s0, s1);
            const f32x4 a = v0 + s0 * g512, b = v1 + s1 * g512;
            float* ob = out + OFF_RP + (size_t)u.pm * DK * DVH;
#pragma unroll
            for (int j = 0; j < 4; ++j) { const int d0 = lc + j, d1 = lc + 4 + j;
                __builtin_nontemporal_store(a[j], GP(float, ob, (((d0 >> 1) + 128 * (d0 & 1)) * DVH + e) * 4)); __builtin_nontemporal_store(b[j], GP(float, ob, (((d1 >> 1) + 128 * (d1 & 1)) * DVH + e) * 4)); }
        }
    }
};

struct Sched1 {
    const char *HN, *WINT; int G, c;
    __device__ __forceinline__ bool next(int i, GUnit& u) const {
        const int L = i * G + c; if (L >= 2992) return false;
        const bool mainp = L < 2448;
        int pm, pn; tile_of(mainp ? L : L - 2448, mainp ? 34 : 16, mainp ? 72 : 34, pm, pn);
        const int t = pn < 16 ? pn : pn + 16;
        const char* am = HN + (size_t)pm * (256 * 4096); const char* bm = WINT + (size_t)t * (256 * 4096);
        const char* av = WINT + (size_t)(16 + pm) * (256 * 4096); const char* bv = HN + (size_t)pn * (256 * 4096);
        const int km = t < 8 ? K_ROTQ : t < 16 ? K_ROTK : t < 48 ? K_SILU : t < 56 ? K_PLAIN : t < 72 ? K_PROD : t < 80 ? K_SIGA : K_SIGB;
        GUnit r; r.a = mainp ? am : av; r.b = mainp ? bm : bv; r.x = r.a; r.lda = 4096; r.ldb = 4096; r.nt = 32; r.kind = mainp ? km : K_VT; r.pm = pm; r.pn = mainp ? t : pn;
        u = r; return true;
    }
};
struct Sched3 {
    const char *ARET, *PRETT, *ACONV, *PCONVT; int G, c;
    __device__ __forceinline__ bool next(int i, GUnit& u) const {
        const int L = (i >> 1) * G + c, sub = i & 1; if (L >= 256) return false;
        int pm, pn; tile_of(L, 32, 8, pm, pn);
        GUnit r;
        r.a = sub ? ACONV + (size_t)pm * (256 * 4096) : ARET + (size_t)pm * (256 * 8192);
        r.x = sub ? ACONV + (size_t)(MP + 16 * pm) * 4096 : ARET + (size_t)(MP + 16 * pm) * 8192;
        r.b = sub ? PCONVT + (size_t)pn * (256 * 4096) : PRETT + (size_t)pn * (256 * 8192);
        r.lda = sub ? 4096u : 8192u; r.ldb = r.lda; r.nt = sub ? 32 : 64; r.kind = sub ? K_YB : K_YA; r.pm = pm; r.pn = pn;
        u = r; return true;
    }
};
struct SchedX {
    const char *A, *B; int nt, G, c, kind;
    __device__ __forceinline__ bool next(int i, GUnit& u) const {
        const int L = i * G + c; if (L >= 256) return false;
        int pm, pn; tile_of(L, 32, 8, pm, pn);
        const unsigned ld = (unsigned)nt * 128u;
        GUnit r; r.a = A + (size_t)pm * 256 * ld; r.x = A + (size_t)(MP + 16 * pm) * ld; r.b = B + (size_t)pn * 256 * ld; r.lda = ld; r.ldb = ld; r.nt = nt; r.pm = pm; r.pn = pn; r.kind = kind;
        u = r; return true;
    }
};
struct SchedSimple {
    const char *A, *B; int nN, nt, G, c, kind_split, kind_lo, kind_hi;
    __device__ __forceinline__ bool next(int i, GUnit& u) const {
        const int L = i * G + c; if (L >= 34 * nN) return false;
        int pm, pn; tile_of(L, 34, nN, pm, pn);
        const unsigned ld = (unsigned)nt * 128u;
        GUnit r; r.a = A + (size_t)pm * 256 * ld; r.x = r.a; r.b = B + (size_t)pn * 256 * ld; r.lda = ld; r.ldb = ld; r.nt = nt; r.pm = pm; r.pn = pn; r.kind = pn < kind_split ? kind_lo : kind_hi;
        u = r; return true;
    }
};
struct Sched6 {
    const char *A, *B, *KHT, *VT; int G, c;
    __device__ __forceinline__ bool next(int i, GUnit& u) const {
        const int q = (i >> 1) * G + c, sub = i & 1; const bool tile = q < 748;
        const int je = (G == 256) ? ((c >= 236 && i >= 4) ? (i - 4) * 20 + (c - 236) : 64) : (q - 748) * 2 + sub;
        const int j = tile ? 0 : je;
        if (j >= 64) return false;
        int pm, pn; tile_of(tile ? q : 0, 34, 22, pm, pn);
        pn += 22 * sub;
        const int bh = j >> 1, pe = j & 1, b = bh >> 3, h = bh & 7;
        GUnit r;
        r.a = tile ? A + (size_t)pm * (256 * 4096) : VT + ((size_t)(h * DVH + pe * 256) * LDV + (size_t)b * SEQ + (SEQ - 512)) * 2; r.x = r.a;
        r.b = tile ? B + (size_t)pn * (256 * 4096) : KHT + (size_t)bh * (DK * SEQ * 2) + (SEQ - 512) * 2;
        r.lda = tile ? 4096u : (unsigned)(LDV * 2); r.ldb = 4096u; r.nt = tile ? 32 : 8; r.kind = tile ? (sub ? K_GATE : K_UP) : K_RETP; r.pm = tile ? pm : bh; r.pn = tile ? pn : pe;
        u = r; return true;
    }
};
struct SchedState {
    const char *KHT, *VT; int c;
    __device__ __forceinline__ bool next(int i, GUnit& u) const {
        if (i != 0 || c >= 192) return false;
        const int sg = 3 - (c >> 6), k = c & 63, bh = k >> 1, pe = k & 1, b = bh >> 3, h = bh & 7;
        GUnit r; r.a = VT + ((size_t)(h * DVH + pe * 256) * LDV + (size_t)b * SEQ) * 2; r.x = r.a; r.b = KHT + (size_t)bh * (DK * SEQ * 2);
        r.lda = (unsigned)(LDV * 2); r.ldb = (unsigned)(SEQ * 2); r.nt = 8 * sg; r.kind = K_STATE; r.pm = bh; r.pn = pe | (sg << 4);
        u = r; return true;
    }
};
#define XB_TMO      128
#define XB_XCNT(j)  (256  + 64 * (j))
#define XB_XSUB(j)  (1280 + 64 * (j))
#define XB_XGEN(j)  (2304 + 64 * (j))
#define XB_TOP      3328
#define XB_TOPGEN   3392
#define XCD_BAR_WORDS 3456
#define XB_SPIN_CAP (1u << 18)
__device__ __forceinline__ unsigned xb_ld(unsigned* p)              { return __hip_atomic_load(p, __ATOMIC_RELAXED, __HIP_MEMORY_SCOPE_AGENT); }
__device__ __forceinline__ unsigned xb_add(unsigned* p, unsigned v) { return __hip_atomic_fetch_add(p, v, __ATOMIC_RELAXED, __HIP_MEMORY_SCOPE_AGENT); }
__device__ __forceinline__ unsigned xb_xcc_id() { return (unsigned)__builtin_amdgcn_s_getreg((3 << 11) | 20) & 0xFu; }
#define XB_SPIN(cond, bar) do { unsigned _sp = 0; while (cond) { __builtin_amdgcn_s_sleep(1); \
    if ((++_sp & 255u) == 0u) { if (xb_ld(&(bar)[XB_TMO])) break; if (_sp > XB_SPIN_CAP) { atomicAdd(&(bar)[XB_TMO], 1u); break; } } } } while (0)
struct XcdBarrier { unsigned* bar; unsigned x; volatile LAS unsigned* st; };
__device__ __forceinline__ XcdBarrier xcd_barrier_post(unsigned* bar, volatile LAS unsigned* st) {
    XcdBarrier b; b.bar = bar; b.x = xb_xcc_id(); b.st = st;
    if (threadIdx.x == 0) (void)xb_add(&bar[XB_XCNT(b.x)], 1u);
    return b;
}
__device__ __forceinline__ void xcd_barrier_complete(unsigned* bar, unsigned x, unsigned& nloc, unsigned& nx) {
    const unsigned G = gridDim.x * gridDim.y * gridDim.z;
    unsigned sum, cnt, mine, sp = 0u;
    for (;;) {
        sum = 0u; cnt = 0u; mine = 0u;
#pragma unroll
        for (unsigned j = 0; j < 16; ++j) { const unsigned c = xb_ld(&bar[XB_XCNT(j)]); sum += c; cnt += (c > 0u) ? 1u : 0u; mine = (j == x) ? c : mine; }
        if (sum == G) break;
        __builtin_amdgcn_s_sleep(1);
        if ((++sp & 255u) == 0u) { if (xb_ld(&bar[XB_TMO])) break; if (sp > XB_SPIN_CAP) { atomicAdd(&bar[XB_TMO], 1u); break; } }
    }
    nloc = mine > 0u ? mine : 1u; nx = cnt > 0u ? cnt : 1u;
}
__device__ __forceinline__ void xcd_barrier(const XcdBarrier& b) {
    asm volatile("s_waitcnt vmcnt(0)" ::: "memory");
    __syncthreads();
    if (threadIdx.x == 0) {
        unsigned* bar = b.bar;
        __builtin_amdgcn_s_waitcnt(0);
        unsigned nloc = b.st[0], nx = b.st[1];
        if (nloc == 0u) { xcd_barrier_complete(bar, b.x, nloc, nx); b.st[0] = nloc; b.st[1] = nx; }
        const unsigned old = xb_add(&bar[XB_XSUB(b.x)], 1u);
        const unsigned gen = old / nloc;
        if (old + 1u == (gen + 1u) * nloc) {
            __builtin_amdgcn_fence(__ATOMIC_RELEASE, "agent");
            asm volatile("s_waitcnt vmcnt(0)" ::: "memory");
            const unsigned og = xb_add(&bar[XB_TOP], 1u);
            const unsigned tg = og / nx;
            if (og + 1u == (tg + 1u) * nx) xb_add(&bar[XB_TOPGEN], 1u);
            else XB_SPIN(xb_ld(&bar[XB_TOPGEN]) == tg, bar);
            __builtin_amdgcn_fence(__ATOMIC_ACQUIRE, "agent");
            xb_add(&bar[XB_XGEN(b.x)], 1u);
            asm volatile("s_waitcnt vmcnt(0)" ::: "memory");
        } else {
            XB_SPIN(xb_ld(&bar[XB_XGEN(b.x)]) == gen, bar);
            __builtin_amdgcn_fence(__ATOMIC_ACQUIRE, "agent");
            asm volatile("s_waitcnt vmcnt(0)" ::: "memory");
        }
    }
    __syncthreads();
}

template <bool NTS, class ColMap>
__device__ __forceinline__ void transpose_item(const float* W, int N, int K, bf16_t* WT, LAS float* scr, int item, int lane, ColMap cm) {
    const int nblk = N / 64, kb = item / nblk, nb = item % nblk, k0 = 64 * kb, n0 = 64 * nb;
    const int sc = cm(n0 + lane);
    float wv[64];
#pragma unroll
    for (int kk = 0; kk < 64; ++kk) wv[kk] = __builtin_nontemporal_load(W + (size_t)(k0 + kk) * N + sc);
#pragma unroll
    for (int kk = 0; kk < 64; ++kk) scr[kk * 65 + lane] = wv[kk];
    LDS_WAIT(); CFENCE();
    const int c = lane & 7;
#pragma unroll
    for (int j = 0; j < 8; ++j) { const int n = (lane >> 3) + 8 * j; const LAS float* s = scr + (8 * c) * 65 + n;
        u32x4 o; o.x = cvt_pk_bf16(s[0 * 65], s[1 * 65]); o.y = cvt_pk_bf16(s[2 * 65], s[3 * 65]); o.z = cvt_pk_bf16(s[4 * 65], s[5 * 65]); o.w = cvt_pk_bf16(s[6 * 65], s[7 * 65]);
        if (NTS) __builtin_nontemporal_store(o, (u32x4*)(WT + (size_t)(n0 + n) * K + k0 + 8 * c)); else *(u32x4*)(WT + (size_t)(n0 + n) * K + k0 + 8 * c) = o; }
    LDS_WAIT(); CFENCE();
}
struct ColId { __device__ __forceinline__ int operator()(int n) const { return n; } };
struct ColWin {
    __device__ __forceinline__ int operator()(int np) const {
        if (np < 4096) { const int seg = np >> 11, w = np & 2047, h = w >> 8, r = w & 255; return seg * 2048 + h * 256 + (r >> 1) + 128 * (r & 1); }
        if (np < 14336 || np >= 18432) return np;
        const int w = np - 14336; return 14336 + (w >> 1) + 2048 * (w & 1);
    }
};
__device__ __forceinline__ void sincos_tab(int pidx, int i, float& c, float& s) {
    const int pos = pidx < SEQ ? pidx : 16384 + (pidx - SEQ);
    const float inv = (float)exp2(-(double)i * (13.287712379549449 / 128.0));
    const float ang = (float)pos * inv;
    const double a = (double)ang;
    const double n = rint(a * 0.15915494309189535);
    double r = fma(-n, 6.283185307179586, a); r = fma(-n, 2.4492935982947064e-16, r);
    const double r2 = r * r;
    double ps = -1.0 / 51090942171709440000.0;
    ps = ps * r2 + 1.0 / 121645100408832000.0; ps = ps * r2 - 1.0 / 355687428096000.0; ps = ps * r2 + 1.0 / 1307674368000.0; ps = ps * r2 - 1.0 / 6227020800.0;
    ps = ps * r2 + 1.0 / 39916800.0; ps = ps * r2 - 1.0 / 362880.0; ps = ps * r2 + 1.0 / 5040.0; ps = ps * r2 - 1.0 / 120.0; ps = ps * r2 + 1.0 / 6.0; ps = 1.0 - ps * r2;
    double pc = 1.0 / 1124000727777607680000.0;
    pc = pc * r2 - 1.0 / 2432902008176640000.0; pc = pc * r2 + 1.0 / 6402373705728000.0; pc = pc * r2 - 1.0 / 20922789888000.0; pc = pc * r2 + 1.0 / 87178291200.0;
    pc = pc * r2 - 1.0 / 479001600.0; pc = pc * r2 + 1.0 / 3628800.0; pc = pc * r2 - 1.0 / 40320.0; pc = pc * r2 + 1.0 / 720.0; pc = pc * r2 - 1.0 / 24.0; pc = pc * r2 + 0.5; pc = 1.0 - pc * r2;
    s = (float)(r * ps); c = (float)pc;
}
__device__ __forceinline__ void rms_row_to_bf16(const float* xr_, const float* g, bf16_t* orow, int lane) {
    const f32x4* xr = (const f32x4*)xr_ + lane; f32x4 v[8]; float s = 0.f;
#pragma unroll
    for (int j = 0; j < 8; ++j) { v[j] = __builtin_nontemporal_load(xr + 64 * j); s += (v[j][0] * v[j][0] + v[j][1] * v[j][1]) + (v[j][2] * v[j][2] + v[j][3] * v[j][3]); }
    const float r = rsqrtf(wave_sum(s) * (1.0f / DM) + EPS);
#pragma unroll
    for (int j = 0; j < 8; ++j) { const f32x4 gg = ((const f32x4*)g)[lane + 64 * j]; const f32x4 y = v[j] * r * gg;
        u32x2 w; w.x = cvt_pk_bf16(y[0], y[1]); w.y = cvt_pk_bf16(y[2], y[3]); ((u32x2*)orow)[lane + 64 * j] = w; }
}
constexpr int P0_I_IN = (DM / 64) * (DIN / 64), P0_I_PR = (DVT / 64) * (DM / 64), P0_I_SQ = (DM / 64) * (DM / 64), P0_I_UP = (DM / 64) * (DFF / 64), P0_I_DN = (DFF / 64) * (DM / 64);
constexpr int P0_NITEMS = P0_I_IN + P0_I_PR + 2 * P0_I_SQ + 2 * P0_I_UP + P0_I_DN, P0_DEF_LO = P0_I_IN, P0_DEF_N = P0_I_PR + 2 * P0_I_SQ;
__device__ __forceinline__ void p0_items(const Frame& F, int gw, int NGW, int v_lo, int v_hi, int skip_lo, int skip_len) {
    const int lane = opaque_tid() & 63;
    LAS float* scr = (LAS float*)(F.lds + F.wave * 16640);
    constexpr int I_IN = P0_I_IN, I_PR = P0_I_PR, I_SQ = P0_I_SQ, I_UP = P0_I_UP;
    for (int v = v_lo + gw; v < v_hi; v += NGW) {
        int r = v >= skip_lo ? v + skip_len : v;
        if (r < I_IN) { transpose_item<false>(INP(F, I_WIN), DIN, DM, WSB(F, WS_WINT), scr, r, lane, ColWin()); continue; } r -= I_IN;
        if (r < I_PR) { transpose_item<true>(INP(F, I_PRET), DM, DVT, WSB(F, WS_PRETT), scr, r, lane, ColId()); continue; } r -= I_PR;
        if (r < I_SQ) { transpose_item<true>(INP(F, I_PCONV), DM, DM, WSB(F, WS_PCONVT), scr, r, lane, ColId()); continue; } r -= I_SQ;
        if (r < I_SQ) { transpose_item<true>(INP(F, I_WO), DM, DM, WSB(F, WS_WOT), scr, r, lane, ColId()); continue; } r -= I_SQ;
        if (r < I_UP) { transpose_item<true>(INP(F, I_WUP), DFF, DM, WSB(F, WS_WUGT), scr, r, lane, ColId()); continue; } r -= I_UP;
        if (r < I_UP) { transpose_item<true>(INP(F, I_WGATE), DFF, DM, WSB(F, WS_WUGT) + (size_t)DFF * DM, scr, r, lane, ColId()); continue; } r -= I_UP;
        transpose_item<true>(INP(F, I_WDOWN), DM, DFF, WSB(F, WS_WDT), scr, r, lane, ColId());
    }
}
__device__ __forceinline__ void p0_prologue(const Frame& F) {
    const int tid = opaque_tid(), lane = tid & 63;
    const int gw = F.vcu * NWAVES + F.wave, NGW = F.G * NWAVES;
    if (F.G == 256) p0_items(F, gw, NGW, 0, P0_NITEMS - P0_DEF_N, P0_DEF_LO, P0_DEF_N);
    else p0_items(F, gw, NGW, 0, P0_NITEMS, 0x7fffffff, 0);
    for (int m = gw; m < MT; m += NGW) rms_row_to_bf16(xrow(F, m), INP(F, I_GPREMIX), WSB(F, WS_HN) + (size_t)m * DM, lane);
    const int gt = F.vcu * NTHREADS + tid, NGT = F.G * NTHREADS;
    for (int e = gt; e < 2052 * 128; e += NGT) { float c, s; sincos_tab(e >> 7, e & 127, c, s); ((f32x2*)WSF(F, WS_ROPE))[e] = (f32x2){c, s}; }
}

constexpr int FL_KBUF = 0, FL_PBUF = 65536, FL_RED = 81920, FL_QBUF = 86016;
__device__ __forceinline__ void flash_unit(const Frame& F, int b, int h, int qb) {
    constexpr int ABL = 0;
    LAS unsigned char* lds = F.lds;
    const int lane = opaque_tid() & 63;
    const int w = F.wave, fr = lane & 15, fq = lane >> 4;
    const int i0 = qb * 128; const int mrow0 = b * SEQ;
    const float L2g = log2gamma(h);
    { const char* qb_ = (const char*)WSB(F, WS_Q) + ((size_t)(mrow0 + i0 + 16 * w) * DM + h * DK) * 2;
      const int r0 = lane >> 5, cp = lane & 31;
#pragma unroll
      for (int i = 0; i < 8; ++i) { const int row = r0 + 2 * i; const unsigned off = (unsigned)(row * (DM * 2) + ((cp ^ row) * 16));
          __builtin_amdgcn_global_load_lds((const unsigned*)(qb_ + off), (LAS unsigned*)(lds + FL_QBUF + w * 8192 + i * 1024), 16, 0, 0); } }
    f32x4 acc[4][8];
#pragma unroll
    for (int ef = 0; ef < 4; ++ef)
#pragma unroll
        for (int qf = 0; qf < 8; ++qf) acc[ef][qf] = (f32x4){0.f, 0.f, 0.f, 0.f};
    const int nkb = 2 * qb + 2, sg = qb >> 2, jb0 = 8 * sg;
    const char* kbase = (const char*)WSB(F, WS_K) + ((size_t)mrow0 * DM + h * DK) * 2;
    const int krow0 = 2 * w + (lane >> 5);
    const unsigned ksrc = (unsigned)(krow0 * (DM * 2) + (((lane & 31) ^ (krow0 & 15)) * 16));
#define FL_STAGE_K(jb, buf) do { if (ABL & 1) break; const char* kb_ = kbase + (size_t)(jb) * (64 * DM * 2); _Pragma("unroll") for (int i = 0; i < 4; ++i) \
        __builtin_amdgcn_global_load_lds((const unsigned*)(kb_ + (size_t)i * (16 * DM * 2) + ksrc), (LAS unsigned*)(lds + FL_KBUF + (buf) * 32768 + i * 8192 + w * 1024), 16, 0, 0); } while (0)
    FL_STAGE_K(jb0, 0);
    const char* vbase = (const char*)WSB(F, WS_VT) + ((size_t)(h * DVH + 64 * w) * LDV + mrow0) * 2;
    float c2[4];
#pragma unroll
    for (int r = 0; r < 4; ++r) c2[r] = __builtin_amdgcn_exp2f(-L2g * (float)(4 * (lane >> 4) + r));
    bf16x8 Vf[4][2];
    if (sg > 0) {
        const char* sb_ = (const char*)WSB(F, WS_ST) + ((size_t)(((b * NH + h) * 3 + (sg - 1)) * DVH + 64 * w) * DK) * 2;
        const unsigned soff = (unsigned)(fr * (DK * 2) + fq * 16);
#pragma unroll
        for (int ef = 0; ef < 4; ++ef)
#pragma unroll
            for (int ks = 0; ks < 2; ++ks) Vf[ef][ks] = *(const bf16x8*)(sb_ + (size_t)ef * (16 * DK * 2) + ks * 64 + soff);
        VM_WAIT(); RAW_BAR();
#pragma unroll
        for (int ks = 0; ks < 8; ++ks) {
#pragma unroll
            for (int qf = 0; qf < 8; ++qf) { const bf16x8 Qf = *(const LAS bf16x8*)(lds + FL_QBUF + (16 * qf + fr) * 512 + (((ks * 4 + fq) ^ fr) * 16));
#pragma unroll
                for (int ef = 0; ef < 4; ++ef) acc[ef][qf] = __builtin_amdgcn_mfma_f32_16x16x32_bf16(Vf[ef][ks & 1], Qf, acc[ef][qf], 0, 0, 0); }
            if (ks < 6) {
#pragma unroll
                for (int ef = 0; ef < 4; ++ef) Vf[ef][ks & 1] = *(const bf16x8*)(sb_ + (size_t)ef * (16 * DK * 2) + (ks + 2) * 64 + soff); } }
#pragma unroll
        for (int qf = 0; qf < 8; ++qf) { const float lam = __builtin_amdgcn_exp2f(L2g * (float)(i0 + 16 * qf + fr - 512 * sg + 1));
#pragma unroll
            for (int ef = 0; ef < 4; ++ef) acc[ef][qf] *= lam; }
    }
    { const char* v0_ = vbase + (size_t)jb0 * 128; const unsigned voff = (unsigned)((lane & 15) * (LDV * 2) + (lane >> 4) * 16);
#pragma unroll
      for (int ef = 0; ef < 4; ++ef)
#pragma unroll
          for (int ks = 0; ks < 2; ++ks) Vf[ef][ks] = *(const bf16x8*)(v0_ + (size_t)ef * (16 * LDV * 2) + ks * 64 + voff); }
    VM_WAIT();
    for (int jb = jb0; jb < nkb; ++jb) {
        RAW_BAR();
        const bool more = jb + 1 < nkb;
        if (more) FL_STAGE_K(jb + 1, (jb + 1) & 1);
        int fr = lane & 15, fq = lane >> 4; asm volatile("" : "+v"(fr), "+v"(fq));
        f32x4 sacc[4];
        const LAS unsigned char* kl = lds + FL_KBUF + (jb & 1) * 32768 + fr * 512;
        const LAS unsigned char* ql_ = lds + FL_QBUF + w * 8192 + fr * 512;
#pragma unroll
        for (int kf = 0; kf < 4; ++kf) sacc[kf] = (f32x4){0.f, 0.f, 0.f, 0.f};
        if (!(ABL & 2)) {
          bf16x8 Qn, Kn[4];
          { const int sw = (fq ^ fr) * 16; Qn = *(const LAS bf16x8*)(ql_ + sw);
#pragma unroll
            for (int kf = 0; kf < 4; ++kf) Kn[kf] = *(const LAS bf16x8*)(kl + kf * 8192 + sw); }
#pragma unroll
          for (int ks = 0; ks < 8; ++ks) { const bf16x8 Qc = Qn; bf16x8 Kc[4];
#pragma unroll
              for (int kf = 0; kf < 4; ++kf) Kc[kf] = Kn[kf];
              if (ks < 7) { const int sw = (((ks + 1) * 4 + fq) ^ fr) * 16; Qn = *(const LAS bf16x8*)(ql_ + sw);
#pragma unroll
                  for (int kf = 0; kf < 4; ++kf) Kn[kf] = *(const LAS bf16x8*)(kl + kf * 8192 + sw); }
              __builtin_amdgcn_sched_barrier(0);
#pragma unroll
              for (int kf = 0; kf < 4; ++kf) sacc[kf] = __builtin_amdgcn_mfma_f32_16x16x32_bf16(Kc[kf], Qc, sacc[kf], 0, 0, 0);
              __builtin_amdgcn_sched_barrier(0); } }
        { const int ql = 16 * w + fr, iq = i0 + ql;
          const float rowf = __builtin_amdgcn_exp2f(L2g * (float)(iq - 64 * jb));
          const bool diag = jb >= 2 * qb;
#pragma unroll
          for (int kf = 0; kf < 4; ++kf) { const int jbase = 64 * jb + 16 * kf + 4 * fq; float pv[4];
              const float rk = rowf * __builtin_amdgcn_exp2f(L2g * (float)(-16 * kf));
#pragma unroll
              for (int r = 0; r < 4; ++r) { if (ABL & 8) { pv[r] = sacc[kf][r]; continue; } pv[r] = sacc[kf][r] * (rk * c2[r]); if (diag) pv[r] = (iq - (jbase + r)) >= 0 ? pv[r] : 0.f; }
              u32x2 pw; pw.x = cvt_pk_bf16(pv[0], pv[1]); pw.y = cvt_pk_bf16(pv[2], pv[3]);
              *(LAS u32x2*)(lds + FL_PBUF + ql * 128 + (((kf * 2 + (fq >> 1)) ^ ((ql >> 1) & 7)) * 16) + (fq & 1) * 8) = pw; } }
        LDS_WAIT(); RAW_BAR();
        { const LAS unsigned char* pl = lds + FL_PBUF + fr * 128;
          const char* vn_ = vbase + (size_t)(jb + 1) * 128; const unsigned voff = (unsigned)(fr * (LDV * 2) + fq * 16);
#pragma unroll
          for (int ks = 0; ks < 2; ++ks) { const int sw = (((ks * 4 + fq) ^ ((fr >> 1) & 7)) * 16);
              bf16x8 Pn0 = *(const LAS bf16x8*)(pl + sw), Pn1 = *(const LAS bf16x8*)(pl + 2048 + sw);
#pragma unroll
              for (int qf = 0; qf < 8; ++qf) { const bf16x8 Pc = Pn0; Pn0 = Pn1;
                  if (qf < 6) Pn1 = *(const LAS bf16x8*)(pl + (qf + 2) * 2048 + sw);
                  __builtin_amdgcn_sched_barrier(0);
#pragma unroll
                  for (int ef = 0; ef < 4; ++ef) { if (ABL & 4) { asm volatile("" :: "v"(Pc)); continue; } acc[ef][qf] = __builtin_amdgcn_mfma_f32_16x16x32_bf16(Vf[ef][ks], Pc, acc[ef][qf], 0, 0, 0); }
                  __builtin_amdgcn_sched_barrier(0); }
              if (more && !(ABL & 1)) {
#pragma unroll
                  for (int ef = 0; ef < 4; ++ef) Vf[ef][ks] = *(const bf16x8*)(vn_ + (size_t)ef * (16 * LDV * 2) + ks * 64 + voff); } } }
        asm volatile("s_waitcnt vmcnt(8)" ::: "memory");
    }
#undef FL_STAGE_K
    LAS float* red = (LAS float*)(lds + FL_RED);
    float ss[8];
#pragma unroll
    for (int qf = 0; qf < 8; ++qf) { float s = 0.f;
#pragma unroll
        for (int ef = 0; ef < 4; ++ef) { const f32x4 a = acc[ef][qf]; s += (a[0] * a[0] + a[1] * a[1]) + (a[2] * a[2] + a[3] * a[3]); }
        s += __shfl_xor(s, 16); s += __shfl_xor(s, 32); ss[qf] = s; }
    if (fq == 0) {
#pragma unroll
        for (int qf = 0; qf < 8; ++qf) red[w * 128 + 16 * qf + fr] = ss[qf]; }
    LDS_WAIT(); RAW_BAR();
    { const size_t ub = ((size_t)(mrow0 + i0) * DVT + h * DVH + 64 * w) * 2;
      const char* gbase = (const char*)WSB(F, WS_GR) + ub; char* obase = (char*)WSB(F, WS_ARET) + ub;
      const unsigned loff = (unsigned)(fr * (DVT * 2) + fq * 8);
#pragma unroll
      for (int qf = 0; qf < 8; ++qf) { float tot = 0.f;
#pragma unroll
          for (int ww = 0; ww < 8; ++ww) tot += red[ww * 128 + 16 * qf + fr];
          const float rstd = rsqrtf(tot * (1.0f / DVH) + EPS);
#pragma unroll
          for (int ef = 0; ef < 4; ++ef) { const size_t uo = (size_t)qf * (16 * DVT * 2) + ef * 32;
              const u32x2 g = *(const u32x2*)(gbase + uo + loff); const f32x4 a = acc[ef][qf];
              u32x2 o; o.x = cvt_pk_bf16(a[0] * rstd * bf_lo(g.x), a[1] * rstd * bf_hi(g.x)); o.y = cvt_pk_bf16(a[2] * rstd * bf_lo(g.y), a[3] * rstd * bf_hi(g.y));
              *(u32x2*)(obase + uo + loff) = o; }
          CFENCE(); } }
    LDS_WAIT(); RAW_BAR();
}

constexpr int SS_Q = 110592, SS_K = 126976, SS_D = 143360, SS_RED = 143616;
struct StreamSt {
    f32x4 cr[4], vd[4], bc[4];
    const char* s0; char* s1;
    unsigned toff; int git;
    const LAS float* sq; const LAS float* sk; float g4;
};
__device__ __forceinline__ void stream_load(StreamSt& T, int it) {
#pragma unroll
    for (int k = 0; k < 4; ++k) T.bc[k] = __builtin_nontemporal_load((const f32x4*)(T.s0 + (size_t)((4 * it + k) * (DVH * 4)) + T.toff));
}
__device__ __forceinline__ void stream_proc(StreamSt& T, int it) {
#pragma unroll
    for (int k = 0; k < 4; ++k) { const int d = 4 * it + k; const f32x4 s = T.bc[k]; f32x4 sn = s * T.g4;
#pragma unroll
        for (int j = 0; j < 4; ++j) { T.cr[j] += s * T.sq[j * 256 + d]; sn += T.vd[j] * T.sk[j * 256 + d]; }
        __builtin_nontemporal_store(sn, (f32x4*)(T.s1 + (size_t)(d * (DVH * 4)) + T.toff)); }
}
constexpr int F6_KBUF = 0, F6_PBUF = 65536, F6_RED = 73728, F6_QBUF = 77824;
template <bool STREAM>
__device__ __forceinline__ void flash64_unit(const Frame& F, int b, int h, int qb, StreamSt& T) {
    LAS unsigned char* lds = F.lds;
    const int lane = opaque_tid() & 63;
    const int w = F.wave, qfw = w & 3, kf0 = 2 * (w >> 2);
    const int i0 = qb * 64; const int mrow0 = b * SEQ;
    const float L2g = log2gamma(h);
    { const char* qb_ = (const char*)WSB(F, WS_Q) + ((size_t)(mrow0 + i0) * DM + h * DK) * 2;
      const int r0 = lane >> 5, cp = lane & 31;
#pragma unroll
      for (int i = 0; i < 4; ++i) { const int row = 8 * w + 2 * i + r0; const unsigned off = (unsigned)(row * (DM * 2) + ((cp ^ (row & 15)) * 16));
          __builtin_amdgcn_global_load_lds((const unsigned*)(qb_ + off), (LAS unsigned*)(lds + F6_QBUF + (4 * w + i) * 1024), 16, 0, 0); } }
    f32x4 acc[4][4];
#pragma unroll
    for (int ef = 0; ef < 4; ++ef)
#pragma unroll
        for (int qf = 0; qf < 4; ++qf) acc[ef][qf] = (f32x4){0.f, 0.f, 0.f, 0.f};
    const int nkb = qb + 1;
    const char* kbase = (const char*)WSB(F, WS_K) + ((size_t)mrow0 * DM + h * DK) * 2;
    const int krow0 = 2 * w + (lane >> 5);
    const unsigned ksrc = (unsigned)(krow0 * (DM * 2) + (((lane & 31) ^ (krow0 & 15)) * 16));
#define F6_STAGE_K(jb, buf) do { const char* kb_ = kbase + (size_t)(jb) * (64 * DM * 2); _Pragma("unroll") for (int i = 0; i < 4; ++i) \
        __builtin_amdgcn_global_load_lds((const unsigned*)(kb_ + (size_t)i * (16 * DM * 2) + ksrc), (LAS unsigned*)(lds + F6_KBUF + (buf) * 32768 + i * 8192 + w * 1024), 16, 0, 0); } while (0)
    F6_STAGE_K(0, 0);
    const char* vbase = (const char*)WSB(F, WS_VT) + ((size_t)(h * DVH + 64 * w) * LDV + mrow0) * 2;
    float c2[4];
#pragma unroll
    for (int r = 0; r < 4; ++r) c2[r] = __builtin_amdgcn_exp2f(-L2g * (float)(4 * (lane >> 4) + r));
    bf16x8 Vf[4][2];
    { const unsigned voff = (unsigned)((lane & 15) * (LDV * 2) + (lane >> 4) * 16);
#pragma unroll
      for (int ef = 0; ef < 4; ++ef)
#pragma unroll
          for (int ks = 0; ks < 2; ++ks) Vf[ef][ks] = *(const bf16x8*)(vbase + (size_t)ef * (16 * LDV * 2) + ks * 64 + voff); }
    VM_WAIT();
    for (int jb = 0; jb < nkb; ++jb) {
        RAW_BAR();
        const bool more = jb + 1 < nkb;
        if (more) F6_STAGE_K(jb + 1, (jb + 1) & 1);
        int fr = lane & 15, fq = lane >> 4; asm volatile("" : "+v"(fr), "+v"(fq));
        f32x4 sacc[2];
        sacc[0] = (f32x4){0.f, 0.f, 0.f, 0.f}; sacc[1] = (f32x4){0.f, 0.f, 0.f, 0.f};
        { const LAS unsigned char* kl = lds + F6_KBUF + (jb & 1) * 32768 + (16 * kf0 + fr) * 512;
          const LAS unsigned char* ql_ = lds + F6_QBUF + (16 * qfw + fr) * 512;
          bf16x8 Qa, Ka0, Ka1, Qb, Kb0, Kb1;
          { const int s0 = (fq ^ fr) * 16, s1 = ((4 + fq) ^ fr) * 16;
            Qa = *(const LAS bf16x8*)(ql_ + s0); Ka0 = *(const LAS bf16x8*)(kl + s0); Ka1 = *(const LAS bf16x8*)(kl + 8192 + s0);
            Qb = *(const LAS bf16x8*)(ql_ + s1); Kb0 = *(const LAS bf16x8*)(kl + s1); Kb1 = *(const LAS bf16x8*)(kl + 8192 + s1); }
#pragma unroll
          for (int ks = 0; ks < 8; ++ks) { const bf16x8 Qc = Qa, Kc0 = Ka0, Kc1 = Ka1;
              Qa = Qb; Ka0 = Kb0; Ka1 = Kb1;
              if (ks < 6) { const int sw = (((ks + 2) * 4 + fq) ^ fr) * 16; Qb = *(const LAS bf16x8*)(ql_ + sw); Kb0 = *(const LAS bf16x8*)(kl + sw); Kb1 = *(const LAS bf16x8*)(kl + 8192 + sw); }
              __builtin_amdgcn_sched_barrier(0);
              sacc[0] = __builtin_amdgcn_mfma_f32_16x16x32_bf16(Kc0, Qc, sacc[0], 0, 0, 0);
              sacc[1] = __builtin_amdgcn_mfma_f32_16x16x32_bf16(Kc1, Qc, sacc[1], 0, 0, 0);
              __builtin_amdgcn_sched_barrier(0); } }
        { const int ql = 16 * qfw + fr, iq = i0 + ql;
          const float rowf = __builtin_amdgcn_exp2f(L2g * (float)(iq - 64 * jb));
          const bool diag = jb == qb;
#pragma unroll
          for (int kk = 0; kk < 2; ++kk) { const int kf = kf0 + kk; const int jbase = 64 * jb + 16 * kf + 4 * fq; float pv[4];
              const float rk = rowf * __builtin_amdgcn_exp2f(L2g * (float)(-16 * kf));
#pragma unroll
              for (int r = 0; r < 4; ++r) { pv[r] = sacc[kk][r] * (rk * c2[r]); if (diag) pv[r] = (iq - (jbase + r)) >= 0 ? pv[r] : 0.f; }
              u32x2 pw; pw.x = cvt_pk_bf16(pv[0], pv[1]); pw.y = cvt_pk_bf16(pv[2], pv[3]);
              *(LAS u32x2*)(lds + F6_PBUF + ql * 128 + (((kf * 2 + (fq >> 1)) ^ ((ql >> 1) & 7)) * 16) + (fq & 1) * 8) = pw; } }
        LDS_WAIT(); RAW_BAR();
        { const LAS unsigned char* pl = lds + F6_PBUF + fr * 128;
          const char* vn_ = vbase + (size_t)(jb + 1) * 128; const unsigned voff = (unsigned)(fr * (LDV * 2) + fq * 16);
          bf16x8 Pf[2][4];
#pragma unroll
          for (int ks = 0; ks < 2; ++ks) { const int sw = (((ks * 4 + fq) ^ ((fr >> 1) & 7)) * 16);
#pragma unroll
              for (int qf = 0; qf < 4; ++qf) Pf[ks][qf] = *(const LAS bf16x8*)(pl + qf * 2048 + sw); }
#pragma unroll
          for (int ks = 0; ks < 2; ++ks) {
#pragma unroll
              for (int qf = 0; qf < 4; ++qf)
#pragma unroll
                  for (int ef = 0; ef < 4; ++ef) acc[ef][qf] = __builtin_amdgcn_mfma_f32_16x16x32_bf16(Vf[ef][ks], Pf[ks][qf], acc[ef][qf], 0, 0, 0);
              if (more) {
#pragma unroll
                  for (int ef = 0; ef < 4; ++ef) Vf[ef][ks] = *(const bf16x8*)(vn_ + (size_t)ef * (16 * LDV * 2) + ks * 64 + voff); } } }
        if constexpr (STREAM) {
            const int it = T.git; T.git = it + 1;
            if (it < 63) { stream_proc(T, it); stream_load(T, it + 1); if (more) asm volatile("s_waitcnt vmcnt(16)" ::: "memory"); }
            else if (it == 63) { stream_proc(T, it); if (more) asm volatile("s_waitcnt vmcnt(12)" ::: "memory"); }
            else { if (more) asm volatile("s_waitcnt vmcnt(8)" ::: "memory"); }
        } else {
            asm volatile("s_waitcnt vmcnt(8)" ::: "memory");
        }
    }
#undef F6_STAGE_K
    LAS float* red = (LAS float*)(lds + F6_RED);
    { const int fr = lane & 15, fq = lane >> 4;
      float ss[4];
#pragma unroll
      for (int qf = 0; qf < 4; ++qf) { float s = 0.f;
#pragma unroll
          for (int ef = 0; ef < 4; ++ef) { const f32x4 a = acc[ef][qf]; s += (a[0] * a[0] + a[1] * a[1]) + (a[2] * a[2] + a[3] * a[3]); }
          s += __shfl_xor(s, 16); s += __shfl_xor(s, 32); ss[qf] = s; }
      if (fq == 0) {
#pragma unroll
          for (int qf = 0; qf < 4; ++qf) red[w * 64 + 16 * qf + fr] = ss[qf]; }
      LDS_WAIT(); RAW_BAR();
      const size_t ub = ((size_t)(mrow0 + i0) * DVT + h * DVH + 64 * w) * 2;
      const char* gbase = (const char*)WSB(F, WS_GR) + ub; char* obase = (char*)WSB(F, WS_ARET) + ub;
      const unsigned loff = (unsigned)(fr * (DVT * 2) + fq * 8);
#pragma unroll
      for (int qf = 0; qf < 4; ++qf) { float tot = 0.f;
#pragma unroll
          for (int ww = 0; ww < 8; ++ww) tot += red[ww * 64 + 16 * qf + fr];
          const float rstd = rsqrtf(tot * (1.0f / DVH) + EPS);
#pragma unroll
          for (int ef = 0; ef < 4; ++ef) { const size_t uo = (size_t)qf * (16 * DVT * 2) + ef * 32;
              const u32x2 g = *(const u32x2*)(gbase + uo + loff); const f32x4 a = acc[ef][qf];
              u32x2 o; o.x = cvt_pk_bf16(a[0] * rstd * bf_lo(g.x), a[1] * rstd * bf_hi(g.x)); o.y = cvt_pk_bf16(a[2] * rstd * bf_lo(g.y), a[3] * rstd * bf_hi(g.y));
              *(u32x2*)(obase + uo + loff) = o; }
          CFENCE(); } }
    LDS_WAIT(); RAW_BAR();
}

constexpr int SM_QS = 0, SM_KS = 4096, SM_VS = 8192, SM_SD = 16384, SM_RED = 16640, SM_XR = 32768;
__device__ __forceinline__ void sample_unit(const Frame& F, int b, int h) {
    LAS unsigned char* lds = F.lds;
    const int tid = opaque_tid();
    const int lane = tid & 63, w = tid >> 6;
    LAS float* qs = (LAS float*)(lds + SM_QS); LAS float* ks = (LAS float*)(lds + SM_KS); LAS float* vs = (LAS float*)(lds + SM_VS);
    LAS float* sd = (LAS float*)(lds + SM_SD); LAS float* red = (LAS float*)(lds + SM_RED); LAS float* xr = (LAS float*)(lds + SM_XR);
    const int m0 = MP + 4 * b;
    const float L2g = log2gamma(h);
    for (int e = tid; e < 1024; e += NTHREADS) { const int t = e >> 8, d = e & 255, dp = d < 128 ? 2 * d : 2 * (d - 128) + 1;
        qs[e] = bf1(WSB(F, WS_Q)[(size_t)(m0 + t) * DM + h * DK + dp]); ks[e] = bf1(WSB(F, WS_K)[(size_t)(m0 + t) * DM + h * DK + dp]); }
    { const int e = tid; const u32x2 vv = *(const u32x2*)(WSB(F, WS_VT) + (size_t)(h * DVH + e) * LDV + m0);
      vs[0 * 512 + e] = bf_lo(vv.x); vs[1 * 512 + e] = bf_hi(vv.x); vs[2 * 512 + e] = bf_lo(vv.y); vs[3 * 512 + e] = bf_hi(vv.y); }
    LDS_WAIT(); RAW_BAR();
#pragma unroll
    for (int pp = 0; pp < 2; ++pp) { const int pr = 2 * w + pp, t = pr >> 2, j = pr & 3; float s = 0.f;
#pragma unroll
        for (int i = 0; i < 4; ++i) s += qs[t * 256 + lane + 64 * i] * ks[j * 256 + lane + 64 * i];
        s = wave_sum(s);
        if (lane == 0) sd[pr] = (j <= t) ? s * __builtin_amdgcn_exp2f(L2g * (float)(t - j)) : 0.f; }
    const int e4 = (tid & 127) * 4, dg = tid >> 7;
    f32x4 vd[4];
#pragma unroll
    for (int j = 0; j < 4; ++j) { const float dj = __builtin_amdgcn_exp2f(L2g * (float)(3 - j)); vd[j] = (f32x4){vs[j * 512 + e4], vs[j * 512 + e4 + 1], vs[j * 512 + e4 + 2], vs[j * 512 + e4 + 3]} * dj; }
    const float g4 = __builtin_amdgcn_exp2f(L2g * 4.0f);
    f32x4 cr[4];
#pragma unroll
    for (int t = 0; t < 4; ++t) cr[t] = (f32x4){0.f, 0.f, 0.f, 0.f};
    const char* s0 = (const char*)(INP(F, I_SRET) + ((size_t)(b * NH + h) * DK) * DVH);
    char* s1 = (char*)(F.out + OFF_RS + ((size_t)(b * NH + h) * DK) * DVH);
    const unsigned toff = (unsigned)((dg * DVH + e4) * 4);
    f32x4 bA[16], bB[16];
#define SM_LOAD(buf, bt) do { _Pragma("unroll") for (int k_ = 0; k_ < 16; ++k_) buf[k_] = __builtin_nontemporal_load((const f32x4*)(s0 + (size_t)(((bt) * 16 + k_) * (4 * DVH * 4)) + toff)); } while (0)
#define SM_PROC(buf, bt) do { _Pragma("unroll") for (int k_ = 0; k_ < 16; ++k_) { const int d = ((bt) * 16 + k_) * 4 + dg; const f32x4 s = buf[k_]; f32x4 sn = s * g4; \
        _Pragma("unroll") for (int j = 0; j < 4; ++j) { cr[j] += s * qs[j * 256 + d]; sn += vd[j] * ks[j * 256 + d]; } \
        __builtin_nontemporal_store(sn, (f32x4*)(s1 + (size_t)(((bt) * 16 + k_) * (4 * DVH * 4)) + toff)); } } while (0)
    SM_LOAD(bA, 0); SM_LOAD(bB, 1);
    SM_PROC(bA, 0); SM_LOAD(bA, 2);
    SM_PROC(bB, 1); SM_LOAD(bB, 3);
    SM_PROC(bA, 2);
    SM_PROC(bB, 3);
#undef SM_LOAD
#undef SM_PROC
#pragma unroll
    for (int t = 0; t < 4; ++t) *(LAS f32x4*)(xr + (dg * 4 + t) * 512 + e4) = cr[t];
    LDS_WAIT(); RAW_BAR();
    { const int e = tid; float o[4];
#pragma unroll
      for (int t = 0; t < 4; ++t) { float c = (xr[(0 * 4 + t) * 512 + e] + xr[(1 * 4 + t) * 512 + e]) + (xr[(2 * 4 + t) * 512 + e] + xr[(3 * 4 + t) * 512 + e]);
          float in = 0.f;
#pragma unroll
          for (int j = 0; j < 4; ++j) in += sd[t * 4 + j] * vs[j * 512 + e];
          o[t] = in + c * __builtin_amdgcn_exp2f(L2g * (float)(t + 1)); }
#pragma unroll
      for (int t = 0; t < 4; ++t) { const float s = wave_sum(o[t] * o[t]); if (lane == 0) red[w * 4 + t] = s; }
      LDS_WAIT(); RAW_BAR();
#pragma unroll
      for (int t = 0; t < 4; ++t) { float tot = 0.f;
#pragma unroll
          for (int ww = 0; ww < 8; ++ww) tot += red[ww * 4 + t];
          const float rstd = rsqrtf(tot * (1.0f / DVH) + EPS);
          const size_t off = (size_t)(m0 + t) * DVT + h * DVH + e;
          const float val = o[t] * rstd * bf1(WSB(F, WS_GR)[off]);
          WSB(F, WS_ARET)[off] = (bf16_t)(cvt_pk_bf16(val, 0.f) & 0xffffu); } }
    LDS_WAIT(); RAW_BAR();
}

__device__ __forceinline__ void conv_branch_range(const Frame& F, int i0, int i1) {
#pragma unroll 2
    for (int it = i0 + opaque_tid(); it < i1; it += NTHREADS) { const int m = it >> 8, c = (it & 255) * 8;
        f32x4 u2a, u2b, u1a, u1b, u0a, u0b;
        unpack8(*(const u32x4*)(WSB(F, WS_CPR) + (size_t)m * DM + c), u2a, u2b);
        const f32x4 z = (f32x4){0.f, 0.f, 0.f, 0.f}; u1a = z; u1b = z; u0a = z; u0b = z;
        if (m < MP) { const int t = m & (SEQ - 1);
            if (t >= 1) unpack8(*(const u32x4*)(WSB(F, WS_CPR) + (size_t)(m - 1) * DM + c), u1a, u1b);
            if (t >= 2) unpack8(*(const u32x4*)(WSB(F, WS_CPR) + (size_t)(m - 2) * DM + c), u0a, u0b);
        } else { const int ms = m - MP, b = ms >> 2, t = ms & 3;
            if (t + 1 >= 2) unpack8(*(const u32x4*)(WSB(F, WS_CPR) + (size_t)(m - 1) * DM + c), u1a, u1b); else { const float* sp = INP(F, I_SCONV) + ((size_t)b * 2 + (t + 1)) * DM + c; u1a = *(const f32x4*)sp; u1b = *(const f32x4*)(sp + 4); }
            if (t >= 2) unpack8(*(const u32x4*)(WSB(F, WS_CPR) + (size_t)(m - 2) * DM + c), u0a, u0b); else { const float* sp = INP(F, I_SCONV) + ((size_t)b * 2 + t) * DM + c; u0a = *(const f32x4*)sp; u0b = *(const f32x4*)(sp + 4); } }
        const f32x4 w0a = *(const f32x4*)(INP(F, I_CONVW) + c), w0b = *(const f32x4*)(INP(F, I_CONVW) + c + 4), w1a = *(const f32x4*)(INP(F, I_CONVW) + DM + c), w1b = *(const f32x4*)(INP(F, I_CONVW) + DM + c + 4),
                    w2a = *(const f32x4*)(INP(F, I_CONVW) + 2 * DM + c), w2b = *(const f32x4*)(INP(F, I_CONVW) + 2 * DM + c + 4);
        f32x4 ga, gb; unpack8(__builtin_nontemporal_load((const u32x4*)(WSB(F, WS_GB) + (size_t)m * DM + c)), ga, gb);
        const f32x4 oa = (w0a * u0a + w1a * u1a + w2a * u2a) * ga, ob = (w0b * u0b + w1b * u1b + w2b * u2b) * gb;
        *(u32x4*)(WSB(F, WS_ACONV) + (size_t)m * DM + c) = pack8(oa, ob); }
}
__device__ __forceinline__ void kht_prep(const Frame& F, int wi, int nw) {
    LAS float* scr = (LAS float*)(F.lds + F.wave * 16640);
    const int lane = opaque_tid() & 63;
    const int gw = wi * NWAVES + F.wave, NGW = nw * NWAVES;
    constexpr int NIT = NBATCH * NH * (SEQ / 64) * (DK / 64);
    for (int it = gw; it < NIT; it += NGW) { const int db = it & 3, tb = (it >> 2) & 31, bh = it >> 7, b = bh >> 3, h = bh & 7;
        const float L2g = log2gamma(h);
        const int t0 = 64 * tb, d0 = 64 * db;
#pragma unroll
        for (int i = 0; i < 8; ++i) { const int tr = (lane >> 3) + 8 * i, cc = lane & 7;
            f32x4 a, bq; unpack8(*(const u32x4*)(WSB(F, WS_K) + (size_t)(b * SEQ + t0 + tr) * DM + h * DK + d0 + 8 * cc), a, bq);
            const float dec = __builtin_amdgcn_exp2f(L2g * (float)(SEQ - 1 - (t0 + tr)));
            LAS float* sp = scr + tr * 65 + 8 * cc;
            sp[0] = a[0] * dec; sp[1] = a[1] * dec; sp[2] = a[2] * dec; sp[3] = a[3] * dec; sp[4] = bq[0] * dec; sp[5] = bq[1] * dec; sp[6] = bq[2] * dec; sp[7] = bq[3] * dec; }
        LDS_WAIT(); CFENCE();
#pragma unroll
        for (int j = 0; j < 8; ++j) { const int n = (lane >> 3) + 8 * j, cc = lane & 7; const LAS float* s = scr + (8 * cc) * 65 + n;
            u32x4 o; o.x = cvt_pk_bf16(s[0 * 65], s[1 * 65]); o.y = cvt_pk_bf16(s[2 * 65], s[3 * 65]); o.z = cvt_pk_bf16(s[4 * 65], s[5 * 65]); o.w = cvt_pk_bf16(s[6 * 65], s[7 * 65]);
            *(u32x4*)(WSB(F, WS_KHT) + ((size_t)bh * DK + d0 + n) * SEQ + t0 + 8 * cc) = o; }
        LDS_WAIT(); CFENCE(); }
}

__device__ __forceinline__ void p2_merged(const Frame& F) {
    LAS unsigned char* lds = F.lds;
    const int tid = opaque_tid(), lane = tid & 63, g = tid >> 7, wg = (tid >> 6) & 1, e4 = (tid & 127) * 4;
    const int su = 4 * F.vcu + g, bS = su >> 3, hS = su & 7, m0 = MP + 4 * bS;
    const float L2g = log2gamma(hS);
    LAS float* sq = (LAS float*)(lds + SS_Q) + g * 1024; LAS float* sk = (LAS float*)(lds + SS_K) + g * 1024;
    LAS float* sd = (LAS float*)(lds + SS_D) + g * 16; LAS float* sred = (LAS float*)(lds + SS_RED);
    for (int e = (tid & 127); e < 1024; e += 128) { const int t = e >> 8, d = e & 255, dp = d < 128 ? 2 * d : 2 * (d - 128) + 1;
        sq[e] = bf1(WSB(F, WS_Q)[(size_t)(m0 + t) * DM + hS * DK + dp]); sk[e] = bf1(WSB(F, WS_K)[(size_t)(m0 + t) * DM + hS * DK + dp]); }
    StreamSt T;
    {
      f32x4 v[4];
#pragma unroll
      for (int c = 0; c < 4; ++c) { const u32x2 vv = *(const u32x2*)(WSB(F, WS_VT) + (size_t)(hS * DVH + e4 + c) * LDV + m0);
          v[0][c] = bf_lo(vv.x); v[1][c] = bf_hi(vv.x); v[2][c] = bf_lo(vv.y); v[3][c] = bf_hi(vv.y); }
#pragma unroll
      for (int j = 0; j < 4; ++j) T.vd[j] = v[j] * __builtin_amdgcn_exp2f(L2g * (float)(3 - j)); }
#pragma unroll
    for (int t = 0; t < 4; ++t) T.cr[t] = (f32x4){0.f, 0.f, 0.f, 0.f};
    T.s0 = (const char*)(INP(F, I_SRET) + ((size_t)(bS * NH + hS) * DK) * DVH); T.s1 = (char*)(F.out + OFF_RS + ((size_t)(bS * NH + hS) * DK) * DVH);
    T.toff = (unsigned)(e4 * 4); T.git = 0; T.sq = sq; T.sk = sk; T.g4 = __builtin_amdgcn_exp2f(L2g * 4.0f);
    stream_load(T, 0);
    LDS_WAIT(); RAW_BAR();
#pragma unroll
    for (int i = 0; i < 8; ++i) { const int pr = 8 * wg + i, t = pr >> 2, j = pr & 3; float sc = 0.f;
#pragma unroll
        for (int i4 = 0; i4 < 4; ++i4) sc += sq[t * 256 + lane + 64 * i4] * sk[j * 256 + lane + 64 * i4];
        sc = wave_sum(sc);
        if (lane == 0) sd[pr] = (j <= t) ? sc * __builtin_amdgcn_exp2f(L2g * (float)((t - j) - (3 - j))) : 0.f; }
    LDS_WAIT(); RAW_BAR();
    { const int p = F.vcu, bh = p >> 3, ql = p & 7, b_ = bh >> 3, h_ = bh & 7;
#pragma unroll 1
      for (int u = 0; u < 4; ++u) { const int qb = u == 0 ? 31 - ql : u == 1 ? 16 + ql : u == 2 ? 15 - ql : ql; flash64_unit<true>(F, b_, h_, qb, T); } }
    while (T.git < 64) { const int it = T.git; T.git = it + 1; stream_proc(T, it); if (it < 63) stream_load(T, it + 1); }
    f32x4 o[4];
    float L2e = L2g; asm volatile("" : "+v"(L2e));
#pragma unroll
    for (int t = 0; t < 4; ++t) { f32x4 in = (f32x4){0.f, 0.f, 0.f, 0.f};
#pragma unroll
        for (int j = 0; j < 4; ++j) in += T.vd[j] * sd[t * 4 + j];
        o[t] = in + T.cr[t] * __builtin_amdgcn_exp2f(L2e * (float)(t + 1));
        const float ps = wave_sum((o[t][0] * o[t][0] + o[t][1] * o[t][1]) + (o[t][2] * o[t][2] + o[t][3] * o[t][3]));
        if (lane == 0) sred[(g * 2 + wg) * 4 + t] = ps; }
    LDS_WAIT(); RAW_BAR();
#pragma unroll
    for (int t = 0; t < 4; ++t) { const float tot = sred[(g * 2) * 4 + t] + sred[(g * 2 + 1) * 4 + t];
        const float rstd = rsqrtf(tot * (1.0f / DVH) + EPS);
        const size_t off = (size_t)(m0 + t) * DVT + hS * DVH + e4;
        const u32x2 gg = *(const u32x2*)(WSB(F, WS_GR) + off);
        u32x2 ow; ow.x = cvt_pk_bf16(o[t][0] * rstd * bf_lo(gg.x), o[t][1] * rstd * bf_hi(gg.x)); ow.y = cvt_pk_bf16(o[t][2] * rstd * bf_lo(gg.y), o[t][3] * rstd * bf_hi(gg.y));
        *(u32x2*)(WSB(F, WS_ARET) + off) = ow; }
    LDS_WAIT(); RAW_BAR();
}

__device__ __forceinline__ void conv_branch_range(const Frame& F, int i0, int i1);

__device__ __forceinline__ void p2_main(const Frame& F, int c) {
    unsigned* cnt = (unsigned*)(F.ws + WS_STCNT);
    { SchedState S{(const char*)WSB(F, WS_KHT), (const char*)WSB(F, WS_VT), c}; EpiState E{WSB(F, WS_ST)}; gemm_phase<false>(F.lds, S, E); }
    if (c < 192) {
        if (threadIdx.x == 0) { __builtin_amdgcn_fence(__ATOMIC_RELEASE, "agent"); asm volatile("s_waitcnt vmcnt(0)" ::: "memory");
            __hip_atomic_fetch_add(cnt, 1u, __ATOMIC_RELAXED, __HIP_MEMORY_SCOPE_AGENT); }
    }
    const int vc = F.vcu;
    const int nS = vc < DECB * NH ? (DECB * NH - vc + F.G - 1) / F.G : 0, nP = vc < 256 ? (256 - vc + F.G - 1) / F.G : 0;
    const int typ = (vc >> 3) % 3, fpos = typ == 0 ? (nS < 1 ? nS : 1) : typ == 1 ? nS / 2 : nS;
    int ns = 0, nf = 0;
#pragma unroll 1
    for (int slot = 0; slot < nS + 2 * nP; ++slot) {
        if (slot >= fpos && nf < 2 * nP) {
            if (nf == 0) {
                if (threadIdx.x == 0) { unsigned sp = 0;
                    while (__hip_atomic_load(cnt, __ATOMIC_RELAXED, __HIP_MEMORY_SCOPE_AGENT) < 192u) { __builtin_amdgcn_s_sleep(2); if (++sp > (1u << 22)) break; }
                    __builtin_amdgcn_fence(__ATOMIC_ACQUIRE, "agent"); asm volatile("s_waitcnt vmcnt(0)" ::: "memory"); }
                __syncthreads(); }
            const int p = vc + (nf >> 1) * F.G, bh = p >> 3, ql = p & 7;
            flash_unit(F, bh >> 3, bh & 7, (nf & 1) ? ql : 15 - ql); ++nf;
        } else { const int su = vc + ns * F.G; ++ns; sample_unit(F, su >> 3, su & 7); }
    }
    { constexpr int NIT = MT * (DM / 8), PER = (NIT + 383) / 384;
      if (F.G == 256) { const int wgt = c >> 6, u0 = c < 64 ? 0 : c < 128 ? (c - 64) : c < 192 ? 64 + 2 * (c - 128) : 192 + 3 * (c - 192);
          const int i0 = u0 * PER, i1 = (u0 + wgt) * PER < NIT ? (u0 + wgt) * PER : NIT; conv_branch_range(F, i0, i1); }
      else { const int per = (NIT + F.G - 1) / F.G; const int i0 = c * per, i1 = (c + 1) * per < NIT ? (c + 1) * per : NIT; conv_branch_range(F, i0, i1); } }
}

__device__ __forceinline__ void p5_rows(const Frame& F) {
    const int gw = F.vcu * NWAVES + F.wave, NGW = F.G * NWAVES, lane = opaque_tid() & 63;
#pragma unroll 2
    for (int m = gw; m < MT; m += NGW) {
        const u32x2* mr = (const u32x2*)(WSB(F, WS_MIX) + (size_t)m * DM) + lane; const f32x4* xr = (const f32x4*)xrow(F, m) + lane;
        f32x4 v[8]; float s = 0.f;
#pragma unroll
        for (int j = 0; j < 8; ++j) { const u32x2 w_ = mr[64 * j]; v[j] = (f32x4){bf_lo(w_.x), bf_hi(w_.x), bf_lo(w_.y), bf_hi(w_.y)}; s += (v[j][0] * v[j][0] + v[j][1] * v[j][1]) + (v[j][2] * v[j][2] + v[j][3] * v[j][3]); }
        const float r1 = rsqrtf(wave_sum(s) * (1.0f / DM) + EPS); float s2 = 0.f;
#pragma unroll
        for (int j = 0; j < 8; ++j) { const f32x4 g = ((const f32x4*)INP(F, I_GPOSTMIX))[lane + 64 * j]; v[j] = __builtin_nontemporal_load(xr + 64 * j) + v[j] * r1 * g;
            s2 += (v[j][0] * v[j][0] + v[j][1] * v[j][1]) + (v[j][2] * v[j][2] + v[j][3] * v[j][3]); __builtin_nontemporal_store(v[j], (f32x4*)(WSF(F, WS_X1) + (size_t)m * DM) + lane + 64 * j); }
        const float r2 = rsqrtf(wave_sum(s2) * (1.0f / DM) + EPS);
#pragma unroll
        for (int j = 0; j < 8; ++j) { const f32x4 g = ((const f32x4*)INP(F, I_GPREFFN))[lane + 64 * j]; const f32x4 y = v[j] * r2 * g;
            u32x2 w; w.x = cvt_pk_bf16(y[0], y[1]); w.y = cvt_pk_bf16(y[2], y[3]); ((u32x2*)(WSB(F, WS_HN) + (size_t)m * DM))[lane + 64 * j] = w; }
    }
}
__device__ __forceinline__ float gelu_tanh(float v) { const float u = 1.5957691216057308f * (v + 0.044715f * v * v * v); return v * __builtin_amdgcn_rcpf(1.0f + __builtin_amdgcn_exp2f(u * -1.4426950408889634f)); }
__device__ __forceinline__ void p7_elementwise(const Frame& F, int wi, int nw) {
    const int gt = wi * NTHREADS + opaque_tid(), NGT = nw * NTHREADS;
    constexpr int CPR8 = DFF / 8;
    constexpr int NFIX = 2 * (MP / 256) + 2 * DECB;
    for (int it = gt; it < NFIX * CPR8; it += NGT) { const int k = it / CPR8, c = (it - k * CPR8) * 8;
        const int m = k < 64 ? (k >> 1) * 256 + (k & 1) : MP + ((k - 64) >> 1) * 4 + ((k - 64) & 1);
        f32x4 u2a, u2b, u1a, u1b, u0a, u0b;
        unpack8(*(const u32x4*)(WSB(F, WS_U) + (size_t)m * DFF + c), u2a, u2b);
        const f32x4 z = (f32x4){0.f, 0.f, 0.f, 0.f}; u1a = z; u1b = z; u0a = z; u0b = z;
        if (m < MP) { const int t = m & (SEQ - 1);
            if (t >= 1) unpack8(*(const u32x4*)(WSB(F, WS_U) + (size_t)(m - 1) * DFF + c), u1a, u1b);
            if (t >= 2) unpack8(*(const u32x4*)(WSB(F, WS_U) + (size_t)(m - 2) * DFF + c), u0a, u0b);
        } else { const int ms = m - MP, b = ms >> 2, t = ms & 3;
            if (t + 1 >= 2) unpack8(*(const u32x4*)(WSB(F, WS_U) + (size_t)(m - 1) * DFF + c), u1a, u1b); else { const float* sp = INP(F, I_SFFN) + ((size_t)b * 2 + (t + 1)) * DFF + c; u1a = *(const f32x4*)sp; u1b = *(const f32x4*)(sp + 4); }
            if (t >= 2) unpack8(*(const u32x4*)(WSB(F, WS_U) + (size_t)(m - 2) * DFF + c), u0a, u0b); else { const float* sp = INP(F, I_SFFN) + ((size_t)b * 2 + t) * DFF + c; u0a = *(const f32x4*)sp; u0b = *(const f32x4*)(sp + 4); } }
        const float* cw = INP(F, I_FCW) + c;
        const f32x4 w0a = *(const f32x4*)cw, w0b = *(const f32x4*)(cw + 4), w1a = *(const f32x4*)(cw + DFF), w1b = *(const f32x4*)(cw + DFF + 4), w2a = *(const f32x4*)(cw + 2 * DFF), w2b = *(const f32x4*)(cw + 2 * DFF + 4);
        const f32x4 ba = *(const f32x4*)(INP(F, I_FCB) + c), bb = *(const f32x4*)(INP(F, I_FCB) + c + 4);
        f32x4 ga, gb; unpack8(__builtin_nontemporal_load((const u32x4*)(WSB(F, WS_G) + (size_t)m * DFF + c)), ga, gb);
        f32x4 va = w0a * u0a + w1a * u1a + w2a * u2a + ba, vb = w0b * u0b + w1b * u1b + w2b * u2b + bb, oa, ob;
#pragma unroll
        for (int j = 0; j < 4; ++j) { oa[j] = gelu_tanh(va[j]) * ga[j]; ob[j] = gelu_tanh(vb[j]) * gb[j]; }
        *(u32x4*)(WSB(F, WS_AFF) + (size_t)m * DFF + c) = pack8(oa, ob); }
}
__device__ __forceinline__ void p9_rows(const Frame& F) {
    const int gw = F.vcu * NWAVES + F.wave, NGW = F.G * NWAVES, lane = opaque_tid() & 63;
#pragma unroll 2
    for (int m = gw; m < MT; m += NGW) {
        const u32x2* fr_ = (const u32x2*)(WSB(F, WS_F) + (size_t)m * DM) + lane; const f32x4* xr = (const f32x4*)(WSF(F, WS_X1) + (size_t)m * DM) + lane;
        f32x4 v[8]; float s = 0.f;
#pragma unroll
        for (int j = 0; j < 8; ++j) { const u32x2 w_ = fr_[64 * j]; v[j] = (f32x4){bf_lo(w_.x), bf_hi(w_.x), bf_lo(w_.y), bf_hi(w_.y)}; s += (v[j][0] * v[j][0] + v[j][1] * v[j][1]) + (v[j][2] * v[j][2] + v[j][3] * v[j][3]); }
        const float r1 = rsqrtf(wave_sum(s) * (1.0f / DM) + EPS);
#pragma unroll
        for (int j = 0; j < 8; ++j) { const f32x4 g = ((const f32x4*)INP(F, I_GPOSTFFN))[lane + 64 * j]; __builtin_nontemporal_store(__builtin_nontemporal_load(xr + 64 * j) + v[j] * r1 * g, (f32x4*)(F.out + (size_t)m * DM) + lane + 64 * j); }
    }
}

__global__ void __launch_bounds__(NTHREADS, 2) fwd_kernel(Params P) {
    extern __shared__ __attribute__((aligned(16))) unsigned char lds_raw[];
    cg::grid_group grid = cg::this_grid();
    Frame F;
    F.lds = (LAS unsigned char*)lds_raw;
    F.wave = __builtin_amdgcn_readfirstlane((int)threadIdx.x >> 6);
    F.G = gridDim.x; { const int bx = blockIdx.x; F.vcu = (F.G % 8 == 0) ? (bx % 8) * (F.G / 8) + bx / 8 : bx; }
    F.P = &P; F.ws = P.ws; F.out = P.out;
    volatile LAS unsigned* bst = (volatile LAS unsigned*)(F.lds + LDS_BYTES - 64);
    if (threadIdx.x < 2) bst[threadIdx.x] = 0u;
    __syncthreads();
    const XcdBarrier xbar = xcd_barrier_post((unsigned*)(P.ws + WS_CTL), bst);
    const int lo = P.ph_lo, hi = P.ph_hi;
#define IN(k) (lo <= (k) && (k) < hi)
#define SEAM(k) do { if (IN(k) && IN((k) + 1)) xcd_barrier(xbar); } while (0)
    const int c = (int)blockIdx.x;
#ifndef PROBE_PH
#define PROBE_PH (-1)
#endif
#define REPS(k) (((k) == PROBE_PH) ? 2 : 1)
#define PHASE(k, ...) do { if (IN(k)) { for (int rep_ = 0; rep_ < REPS(k); ++rep_) { if (rep_) grid.sync(); __VA_ARGS__ } } SEAM(k); } while (0)
    PHASE(0, { p0_prologue(F); __syncthreads(); });
    PHASE(1, {
        const bool tailk = F.G == 256;
        Sched1 S{(const char*)WSB(F, WS_HN), (const char*)WSB(F, WS_WINT), F.G, c};
        Epi1 E{WSB(F, WS_Q), WSB(F, WS_K), WSB(F, WS_GR), WSB(F, WS_GB), WSB(F, WS_CPR), WSB(F, WS_GA), WSB(F, WS_GBT), WSB(F, WS_VT), WSF(F, WS_ROPE), F.out, (unsigned*)(F.ws + WS_P1CNT), tailk ? (2447 - c) / 256 : -1};
        gemm_phase<false>(F.lds, S, E);
        if (tailk && c >= 176) {
            if (threadIdx.x == 0) { unsigned* cnt = (unsigned*)(F.ws + WS_P1CNT); unsigned sp = 0;
                while (__hip_atomic_load(cnt, __ATOMIC_RELAXED, __HIP_MEMORY_SCOPE_AGENT) < 256u) { __builtin_amdgcn_s_sleep(8); if (++sp > (1u << 22)) break; }
                __builtin_amdgcn_fence(__ATOMIC_ACQUIRE, "agent"); asm volatile("s_waitcnt vmcnt(0)" ::: "memory"); }
            __syncthreads();
            kht_prep(F, c - 176, 80);
            p0_items(F, (c - 176) * NWAVES + F.wave, 80 * NWAVES, P0_DEF_LO, P0_DEF_LO + P0_DEF_N, 0x7fffffff, 0); } });
    PHASE(2, { if (F.G != 256) { kht_prep(F, F.vcu, F.G); xcd_barrier(xbar); } p2_main(F, c); __syncthreads(); });
    PHASE(3, {
        Sched3 S{(const char*)WSB(F, WS_ARET), (const char*)WSB(F, WS_PRETT), (const char*)WSB(F, WS_ACONV), (const char*)WSB(F, WS_PCONVT), F.G, c};
        Epi3 E{WSB(F, WS_GA), WSB(F, WS_GBT), WSF(F, WS_MTMP), WSB(F, WS_MBUF)};
        gemm_phase<true>(F.lds, S, E); });
    PHASE(4, {
        SchedX S{(const char*)WSB(F, WS_MBUF), (const char*)WSB(F, WS_WOT), 32, F.G, c, K_MIX};
        EpiB16 E{WSB(F, WS_MIX)};
        gemm_phase<true>(F.lds, S, E); });
    PHASE(5, { p5_rows(F); });
    PHASE(6, {
        Sched6 S{(const char*)WSB(F, WS_HN), (const char*)WSB(F, WS_WUGT), (const char*)WSB(F, WS_KHT), (const char*)WSB(F, WS_VT), F.G, c};
        Epi6 E{WSB(F, WS_U), WSB(F, WS_G), F.out, WSB(F, WS_ST), WSB(F, WS_AFF), INP(F, I_FCW), INP(F, I_FCB)};
        gemm_phase<false>(F.lds, S, E); });
    PHASE(7, {
        p7_elementwise(F, c, F.G); });
    PHASE(8, {
        SchedX S{(const char*)WSB(F, WS_AFF), (const char*)WSB(F, WS_WDT), 88, F.G, c, K_DOWN};
        Epi8 E{WSF(F, WS_X1), F.out, INP(F, I_GPOSTFFN), (unsigned long long*)(F.ws + WS_PART0)};
        gemm_phase<true>(F.lds, S, E); });
#undef PHASE
#undef REPS
#undef IN
#undef SEAM
}

extern "C" void kernel_launch(void* const* d_in, const int* in_sizes, int n_in, void* d_out, int out_size, void* d_ws, size_t ws_size, hipStream_t stream) {
    static int grid = 0;
    if (grid == 0) {
        if (n_in != 19 || (size_t)out_size != OUT_TOTAL || ws_size < WS_END) { fprintf(stderr, "kernel_launch: unexpected problem: n_in %d out %d ws %zu (need %zu)\n", n_in, out_size, ws_size, (size_t)WS_END); grid = -1; return; }
        int dev = 0, cus = 0, per_cu = 0;
        if (hipGetDevice(&dev) != hipSuccess || hipDeviceGetAttribute(&cus, hipDeviceAttributeMultiprocessorCount, dev) != hipSuccess) { grid = -1; return; }
        if (hipFuncSetAttribute((const void*)fwd_kernel, hipFuncAttributeMaxDynamicSharedMemorySize, LDS_BYTES) != hipSuccess) { fprintf(stderr, "kernel_launch: hipFuncSetAttribute failed\n"); grid = -1; return; }
        if (hipOccupancyMaxActiveBlocksPerMultiprocessor(&per_cu, (const void*)fwd_kernel, NTHREADS, LDS_BYTES) != hipSuccess || per_cu < 1) { fprintf(stderr, "kernel_launch: occupancy query failed (%d)\n", per_cu); (void)hipGetLastError(); grid = -1; return; }
        grid = cus * per_cu;
        fprintf(stderr, "kernel_launch: %d CUs x %d blocks/CU -> grid %d\n", cus, per_cu, grid);
    }
    if (grid < 0) return;
    if (hipMemsetAsync((char*)d_ws + WS_CTL, 0, WS_CTL_BYTES, stream) != hipSuccess) { fprintf(stderr, "kernel_launch: hipMemsetAsync failed\n"); return; }
    Params p{};
    for (int i = 0; i < 19; ++i) p.in[i] = (const float*)d_in[i];
    p.out = (float*)d_out; p.ws = (unsigned char*)d_ws; p.ph_lo = 0; p.ph_hi = 9;
    void* args[] = {&p};
    hipError_t e = hipLaunchCooperativeKernel((const void*)fwd_kernel, dim3(grid), dim3(NTHREADS), args, LDS_BYTES, stream);
    if (e != hipSuccess) fprintf(stderr, "kernel_launch: cooperative launch failed: %s (grid %d)\n", hipGetErrorString(e), grid);
}
```
